# Optimizing an MI355X kernel written in HIP

```python
import math
import jax, jax.numpy as jnp
from jax import lax
import numpy as np

D_MODEL = 1024
BATCH = 8
SEQ = 2048
DEPTH = 2

CHUNK = 64
A_HEADS = 8
A_KV_HEADS = 2
A_HEAD_DIM = 64
WINDOW = 128
WINDOW_CHUNKS = WINDOW // CHUNK
B_HEADS = 8
B_Q_LORA = 384
B_KV_LORA = 256
B_NOPE = 64
B_ROPE = 32
B_V = 64
ROPE_THETA = 10000.0
Q_BLOCK = 128
C_HEADS = 4
C_KEY_DIM = 128
C_VAL_DIM = 128
D_CH = 512
CONV_W = 3
D_FF = 3584
N_EXPERTS = 8
TOP_K = 2
EPS = 1e-6
NEG_INF = -1e30

A_Q = A_HEADS * A_HEAD_DIM
A_KV = A_KV_HEADS * A_HEAD_DIM
EVEN_SIZES = (A_Q, A_KV, A_KV, B_Q_LORA, B_KV_LORA, B_ROPE)
EVEN_IN = A_Q + 2 * A_KV + B_Q_LORA + B_KV_LORA + B_ROPE
EVEN_MIX = A_Q + B_HEADS * B_V
C_QK = C_HEADS * C_KEY_DIM
C_WIDTH = C_HEADS * C_VAL_DIM
ODD_SIZES = (C_QK, C_QK, C_WIDTH, C_WIDTH, D_CH, D_CH, D_CH)
ODD_IN = 2 * C_QK + 2 * C_WIDTH + 3 * D_CH
ODD_MIX = C_WIDTH + D_CH
N_EVEN = (DEPTH + 1) // 2
N_ODD = DEPTH // 2

kernel_name = "chunk_causal_hybrid_swa_mla_retnet_shortconv_moe"


def _split(t, sizes):
    outs, start = [], 0
    for s in sizes:
        outs.append(t[..., start:start + s])
        start += s
    return outs


def rmsnorm(x, g):
    xf = x.astype(jnp.float32)
    y = xf * lax.rsqrt(jnp.mean(xf * xf, axis=-1, keepdims=True) + EPS)
    return (y * g.astype(jnp.float32)).astype(x.dtype)


def swiglu(h, w_gate, w_up, w_down):
    return (jax.nn.silu(h @ w_gate) * (h @ w_up)) @ w_down


def rope(t, cos, sin):
    half = t.shape[-1] // 2
    t1, t2 = t[..., :half], t[..., half:]
    return jnp.concatenate([t1 * cos - t2 * sin, t2 * cos + t1 * sin], axis=-1).astype(t.dtype)


def sliding_window_gqa(q, k, v, sinks, slopes):
    Bn, S, Hq, d = q.shape
    Hkv = k.shape[2]
    G = Hq // Hkv
    N = S // CHUNK
    band = (WINDOW_CHUNKS + 1) * CHUNK
    pad = ((0, 0), (WINDOW_CHUNKS * CHUNK, 0), (0, 0), (0, 0))
    kp, vp = jnp.pad(k, pad), jnp.pad(v, pad)

    def banded(t):
        parts = [t[:, j * CHUNK:j * CHUNK + S].reshape(Bn, N, CHUNK, Hkv, d)
                 for j in range(WINDOW_CHUNKS + 1)]
        return jnp.concatenate(parts, axis=2)

    kb, vb = banded(kp), banded(vp)
    qc = q.reshape(Bn, N, CHUNK, Hkv, G, d)
    s = jnp.einsum('bnqhgd,bnkhd->bnhgqk', qc, kb).astype(jnp.float32) * d ** -0.5
    qi = jnp.arange(CHUNK)
    kk = jnp.arange(band)
    dist = jnp.abs(qi[:, None] + WINDOW_CHUNKS * CHUNK - kk[None, :]).astype(jnp.float32)
    bias = -slopes.reshape(Hkv, G)[:, :, None, None] * dist
    key_pos = jnp.arange(N)[:, None] * CHUNK - WINDOW_CHUNKS * CHUNK + kk[None, :]
    valid = (key_pos >= 0)[None, :, None, None, None, :]
    s = jnp.where(valid, s + bias, NEG_INF)
    sink = jnp.broadcast_to(sinks.astype(jnp.float32).reshape(Hkv, G)[:, :, None, None],
                            s.shape[:-1] + (1,))
    p = jax.nn.softmax(jnp.concatenate([s, sink], axis=-1), axis=-1)[..., :-1]
    o = jnp.einsum('bnhgqk,bnkhd->bnqhgd', p.astype(v.dtype), vb)
    return o.reshape(Bn, S, Hq * d)


def mla(c_q, c_kv, k_rope_raw, q_norm, w_uq, kv_norm, w_ukv, cos, sin):
    Bn, S, _ = c_q.shape
    q = (rmsnorm(c_q, q_norm) @ w_uq).reshape(Bn, S, B_HEADS, B_NOPE + B_ROPE)
    q_nope = q[..., :B_NOPE]
    q_rope = rope(q[..., B_NOPE:], cos[:, :, None], sin[:, :, None])
    kv = (rmsnorm(c_kv, kv_norm) @ w_ukv).reshape(Bn, S, B_HEADS, B_NOPE + B_V)
    k_nope, v = kv[..., :B_NOPE], kv[..., B_NOPE:]
    k_rope = rope(k_rope_raw, cos, sin)
    NB = S // Q_BLOCK
    scale = (B_NOPE + B_ROPE) ** -0.5
    key_chunk = jnp.arange(S) // CHUNK

    def to_blocks(t):
        return t.reshape(Bn, NB, Q_BLOCK, *t.shape[2:]).swapaxes(0, 1)

    def block(args):
        qn, qr, bi = args
        s = (jnp.einsum('bqhd,bkhd->bhqk', qn, k_nope)
             + jnp.einsum('bqhd,bkd->bhqk', qr, k_rope)).astype(jnp.float32) * scale
        q_chunk = (bi * Q_BLOCK + jnp.arange(Q_BLOCK)) // CHUNK
        s = jnp.where(key_chunk[None, :] <= q_chunk[:, None], s, NEG_INF)
        p = jax.nn.softmax(s, axis=-1)
        return jnp.einsum('bhqk,bkhd->bqhd', p.astype(v.dtype), v)

    o = lax.map(block, (to_blocks(q_nope), to_blocks(q_rope), jnp.arange(NB)))
    return o.swapaxes(0, 1).reshape(Bn, S, B_HEADS * B_V)


def retention(q, k, v):
    Bn, S, H, dk = q.shape
    dv = v.shape[-1]
    N = S // CHUNK
    f32 = jnp.float32
    q = q.astype(f32)
    k = k.astype(f32) * dk ** -0.5
    v = v.astype(f32)

    def to_chunks(t):
        return t.reshape(Bn, N, CHUNK, H, t.shape[-1]).transpose(1, 0, 3, 2, 4)

    log_g = jnp.log(1.0 - 2.0 ** (-5.0 - jnp.arange(H, dtype=f32)))
    i = jnp.arange(CHUNK, dtype=f32)
    diff = i[:, None] - i[None, :]
    intra_decay = jnp.where(diff >= 0, jnp.exp(log_g[:, None, None] * jnp.maximum(diff, 0.0)), 0.0)
    cross_decay = jnp.exp(log_g[:, None] * (i + 1.0))
    state_decay = jnp.exp(log_g[:, None] * (CHUNK - 1.0 - i))
    chunk_decay = jnp.exp(log_g * CHUNK)

    def step(R, qkv):
        qc, kc, vc = qkv
        scores = jnp.einsum('bhqd,bhkd->bhqk', qc, kc) * intra_decay
        inner = jnp.einsum('bhqk,bhkv->bhqv', scores, vc)
        cross = jnp.einsum('bhqd,bhdv->bhqv', qc, R) * cross_decay[..., None]
        R = chunk_decay[:, None, None] * R + jnp.einsum('bhkd,bhkv->bhdv', kc * state_decay[..., None], vc)
        return R, inner + cross

    R0 = jnp.zeros((Bn, H, dk, dv), f32)
    _, out = lax.scan(step, R0, (to_chunks(q), to_chunks(k), to_chunks(v)))
    return out.transpose(1, 0, 3, 2, 4).reshape(Bn, S, H, dv)


def head_group_norm(y, g):
    mu = jnp.mean(y, axis=-1, keepdims=True)
    var = jnp.mean(jnp.square(y - mu), axis=-1, keepdims=True)
    yn = (y - mu) * lax.rsqrt(var + EPS)
    return yn.reshape(y.shape[0], y.shape[1], -1) * g.astype(jnp.float32)


def short_gated_conv(b_gate, c_gate, h, w):
    S = h.shape[1]
    u = jnp.pad(c_gate * h, ((0, 0), (CONV_W - 1, 0), (0, 0)))
    y = sum(w[j] * u[:, j:j + S] for j in range(CONV_W))
    return b_gate * y


def moe(h, router, we_gate, we_up, we_down):
    logits = jnp.einsum('bsd,de->bse', h, router).astype(jnp.float32)
    top_val, top_idx = lax.top_k(logits, TOP_K)
    gates = jax.nn.softmax(top_val, axis=-1)
    combine = jnp.sum(jax.nn.one_hot(top_idx, N_EXPERTS, dtype=jnp.float32) * gates[..., None], axis=-2)
    out = jnp.zeros(h.shape, jnp.float32)
    for e in range(N_EXPERTS):
        out = out + combine[..., e:e + 1] * swiglu(h, we_gate[e], we_up[e], we_down[e]).astype(jnp.float32)
    return out.astype(h.dtype)


def setup_inputs(seed: int = 0) -> dict:
    key = jax.random.key(seed)
    ks = iter(jax.random.split(key, 32))
    f32 = jnp.float32

    def w(shape, fan_in):
        return jax.random.normal(next(ks), shape, f32) * fan_in ** -0.5

    def gain(shape):
        return 1.0 + 0.1 * jax.random.normal(next(ks), shape, f32)

    x = jax.random.normal(next(ks), (BATCH, SEQ, D_MODEL), f32)
    offsets = jax.random.randint(next(ks), (BATCH, 1), 0, 64, dtype=jnp.int32) * CHUNK
    positions = (offsets + jnp.arange(SEQ, dtype=jnp.int32)[None, :]).astype(jnp.int32)
    return {
        "x": x,
        "positions": positions,
        "even_norm_mix": gain((N_EVEN, D_MODEL)),
        "even_w_in": w((N_EVEN, D_MODEL, EVEN_IN), D_MODEL),
        "even_sinks": jax.random.normal(next(ks), (N_EVEN, A_HEADS), f32),
        "even_q_norm": gain((N_EVEN, B_Q_LORA)),
        "even_w_uq": w((N_EVEN, B_Q_LORA, B_HEADS * (B_NOPE + B_ROPE)), B_Q_LORA),
        "even_kv_norm": gain((N_EVEN, B_KV_LORA)),
        "even_w_ukv": w((N_EVEN, B_KV_LORA, B_HEADS * (B_NOPE + B_V)), B_KV_LORA),
        "even_w_out": w((N_EVEN, EVEN_MIX, D_MODEL), EVEN_MIX),
        "even_norm_ffn": gain((N_EVEN, D_MODEL)),
        "even_w_gate": w((N_EVEN, D_MODEL, D_FF), D_MODEL),
        "even_w_up": w((N_EVEN, D_MODEL, D_FF), D_MODEL),
        "even_w_down": w((N_EVEN, D_FF, D_MODEL), D_FF),
        "odd_norm_mix": gain((N_ODD, D_MODEL)),
        "odd_w_in": w((N_ODD, D_MODEL, ODD_IN), D_MODEL),
        "odd_ret_gn": gain((N_ODD, C_WIDTH)),
        "odd_conv_w": w((N_ODD, CONV_W, D_CH), CONV_W),
        "odd_w_out": w((N_ODD, ODD_MIX, D_MODEL), ODD_MIX),
        "odd_norm_ffn": gain((N_ODD, D_MODEL)),
        "odd_router": w((N_ODD, D_MODEL, N_EXPERTS), D_MODEL),
        "odd_we_gate": w((N_ODD, N_EXPERTS, D_MODEL, D_FF), D_MODEL),
        "odd_we_up": w((N_ODD, N_EXPERTS, D_MODEL, D_FF), D_MODEL),
        "odd_we_down": w((N_ODD, N_EXPERTS, D_FF, D_MODEL), D_FF),
        "final_norm": gain((D_MODEL,)),
    }


def reference(x, positions, even_norm_mix, even_w_in, even_sinks, even_q_norm, even_w_uq,
              even_kv_norm, even_w_ukv, even_w_out, even_norm_ffn, even_w_gate, even_w_up,
              even_w_down, odd_norm_mix, odd_w_in, odd_ret_gn, odd_conv_w, odd_w_out,
              odd_norm_ffn, odd_router, odd_we_gate, odd_we_up, odd_we_down, final_norm):
    Bn, S, _ = x.shape
    inv_freq = ROPE_THETA ** (-jnp.arange(0, B_ROPE, 2, dtype=jnp.float32) / B_ROPE)
    ang = positions.astype(jnp.float32)[..., None] * inv_freq
    cos, sin = jnp.cos(ang), jnp.sin(ang)
    slopes = 2.0 ** (-8.0 * (jnp.arange(A_HEADS, dtype=jnp.float32) + 1.0) / A_HEADS)

    for layer in range(DEPTH):
        i = layer // 2
        if layer % 2 == 0:
            h = rmsnorm(x, even_norm_mix[i])
            qa, ka, va, cq, ckv, kr = _split(h @ even_w_in[i], EVEN_SIZES)
            ya = sliding_window_gqa(qa.reshape(Bn, S, A_HEADS, A_HEAD_DIM),
                                    ka.reshape(Bn, S, A_KV_HEADS, A_HEAD_DIM),
                                    va.reshape(Bn, S, A_KV_HEADS, A_HEAD_DIM),
                                    even_sinks[i], slopes)
            yb = mla(cq, ckv, kr, even_q_norm[i], even_w_uq[i], even_kv_norm[i], even_w_ukv[i], cos, sin)
            x = x + (jnp.concatenate([ya.astype(x.dtype), yb.astype(x.dtype)], axis=-1) @ even_w_out[i])
            x = x + swiglu(rmsnorm(x, even_norm_ffn[i]), even_w_gate[i], even_w_up[i], even_w_down[i])
        else:
            h = rmsnorm(x, odd_norm_mix[i])
            qc, kc, vc, gc, bd, cd, hd = _split(h @ odd_w_in[i], ODD_SIZES)
            yr = retention(qc.reshape(Bn, S, C_HEADS, C_KEY_DIM),
                           kc.reshape(Bn, S, C_HEADS, C_KEY_DIM),
                           vc.reshape(Bn, S, C_HEADS, C_VAL_DIM))
            yc = (jax.nn.silu(gc.astype(jnp.float32)) * head_group_norm(yr, odd_ret_gn[i])).astype(x.dtype)
            yd = short_gated_conv(bd, cd, hd, odd_conv_w[i]).astype(x.dtype)
            x = x + (jnp.concatenate([yc, yd], axis=-1) @ odd_w_out[i])
            x = x + moe(rmsnorm(x, odd_norm_ffn[i]), odd_router[i], odd_we_gate[i], odd_we_up[i], odd_we_down[i])
    return rmsnorm(x, final_norm)
```

```cpp
#include <hip/hip_runtime.h>
#include <cstdint>
#include <cstdio>
#include <cmath>

typedef unsigned short bf16_t;
constexpr int D = 1024, BATCH = 8, SEQ = 2048, T = BATCH * SEQ, CHUNK = 64;
constexpr int EVEN_IN = 1440, EVEN_INP = 1536, FF = 3584, ODD_IN = 3584, NE = 8;
constexpr float EPS = 1e-6f;
constexpr int P0_QA = 0, P0_KA = 512, P0_VA = 640, P0_CQ = 768, P0_CKV = 1152, P0_KR = 1408;
constexpr int P1_Q = 0, P1_K = 512, P1_V = 1024, P1_G = 1536, P1_B = 2048, P1_C = 2560, P1_H = 3072;

constexpr size_t MiB = 1u << 20;
constexpr size_t WS_CTL = 0;
constexpr size_t WS_W_IN0 = 1 * MiB;
constexpr size_t WS_W_UQ = WS_W_IN0 + (size_t)EVEN_INP * D * 2;
constexpr size_t WS_W_UKV = WS_W_UQ + (size_t)768 * 384 * 2;
constexpr size_t WS_W_OUT0 = WS_W_UKV + (size_t)1024 * 256 * 2;
constexpr size_t WS_W_GU0 = WS_W_OUT0 + (size_t)D * D * 2;
constexpr size_t WS_W_DN0 = WS_W_GU0 + (size_t)2 * FF * D * 2;
constexpr size_t WS_W_IN1 = WS_W_DN0 + (size_t)D * FF * 2;
constexpr size_t WS_W_OUT1 = WS_W_IN1 + (size_t)ODD_IN * D * 2;
constexpr size_t WS_WE_GU = 38 * MiB;
constexpr size_t WS_WE_DN = WS_WE_GU + (size_t)NE * 2 * FF * D * 2;
constexpr size_t WS_ACT0 = WS_WE_DN + (size_t)NE * D * FF * 2;
static_assert(WS_W_OUT1 + (size_t)D * D * 2 <= WS_WE_GU, "dense weights fit below 38 MiB");
static_assert(WS_ACT0 == 206 * MiB, "activation base");
constexpr size_t WS_XN = WS_ACT0;
constexpr size_t WS_YMIX = WS_ACT0 + 32 * MiB;
constexpr size_t WS_BIG = WS_ACT0 + 64 * MiB;
constexpr size_t WS_PROJ0 = WS_BIG;
constexpr size_t WS_CQN = WS_BIG + 48 * MiB;
constexpr size_t WS_CKVN = WS_BIG + 60 * MiB;
constexpr size_t WS_KROPE = WS_BIG + 68 * MiB;
constexpr size_t WS_QM = WS_BIG + 70 * MiB;
constexpr size_t WS_KVM = WS_BIG + 94 * MiB;
constexpr size_t WS_ACT = WS_BIG;
constexpr size_t WS_PROJ1 = WS_BIG;
constexpr size_t WS_RKV = WS_BIG + 112 * MiB;
constexpr size_t WS_YR = WS_BIG + 144 * MiB;
constexpr int MOE_MAXT = 136, MOE_HALFT = 68;
constexpr size_t WS_ACTM = WS_ACT0;
constexpr size_t WS_YP0 = WS_ACT0 + 119 * MiB;
constexpr size_t WS_YP1 = WS_YP0 + 68 * MiB;
constexpr size_t WS_TAB = WS_YP1 + 68 * MiB;
constexpr size_t WS_XNM = 1 * MiB;
constexpr size_t WS_END = WS_TAB + 2 * MiB;
static_assert(WS_END <= 471 * MiB, "workspace budget");
constexpr size_t TAB_LTOK = 0;
constexpr size_t TAB_LGATE = 512 * 1024;
constexpr size_t TAB_TSEL = 1024 * 1024;
constexpr size_t TAB_TGATE = 1280 * 1024;
constexpr int CW_CNT = 64;

__device__ __forceinline__ float bf2f(bf16_t v) { return __uint_as_float((unsigned)v << 16); }
__device__ __forceinline__ bf16_t f2bf(float f) { unsigned u = __float_as_uint(f); return (bf16_t)((u + 0x7fffu + ((u >> 16) & 1u)) >> 16); }
__device__ __forceinline__ float wave_sum(float v) {
#pragma unroll
    for (int o = 1; o < 64; o <<= 1) v += __shfl_xor(v, o);
    return v;
}
__device__ __forceinline__ float silu(float v) { return v / (1.f + __expf(-v)); }

struct RowIdent { int off; __device__ int operator()(int n) const { return off + n; } };
struct RowGU { int half; __device__ int operator()(int n) const { return 256 * (n >> 7) + 128 * half + (n & 127); } };
template <class RM>
__global__ void __launch_bounds__(256) k_wconv(const float* __restrict__ W, int K, int N, bf16_t* __restrict__ WT, RM rm) {
    __shared__ float tile[32][33];
    const int nb = N / 32, kb = blockIdx.x / nb, n0 = (blockIdx.x % nb) * 32, k0 = kb * 32;
    const int tx = threadIdx.x & 31, ty = threadIdx.x >> 5;
    for (int i = ty; i < 32; i += 8) tile[i][tx] = W[(size_t)(k0 + i) * N + n0 + tx];
    __syncthreads();
    for (int i = ty; i < 32; i += 8) WT[(size_t)rm(n0 + i) * K + k0 + tx] = f2bf(tile[tx][i]);
}
__global__ void k_fill_bf16(bf16_t* p, size_t n, bf16_t v) { size_t i = (size_t)blockIdx.x * blockDim.x + threadIdx.x; if (i < n) p[i] = v; }

__global__ void __launch_bounds__(256) k_rmsnorm(const float* __restrict__ x, const float* __restrict__ g, bf16_t* __restrict__ o) {
    const int row = blockIdx.x * 4 + (threadIdx.x >> 6), lane = threadIdx.x & 63;
    const float* xr = x + (size_t)row * D;
    float v[16]; float s = 0.f;
#pragma unroll
    for (int j = 0; j < 16; ++j) { v[j] = xr[lane + 64 * j]; s += v[j] * v[j]; }
    const float rs = rsqrtf(wave_sum(s) * (1.f / D) + EPS);
#pragma unroll
    for (int j = 0; j < 16; ++j) o[(size_t)row * D + lane + 64 * j] = f2bf(v[j] * rs * g[lane + 64 * j]);
}

struct GemmArgs { const bf16_t* A; const bf16_t* Bt; int lda, ldb, M, N, K, pad; };
template <bool DUAL, class Ctx>
__global__ void __launch_bounds__(256) k_gemm(GemmArgs g, Ctx ctx) {
    __shared__ float As[16][68], Bs[16][68], B2[16][68];
    const int m0 = blockIdx.y * 64, n0 = blockIdx.x * 64;
    if (!ctx.block_valid(m0)) return;
    const bf16_t* Bt = g.Bt + ctx.b_offset(m0);
    const int tx = threadIdx.x & 15, ty = threadIdx.x >> 4;
    float acc[4][4], acc2[4][4];
#pragma unroll
    for (int i = 0; i < 4; ++i)
#pragma unroll
        for (int j = 0; j < 4; ++j) { acc[i][j] = 0.f; acc2[i][j] = 0.f; }
    const int lr = threadIdx.x >> 2, lk = (threadIdx.x & 3) * 4;
    const size_t arow = (size_t)ctx.a_row(m0 + lr) * g.lda;
    const size_t brow = (size_t)ctx.b_row(n0 + lr) * g.ldb;
    for (int k0 = 0; k0 < g.K; k0 += 16) {
#pragma unroll
        for (int j = 0; j < 4; ++j) {
            As[lk + j][lr] = bf2f(g.A[arow + k0 + lk + j]);
            Bs[lk + j][lr] = bf2f(Bt[brow + k0 + lk + j]);
            if (DUAL) B2[lk + j][lr] = bf2f(Bt[brow + (size_t)128 * g.ldb + k0 + lk + j]);
        }
        __syncthreads();
#pragma unroll
        for (int kk = 0; kk < 16; ++kk) {
            float a[4], b[4], b2[4];
#pragma unroll
            for (int i = 0; i < 4; ++i) { a[i] = As[kk][ty * 4 + i]; b[i] = Bs[kk][tx * 4 + i]; b2[i] = DUAL ? B2[kk][tx * 4 + i] : 0.f; }
#pragma unroll
            for (int i = 0; i < 4; ++i)
#pragma unroll
                for (int j = 0; j < 4; ++j) { acc[i][j] += a[i] * b[j]; if (DUAL) acc2[i][j] += a[i] * b2[j]; }
        }
        __syncthreads();
    }
#pragma unroll
    for (int i = 0; i < 4; ++i)
#pragma unroll
        for (int j = 0; j < 4; ++j) ctx.store(m0 + ty * 4 + i, n0 + tx * 4 + j, acc[i][j], acc2[i][j]);
}
struct CtxBf16 {
    bf16_t* O; int ldc; int pad;
    __device__ bool block_valid(int) const { return true; }
    __device__ size_t b_offset(int) const { return 0; }
    __device__ int a_row(int m) const { return m; }
    __device__ int b_row(int n) const { return n; }
    __device__ void store(int m, int n, float a, float) const { O[(size_t)m * ldc + n] = f2bf(a); }
};
struct CtxRes {
    const float* base; float* out; int ldc; int pad;
    __device__ bool block_valid(int) const { return true; }
    __device__ size_t b_offset(int) const { return 0; }
    __device__ int a_row(int m) const { return m; }
    __device__ int b_row(int n) const { return n; }
    __device__ void store(int m, int n, float a, float) const { out[(size_t)m * ldc + n] = base[(size_t)m * ldc + n] + a; }
};
struct CtxSwiglu {
    bf16_t* O; int ldc; int pad;
    __device__ bool block_valid(int) const { return true; }
    __device__ size_t b_offset(int) const { return 0; }
    __device__ int a_row(int m) const { return m; }
    __device__ int b_row(int n) const { return 256 * (n >> 7) + (n & 127); }
    __device__ void store(int m, int n, float a, float b) const { O[(size_t)m * ldc + n] = f2bf(silu(a) * b); }
};
__device__ __forceinline__ void moe_tile(const unsigned* cnt, int tile, int& e, int& slot0, int& ntiles) {
    int tb = 0; e = -1; slot0 = 0;
#pragma unroll
    for (int i = 0; i < NE; ++i) { const int c = (int)cnt[64 * i], nt = (c + 255) >> 8; if (e < 0 && tile < tb + nt) { e = i; slot0 = (tile - tb) * 256; } tb += nt; }
    ntiles = tb;
}
struct CtxMoeGU {
    bf16_t* O; const unsigned* cnt; const int* ltok; int ldc, tile_lo, tile_hi, pad;
    __device__ bool block_valid(int m0) const { int e, s0, nt; const int t = tile_lo + (m0 >> 8); moe_tile(cnt, t, e, s0, nt); return t < tile_hi && t < nt && e >= 0; }
    __device__ size_t b_offset(int m0) const { int e, s0, nt; moe_tile(cnt, tile_lo + (m0 >> 8), e, s0, nt); return (size_t)e * 2 * FF * D; }
    __device__ int a_row(int m) const { int e, s0, nt; moe_tile(cnt, tile_lo + (m >> 8), e, s0, nt); const int slot = s0 + (m & 255); return slot < (int)cnt[64 * e] ? ltok[e * T + slot] : 0; }
    __device__ int b_row(int n) const { return 256 * (n >> 7) + (n & 127); }
    __device__ void store(int m, int n, float a, float b) const { O[(size_t)m * ldc + n] = f2bf(silu(a) * b); }
};
struct CtxMoeDn {
    bf16_t* O; const unsigned* cnt; const float* lgate; int tile_lo, tile_hi;
    __device__ bool block_valid(int m0) const { int e, s0, nt; const int t = tile_lo + (m0 >> 8); moe_tile(cnt, t, e, s0, nt); return t < tile_hi && t < nt && e >= 0; }
    __device__ size_t b_offset(int m0) const { int e, s0, nt; moe_tile(cnt, tile_lo + (m0 >> 8), e, s0, nt); return (size_t)e * D * FF; }
    __device__ int a_row(int m) const { return m; }
    __device__ int b_row(int n) const { return n; }
    __device__ void store(int m, int n, float a, float) const {
        int e, s0, nt; moe_tile(cnt, tile_lo + (m >> 8), e, s0, nt); const int slot = s0 + (m & 255);
        const float gt = slot < (int)cnt[64 * e] ? lgate[e * T + slot] : 0.f;
        O[(size_t)(tile_lo * 256 + m) * D + n] = f2bf(gt * a);
    }
};

__global__ void __launch_bounds__(256) k_mla_prep(const bf16_t* __restrict__ proj0, const float* __restrict__ qg, const float* __restrict__ kvg, const int* __restrict__ pos,
                                                  bf16_t* __restrict__ cqn, bf16_t* __restrict__ ckvn, bf16_t* __restrict__ krope) {
    const int tkn = blockIdx.x * 4 + (threadIdx.x >> 6), lane = threadIdx.x & 63;
    const bf16_t* pr = proj0 + (size_t)tkn * EVEN_INP;
    float q[6], s = 0.f;
#pragma unroll
    for (int j = 0; j < 6; ++j) { q[j] = bf2f(pr[P0_CQ + lane + 64 * j]); s += q[j] * q[j]; }
    float rs = rsqrtf(wave_sum(s) * (1.f / 384.f) + EPS);
#pragma unroll
    for (int j = 0; j < 6; ++j) cqn[(size_t)tkn * 384 + lane + 64 * j] = f2bf(q[j] * rs * qg[lane + 64 * j]);
    float c[4]; s = 0.f;
#pragma unroll
    for (int j = 0; j < 4; ++j) { c[j] = bf2f(pr[P0_CKV + lane + 64 * j]); s += c[j] * c[j]; }
    rs = rsqrtf(wave_sum(s) * (1.f / 256.f) + EPS);
#pragma unroll
    for (int j = 0; j < 4; ++j) ckvn[(size_t)tkn * 256 + lane + 64 * j] = f2bf(c[j] * rs * kvg[lane + 64 * j]);
    if (lane < 16) {
        const float p = (float)pos[tkn];
        const float inv = powf(10000.f, -(float)(2 * lane) / 32.f);
        const float ang = p * inv, cs = cosf(ang), sn = sinf(ang);
        const float t1 = bf2f(pr[P0_KR + lane]), t2 = bf2f(pr[P0_KR + 16 + lane]);
        krope[(size_t)tkn * 32 + lane] = f2bf(t1 * cs - t2 * sn);
        krope[(size_t)tkn * 32 + 16 + lane] = f2bf(t2 * cs + t1 * sn);
    }
}

__global__ void __launch_bounds__(64) k_swa(const bf16_t* __restrict__ proj0, const float* __restrict__ sinks, bf16_t* __restrict__ ymix) {
    const int idx = blockIdx.x * 64 + threadIdx.x;
    const int tkn = idx >> 3, h = idx & 7, hk = h >> 2;
    const int b = tkn / SEQ, s = tkn % SEQ, n = s / CHUNK, qi = s % CHUNK;
    const float slope = exp2f(-8.f * (float)(h + 1) / 8.f);
    float q[64], o[64];
#pragma unroll
    for (int d = 0; d < 64; ++d) { q[d] = bf2f(proj0[(size_t)tkn * EVEN_INP + P0_QA + h * 64 + d]); o[d] = 0.f; }
    const float sink = sinks[h];
    float m = sink, l = 1.f;
    const int k_lo = (n - 2) * CHUNK, k_hi = (n + 1) * CHUNK;
    for (int kp = (k_lo < 0 ? 0 : k_lo); kp < k_hi; ++kp) {
        const bf16_t* kr = proj0 + (size_t)(b * SEQ + kp) * EVEN_INP + P0_KA + hk * 64;
        float sc = 0.f;
#pragma unroll
        for (int d = 0; d < 64; ++d) sc += q[d] * bf2f(kr[d]);
        const int kk = kp - k_lo;
        const float dist = fabsf((float)(qi + 2 * CHUNK - kk));
        sc = sc * 0.125f - slope * dist;
        const float mn = fmaxf(m, sc), f = __expf(m - mn), p = __expf(sc - mn);
        l = l * f + p; m = mn;
        const bf16_t* vr = proj0 + (size_t)(b * SEQ + kp) * EVEN_INP + P0_VA + hk * 64;
#pragma unroll
        for (int d = 0; d < 64; ++d) o[d] = o[d] * f + p * bf2f(vr[d]);
    }
    const float il = 1.f / l;
#pragma unroll
    for (int d = 0; d < 64; ++d) ymix[(size_t)tkn * D + h * 64 + d] = f2bf(o[d] * il);
}

__global__ void __launch_bounds__(64) k_mla(const bf16_t* __restrict__ qm, const bf16_t* __restrict__ kvm, const bf16_t* __restrict__ krope, const int* __restrict__ pos, bf16_t* __restrict__ ymix) {
    const int idx = blockIdx.x * 64 + threadIdx.x;
    const int tkn = idx >> 3, h = idx & 7;
    const int b = tkn / SEQ, s = tkn % SEQ, c = s / CHUNK;
    float q[96], o[64];
#pragma unroll
    for (int d = 0; d < 96; ++d) q[d] = bf2f(qm[(size_t)tkn * 768 + h * 96 + d]);
    {
        const float p = (float)pos[tkn];
#pragma unroll
        for (int i = 0; i < 16; ++i) {
            const float inv = powf(10000.f, -(float)(2 * i) / 32.f), ang = p * inv, cs = cosf(ang), sn = sinf(ang);
            const float t1 = q[64 + i], t2 = q[80 + i];
            q[64 + i] = t1 * cs - t2 * sn; q[80 + i] = t2 * cs + t1 * sn;
        }
    }
#pragma unroll
    for (int d = 0; d < 64; ++d) o[d] = 0.f;
    const float scale = 0.10206207261596577f;
    float m = -1e30f, l = 0.f;
    const int nk = (c + 1) * CHUNK;
    for (int kp = 0; kp < nk; ++kp) {
        const bf16_t* kr = kvm + (size_t)(b * SEQ + kp) * 1024 + h * 128;
        const bf16_t* rr = krope + (size_t)(b * SEQ + kp) * 32;
        float sc = 0.f;
#pragma unroll
        for (int d = 0; d < 64; ++d) sc += q[d] * bf2f(kr[d]);
#pragma unroll
        for (int d = 0; d < 32; ++d) sc += q[64 + d] * bf2f(rr[d]);
        sc *= scale;
        const float mn = fmaxf(m, sc), f = __expf(m - mn), p = __expf(sc - mn);
        l = l * f + p; m = mn;
#pragma unroll
        for (int d = 0; d < 64; ++d) o[d] = o[d] * f + p * bf2f(kr[64 + d]);
    }
    const float il = 1.f / l;
#pragma unroll
    for (int d = 0; d < 64; ++d) ymix[(size_t)tkn * D + 512 + h * 64 + d] = f2bf(o[d] * il);
}

__global__ void __launch_bounds__(128) k_ret(const bf16_t* __restrict__ proj1, float* __restrict__ yr) {
    const int bh = blockIdx.x, b = bh >> 2, h = bh & 3, dv = threadIdx.x;
    const float g = 1.f - exp2f(-5.f - (float)h);
    const float ks = 0.08838834764831845f;
    float S[128];
#pragma unroll
    for (int d = 0; d < 128; ++d) S[d] = 0.f;
    __shared__ float qs[128], kss[128];
    for (int s = 0; s < SEQ; ++s) {
        const bf16_t* pr = proj1 + (size_t)(b * SEQ + s) * ODD_IN;
        __syncthreads();
        qs[dv] = bf2f(pr[P1_Q + h * 128 + dv]); kss[dv] = bf2f(pr[P1_K + h * 128 + dv]) * ks;
        __syncthreads();
        const float v = bf2f(pr[P1_V + h * 128 + dv]);
        float o = 0.f;
#pragma unroll
        for (int d = 0; d < 128; ++d) { S[d] = g * S[d] + kss[d] * v; o += qs[d] * S[d]; }
        yr[(size_t)(b * SEQ + s) * 512 + h * 128 + dv] = o;
    }
}
__global__ void __launch_bounds__(256) k_ret_gn(const float* __restrict__ yr, const bf16_t* __restrict__ proj1, const float* __restrict__ gn, bf16_t* __restrict__ ymix) {
    const int w = blockIdx.x * 4 + (threadIdx.x >> 6), lane = threadIdx.x & 63;
    const int tkn = w >> 2, h = w & 3;
    const float a = yr[(size_t)tkn * 512 + h * 128 + lane], c = yr[(size_t)tkn * 512 + h * 128 + 64 + lane];
    const float mu = wave_sum(a + c) * (1.f / 128.f);
    const float da = a - mu, dc = c - mu;
    const float var = wave_sum(da * da + dc * dc) * (1.f / 128.f);
    const float rs = rsqrtf(var + EPS);
    const float g0 = bf2f(proj1[(size_t)tkn * ODD_IN + P1_G + h * 128 + lane]), g1 = bf2f(proj1[(size_t)tkn * ODD_IN + P1_G + h * 128 + 64 + lane]);
    ymix[(size_t)tkn * D + h * 128 + lane] = f2bf(silu(g0) * da * rs * gn[h * 128 + lane]);
    ymix[(size_t)tkn * D + h * 128 + 64 + lane] = f2bf(silu(g1) * dc * rs * gn[h * 128 + 64 + lane]);
}
__global__ void __launch_bounds__(256) k_conv(const bf16_t* __restrict__ proj1, const float* __restrict__ w, bf16_t* __restrict__ ymix) {
    const size_t i = (size_t)blockIdx.x * 256 + threadIdx.x;
    const int tkn = (int)(i >> 9), c = (int)(i & 511), s = tkn % SEQ;
    float y = 0.f;
#pragma unroll
    for (int j = 0; j < 3; ++j) {
        const int sp = s - 2 + j;
        if (sp >= 0) { const bf16_t* pr = proj1 + (size_t)(tkn - 2 + j) * ODD_IN; y += w[j * 512 + c] * bf2f(pr[P1_C + c]) * bf2f(pr[P1_H + c]); }
    }
    ymix[(size_t)tkn * D + 512 + c] = f2bf(bf2f(proj1[(size_t)tkn * ODD_IN + P1_B + c]) * y);
}

__global__ void __launch_bounds__(512) k_route(const float* __restrict__ x, const float* __restrict__ g, const float* __restrict__ router, bf16_t* __restrict__ xnm,
                                               unsigned* __restrict__ ctl, unsigned char* __restrict__ tab) {
    __shared__ unsigned lcnt[NE], lbase[NE];
    __shared__ int se[64][2], ss[64][2]; __shared__ float sg[64][2];
    const int wave = threadIdx.x >> 6, lane = threadIdx.x & 63;
    if (threadIdx.x < NE) lcnt[threadIdx.x] = 0u;
    __syncthreads();
    for (int it = 0; it < 8; ++it) {
        const int lt = wave * 8 + it, tkn = blockIdx.x * 64 + lt;
        const float* xr = x + (size_t)tkn * D;
        float v[16]; float s = 0.f;
#pragma unroll
        for (int j = 0; j < 16; ++j) { v[j] = xr[lane + 64 * j]; s += v[j] * v[j]; }
        const float rs = rsqrtf(wave_sum(s) * (1.f / D) + EPS);
        float lg[NE];
#pragma unroll
        for (int e = 0; e < NE; ++e) lg[e] = 0.f;
#pragma unroll
        for (int j = 0; j < 16; ++j) {
            const float hv = v[j] * rs * g[lane + 64 * j];
            xnm[(size_t)tkn * D + lane + 64 * j] = f2bf(hv);
#pragma unroll
            for (int e = 0; e < NE; ++e) lg[e] += hv * router[(size_t)(lane + 64 * j) * NE + e];
        }
#pragma unroll
        for (int e = 0; e < NE; ++e) lg[e] = wave_sum(lg[e]);
        int e0 = 0; float v0 = lg[0];
#pragma unroll
        for (int e = 1; e < NE; ++e) if (lg[e] > v0) { v0 = lg[e]; e0 = e; }
        int e1 = -1; float v1 = -INFINITY;
#pragma unroll
        for (int e = 0; e < NE; ++e) if (e != e0 && lg[e] > v1) { v1 = lg[e]; e1 = e; }
        const float p1 = __expf(v1 - v0), g0 = 1.f / (1.f + p1), g1 = p1 / (1.f + p1);
        if (lane == 0) { se[lt][0] = e0; se[lt][1] = e1; sg[lt][0] = g0; sg[lt][1] = g1; ss[lt][0] = (int)atomicAdd(&lcnt[e0], 1u); ss[lt][1] = (int)atomicAdd(&lcnt[e1], 1u); }
    }
    __syncthreads();
    if (threadIdx.x < NE) lbase[threadIdx.x] = atomicAdd(&ctl[CW_CNT + 64 * threadIdx.x], lcnt[threadIdx.x]);
    __syncthreads();
    if (threadIdx.x < 64) {
        const int lt = threadIdx.x, tkn = blockIdx.x * 64 + lt;
        int* ltok = (int*)(tab + TAB_LTOK); float* lgate = (float*)(tab + TAB_LGATE); int* tsel = (int*)(tab + TAB_TSEL);
#pragma unroll
        for (int k = 0; k < 2; ++k) { const int e = se[lt][k], slot = (int)lbase[e] + ss[lt][k]; ltok[e * T + slot] = tkn; lgate[e * T + slot] = sg[lt][k]; tsel[tkn * 4 + 2 * k] = e; tsel[tkn * 4 + 2 * k + 1] = slot; }
    }
}

__global__ void __launch_bounds__(256) k_final(const float* x3, const bf16_t* __restrict__ yp0, const bf16_t* __restrict__ yp1, const unsigned* __restrict__ ctl,
                                               const unsigned char* __restrict__ tab, const float* __restrict__ g, float* out) {
    const int tkn = blockIdx.x * 4 + (threadIdx.x >> 6), lane = threadIdx.x & 63;
    const int* tsel = (const int*)(tab + TAB_TSEL);
    size_t row[2];
#pragma unroll
    for (int k = 0; k < 2; ++k) {
        const int e = tsel[tkn * 4 + 2 * k], slot = tsel[tkn * 4 + 2 * k + 1];
        int tb = 0;
        for (int i = 0; i < e; ++i) tb += ((int)ctl[CW_CNT + 64 * i] + 255) >> 8;
        row[k] = (size_t)tb * 256 + slot;
    }
    float v[16]; float s = 0.f;
#pragma unroll
    for (int j = 0; j < 16; ++j) {
        const int c = lane + 64 * j;
        v[j] = x3[(size_t)tkn * D + c] + bf2f(yp0[row[0] * D + c]) + bf2f(yp1[row[0] * D + c]) + bf2f(yp0[row[1] * D + c]) + bf2f(yp1[row[1] * D + c]);
        s += v[j] * v[j];
    }
    const float rs = rsqrtf(wave_sum(s) * (1.f / D) + EPS);
#pragma unroll
    for (int j = 0; j < 16; ++j) out[(size_t)tkn * D + lane + 64 * j] = v[j] * rs * g[lane + 64 * j];
}

template <class RM> static void wconv(const float* W, int K, int N, bf16_t* WT, RM rm, hipStream_t st) {
    hipLaunchKernelGGL((k_wconv<RM>), dim3((K / 32) * (N / 32)), dim3(256), 0, st, W, K, N, WT, rm);
}
template <bool DUAL, class Ctx> static void gemm(const bf16_t* A, int lda, const bf16_t* Bt, int ldb, int M, int N, int K, Ctx ctx, hipStream_t st) {
    GemmArgs g{A, Bt, lda, ldb, M, N, K, 0};
    hipLaunchKernelGGL((k_gemm<DUAL, Ctx>), dim3(N / 64, M / 64), dim3(256), 0, st, g, ctx);
}

extern "C" void kernel_launch(void* const* d_in, const int* in_sizes, int n_in, void* d_out, int out_size, void* d_ws, size_t ws_size, hipStream_t stream) {
    if (n_in != 25 || out_size != T * D || ws_size < WS_END) { fprintf(stderr, "kernel_launch: unexpected problem (n_in %d out %d ws %zu need %zu)\n", n_in, out_size, ws_size, (size_t)WS_END); return; }
    const float* x = (const float*)d_in[0]; const int* pos = (const int*)d_in[1];
    const float* e_norm_mix = (const float*)d_in[2]; const float* e_w_in = (const float*)d_in[3]; const float* e_sinks = (const float*)d_in[4];
    const float* e_q_norm = (const float*)d_in[5]; const float* e_w_uq = (const float*)d_in[6]; const float* e_kv_norm = (const float*)d_in[7]; const float* e_w_ukv = (const float*)d_in[8];
    const float* e_w_out = (const float*)d_in[9]; const float* e_norm_ffn = (const float*)d_in[10]; const float* e_w_gate = (const float*)d_in[11]; const float* e_w_up = (const float*)d_in[12];
    const float* e_w_down = (const float*)d_in[13]; const float* o_norm_mix = (const float*)d_in[14]; const float* o_w_in = (const float*)d_in[15]; const float* o_ret_gn = (const float*)d_in[16];
    const float* o_conv_w = (const float*)d_in[17]; const float* o_w_out = (const float*)d_in[18]; const float* o_norm_ffn = (const float*)d_in[19]; const float* o_router = (const float*)d_in[20];
    const float* o_we_gate = (const float*)d_in[21]; const float* o_we_up = (const float*)d_in[22]; const float* o_we_down = (const float*)d_in[23]; const float* final_norm = (const float*)d_in[24];
    unsigned char* ws = (unsigned char*)d_ws; float* out = (float*)d_out;
    unsigned* ctl = (unsigned*)(ws + WS_CTL);
    bf16_t* W_IN0 = (bf16_t*)(ws + WS_W_IN0); bf16_t* W_UQ = (bf16_t*)(ws + WS_W_UQ); bf16_t* W_UKV = (bf16_t*)(ws + WS_W_UKV); bf16_t* W_OUT0 = (bf16_t*)(ws + WS_W_OUT0);
    bf16_t* W_GU0 = (bf16_t*)(ws + WS_W_GU0); bf16_t* W_DN0 = (bf16_t*)(ws + WS_W_DN0); bf16_t* W_IN1 = (bf16_t*)(ws + WS_W_IN1); bf16_t* W_OUT1 = (bf16_t*)(ws + WS_W_OUT1);
    bf16_t* WE_GU = (bf16_t*)(ws + WS_WE_GU); bf16_t* WE_DN = (bf16_t*)(ws + WS_WE_DN);
    bf16_t* XN = (bf16_t*)(ws + WS_XN); bf16_t* YMIX = (bf16_t*)(ws + WS_YMIX); bf16_t* PROJ0 = (bf16_t*)(ws + WS_PROJ0); bf16_t* CQN = (bf16_t*)(ws + WS_CQN);
    bf16_t* CKVN = (bf16_t*)(ws + WS_CKVN); bf16_t* KROPE = (bf16_t*)(ws + WS_KROPE); bf16_t* QM = (bf16_t*)(ws + WS_QM); bf16_t* KVM = (bf16_t*)(ws + WS_KVM);
    bf16_t* ACT = (bf16_t*)(ws + WS_ACT); bf16_t* PROJ1 = (bf16_t*)(ws + WS_PROJ1); float* YR = (float*)(ws + WS_YR);
    bf16_t* ACTM = (bf16_t*)(ws + WS_ACTM); bf16_t* YP0 = (bf16_t*)(ws + WS_YP0); bf16_t* YP1 = (bf16_t*)(ws + WS_YP1); unsigned char* TAB = ws + WS_TAB; bf16_t* XNM = (bf16_t*)(ws + WS_XNM);

    (void)hipMemsetAsync(ws + WS_CTL, 0, 1 * MiB, stream);
    wconv(e_w_in, D, EVEN_IN, W_IN0, RowIdent{0}, stream);
    hipLaunchKernelGGL(k_fill_bf16, dim3(((EVEN_INP - EVEN_IN) * D + 255) / 256), dim3(256), 0, stream, W_IN0 + (size_t)EVEN_IN * D, (size_t)(EVEN_INP - EVEN_IN) * D, (bf16_t)0);
    wconv(e_w_uq, 384, 768, W_UQ, RowIdent{0}, stream);
    wconv(e_w_ukv, 256, 1024, W_UKV, RowIdent{0}, stream);
    wconv(e_w_out, D, D, W_OUT0, RowIdent{0}, stream);
    wconv(e_w_gate, D, FF, W_GU0, RowGU{0}, stream);
    wconv(e_w_up, D, FF, W_GU0, RowGU{1}, stream);
    wconv(e_w_down, FF, D, W_DN0, RowIdent{0}, stream);
    wconv(o_w_in, D, ODD_IN, W_IN1, RowIdent{0}, stream);
    wconv(o_w_out, D, D, W_OUT1, RowIdent{0}, stream);
    for (int e = 0; e < NE; ++e) {
        wconv(o_we_gate + (size_t)e * D * FF, D, FF, WE_GU + (size_t)e * 2 * FF * D, RowGU{0}, stream);
        wconv(o_we_up + (size_t)e * D * FF, D, FF, WE_GU + (size_t)e * 2 * FF * D, RowGU{1}, stream);
        wconv(o_we_down + (size_t)e * FF * D, FF, D, WE_DN + (size_t)e * D * FF, RowIdent{0}, stream);
    }
    hipLaunchKernelGGL(k_rmsnorm, dim3(T / 4), dim3(256), 0, stream, x, e_norm_mix, XN);
    gemm<false>(XN, D, W_IN0, D, T, EVEN_INP, D, CtxBf16{PROJ0, EVEN_INP, 0}, stream);
    hipLaunchKernelGGL(k_mla_prep, dim3(T / 4), dim3(256), 0, stream, PROJ0, e_q_norm, e_kv_norm, pos, CQN, CKVN, KROPE);
    gemm<false>(CQN, 384, W_UQ, 384, T, 768, 384, CtxBf16{QM, 768, 0}, stream);
    gemm<false>(CKVN, 256, W_UKV, 256, T, 1024, 256, CtxBf16{KVM, 1024, 0}, stream);
    hipLaunchKernelGGL(k_swa, dim3(T * 8 / 64), dim3(64), 0, stream, PROJ0, e_sinks, YMIX);
    hipLaunchKernelGGL(k_mla, dim3(T * 8 / 64), dim3(64), 0, stream, QM, KVM, KROPE, pos, YMIX);
    gemm<false>(YMIX, D, W_OUT0, D, T, D, D, CtxRes{x, out, D, 0}, stream);
    hipLaunchKernelGGL(k_rmsnorm, dim3(T / 4), dim3(256), 0, stream, out, e_norm_ffn, XN);
    gemm<true>(XN, D, W_GU0, D, T, FF, D, CtxSwiglu{ACT, FF, 0}, stream);
    gemm<false>(ACT, FF, W_DN0, FF, T, D, FF, CtxRes{out, out, D, 0}, stream);
    hipLaunchKernelGGL(k_rmsnorm, dim3(T / 4), dim3(256), 0, stream, out, o_norm_mix, XN);
    gemm<false>(XN, D, W_IN1, D, T, ODD_IN, D, CtxBf16{PROJ1, ODD_IN, 0}, stream);
    hipLaunchKernelGGL(k_ret, dim3(BATCH * 4), dim3(128), 0, stream, PROJ1, YR);
    hipLaunchKernelGGL(k_ret_gn, dim3(T * 4 / 4), dim3(256), 0, stream, YR, PROJ1, o_ret_gn, YMIX);
    hipLaunchKernelGGL(k_conv, dim3(T * 512 / 256), dim3(256), 0, stream, PROJ1, o_conv_w, YMIX);
    gemm<false>(YMIX, D, W_OUT1, D, T, D, D, CtxRes{out, out, D, 0}, stream);
    hipLaunchKernelGGL(k_route, dim3(T / 64), dim3(512), 0, stream, out, o_norm_ffn, o_router, XNM, ctl, TAB);
    const unsigned* cnt = ctl + CW_CNT; const int* ltok = (const int*)(TAB + TAB_LTOK); const float* lgate = (const float*)(TAB + TAB_LGATE);
    for (int half = 0; half < 2; ++half) {
        const int tlo = half * MOE_HALFT, thi = tlo + MOE_HALFT;
        gemm<true>(XNM, D, WE_GU, D, MOE_HALFT * 256, FF, D, CtxMoeGU{ACTM, cnt, ltok, FF, tlo, thi, 0}, stream);
        gemm<false>(ACTM, FF, WE_DN, FF, MOE_HALFT * 256, D, FF / 2, CtxMoeDn{YP0, cnt, lgate, tlo, thi}, stream);
        gemm<false>(ACTM + FF / 2, FF, WE_DN + FF / 2, FF, MOE_HALFT * 256, D, FF / 2, CtxMoeDn{YP1, cnt, lgate, tlo, thi}, stream);
    }
    hipLaunchKernelGGL(k_final, dim3(T / 4), dim3(256), 0, stream, out, YP0, YP1, ctl, TAB, final_norm, out);
}
```

```cpp
#include <hip/hip_runtime.h>
#include <cstdint>
#include <cstdio>
#include <cmath>

typedef unsigned short bf16_t;
constexpr int D = 1024, BATCH = 8, SEQ = 2048, T = BATCH * SEQ, CHUNK = 64;
constexpr int EVEN_IN = 1440, EVEN_INP = 1536, FF = 3584, ODD_IN = 3584, NE = 8;
constexpr float EPS = 1e-6f;
constexpr int P0_QA = 0, P0_KA = 512, P0_VA = 640, P0_CQ = 768, P0_CKV = 1152, P0_KR = 1408;
constexpr int P1_Q = 0, P1_K = 512, P1_V = 1024, P1_G = 1536, P1_B = 2048, P1_C = 2560, P1_H = 3072;

constexpr size_t MiB = 1u << 20;
constexpr size_t WS_CTL = 0;
constexpr size_t WS_W_IN0 = 1 * MiB;
constexpr size_t WS_W_UQ = WS_W_IN0 + (size_t)EVEN_INP * D * 2;
constexpr size_t WS_W_UKV = WS_W_UQ + (size_t)768 * 384 * 2;
constexpr size_t WS_W_OUT0 = WS_W_UKV + (size_t)1024 * 256 * 2;
constexpr size_t WS_W_GU0 = WS_W_OUT0 + (size_t)D * D * 2;
constexpr size_t WS_W_DN0 = WS_W_GU0 + (size_t)2 * FF * D * 2;
constexpr size_t WS_W_IN1 = WS_W_DN0 + (size_t)D * FF * 2;
constexpr size_t WS_W_OUT1 = WS_W_IN1 + (size_t)ODD_IN * D * 2;
constexpr size_t WS_WE_GU = 38 * MiB;
constexpr size_t WS_WE_DN = WS_WE_GU + (size_t)NE * 2 * FF * D * 2;
constexpr size_t WS_ACT0 = WS_WE_DN + (size_t)NE * D * FF * 2;
static_assert(WS_W_OUT1 + (size_t)D * D * 2 <= WS_WE_GU, "dense weights fit below 38 MiB");
static_assert(WS_ACT0 == 206 * MiB, "activation base");
constexpr size_t WS_XN = WS_ACT0;
constexpr size_t WS_YMIX = WS_ACT0 + 32 * MiB;
constexpr size_t WS_BIG = WS_ACT0 + 64 * MiB;
constexpr size_t WS_PROJ0 = WS_BIG;
constexpr size_t WS_CQN = WS_BIG + 48 * MiB;
constexpr size_t WS_CKVN = WS_BIG + 60 * MiB;
constexpr size_t WS_KROPE = WS_BIG + 68 * MiB;
constexpr size_t WS_QM = WS_BIG + 70 * MiB;
constexpr size_t WS_KVM = WS_BIG + 94 * MiB;
constexpr size_t WS_ACT = WS_BIG;
constexpr size_t WS_PROJ1 = WS_BIG;
constexpr size_t WS_RKV = WS_BIG + 112 * MiB;
constexpr size_t WS_YR = WS_BIG + 144 * MiB;
constexpr int MOE_MAXT = 136, MOE_HALFT = 68;
constexpr size_t WS_ACTM = WS_ACT0;
constexpr size_t WS_YP0 = WS_ACT0 + 119 * MiB;
constexpr size_t WS_YP1 = WS_YP0 + 68 * MiB;
constexpr size_t WS_TAB = WS_YP1 + 68 * MiB;
constexpr size_t WS_XNM = 1 * MiB;
constexpr size_t WS_END = WS_TAB + 2 * MiB;
static_assert(WS_END <= 471 * MiB, "workspace budget");
constexpr size_t TAB_LTOK = 0;
constexpr size_t TAB_LGATE = 512 * 1024;
constexpr size_t TAB_TSEL = 1024 * 1024;
constexpr size_t TAB_TGATE = 1280 * 1024;
constexpr int CW_CNT = 64;

__device__ __forceinline__ float bf2f(bf16_t v) { return __uint_as_float((unsigned)v << 16); }
__device__ __forceinline__ bf16_t f2bf(float f) { unsigned u = __float_as_uint(f); return (bf16_t)((u + 0x7fffu + ((u >> 16) & 1u)) >> 16); }
__device__ __forceinline__ float wave_sum(float v) {
#pragma unroll
    for (int o = 1; o < 64; o <<= 1) v += __shfl_xor(v, o);
    return v;
}
__device__ __forceinline__ float silu(float v) { return v / (1.f + __expf(-v)); }

struct RowIdent { int off; __device__ int operator()(int n) const { return off + n; } };
struct RowGU { int half; __device__ int operator()(int n) const { return 256 * (n >> 7) + 128 * half + (n & 127); } };
template <class RM>
__global__ void __launch_bounds__(256) k_wconv(const float* __restrict__ W, int K, int N, bf16_t* __restrict__ WT, RM rm) {
    __shared__ float tile[32][33];
    const int nb = N / 32, kb = blockIdx.x / nb, n0 = (blockIdx.x % nb) * 32, k0 = kb * 32;
    const int tx = threadIdx.x & 31, ty = threadIdx.x >> 5;
    for (int i = ty; i < 32; i += 8) tile[i][tx] = W[(size_t)(k0 + i) * N + n0 + tx];
    __syncthreads();
    for (int i = ty; i < 32; i += 8) WT[(size_t)rm(n0 + i) * K + k0 + tx] = f2bf(tile[tx][i]);
}
__global__ void k_fill_bf16(bf16_t* p, size_t n, bf16_t v) { size_t i = (size_t)blockIdx.x * blockDim.x + threadIdx.x; if (i < n) p[i] = v; }

__global__ void __launch_bounds__(256) k_rmsnorm(const float* __restrict__ x, const float* __restrict__ g, bf16_t* __restrict__ o) {
    const int row = blockIdx.x * 4 + (threadIdx.x >> 6), lane = threadIdx.x & 63;
    const float* xr = x + (size_t)row * D;
    float v[16]; float s = 0.f;
#pragma unroll
    for (int j = 0; j < 16; ++j) { v[j] = xr[lane + 64 * j]; s += v[j] * v[j]; }
    const float rs = rsqrtf(wave_sum(s) * (1.f / D) + EPS);
#pragma unroll
    for (int j = 0; j < 16; ++j) o[(size_t)row * D + lane + 64 * j] = f2bf(v[j] * rs * g[lane + 64 * j]);
}

struct GemmArgs { const bf16_t* A; const bf16_t* Bt; int lda, ldb, M, N, K, pad; };
template <bool DUAL, class Ctx>
__global__ void __launch_bounds__(256) k_gemm(GemmArgs g, Ctx ctx) {
    __shared__ float As[16][68], Bs[16][68], B2[16][68];
    const int m0 = blockIdx.y * 64, n0 = blockIdx.x * 64;
    if (!ctx.block_valid(m0)) return;
    const bf16_t* Bt = g.Bt + ctx.b_offset(m0);
    const int tx = threadIdx.x & 15, ty = threadIdx.x >> 4;
    float acc[4][4], acc2[4][4];
#pragma unroll
    for (int i = 0; i < 4; ++i)
#pragma unroll
        for (int j = 0; j < 4; ++j) { acc[i][j] = 0.f; acc2[i][j] = 0.f; }
    const int lr = threadIdx.x >> 2, lk = (threadIdx.x & 3) * 4;
    const size_t arow = (size_t)ctx.a_row(m0 + lr) * g.lda;
    const size_t brow = (size_t)ctx.b_row(n0 + lr) * g.ldb;
    for (int k0 = 0; k0 < g.K; k0 += 16) {
#pragma unroll
        for (int j = 0; j < 4; ++j) {
            As[lk + j][lr] = bf2f(g.A[arow + k0 + lk + j]);
            Bs[lk + j][lr] = bf2f(Bt[brow + k0 + lk + j]);
            if (DUAL) B2[lk + j][lr] = bf2f(Bt[brow + (size_t)128 * g.ldb + k0 + lk + j]);
        }
        __syncthreads();
#pragma unroll
        for (int kk = 0; kk < 16; ++kk) {
            float a[4], b[4], b2[4];
#pragma unroll
            for (int i = 0; i < 4; ++i) { a[i] = As[kk][ty * 4 + i]; b[i] = Bs[kk][tx * 4 + i]; b2[i] = DUAL ? B2[kk][tx * 4 + i] : 0.f; }
#pragma unroll
            for (int i = 0; i < 4; ++i)
#pragma unroll
                for (int j = 0; j < 4; ++j) { acc[i][j] += a[i] * b[j]; if (DUAL) acc2[i][j] += a[i] * b2[j]; }
        }
        __syncthreads();
    }
#pragma unroll
    for (int i = 0; i < 4; ++i)
#pragma unroll
        for (int j = 0; j < 4; ++j) ctx.store(m0 + ty * 4 + i, n0 + tx * 4 + j, acc[i][j], acc2[i][j]);
}
struct CtxBf16 {
    bf16_t* O; int ldc; int pad;
    __device__ bool block_valid(int) const { return true; }
    __device__ size_t b_offset(int) const { return 0; }
    __device__ int a_row(int m) const { return m; }
    __device__ int b_row(int n) const { return n; }
    __device__ void store(int m, int n, float a, float) const { O[(size_t)m * ldc + n] = f2bf(a); }
};
struct CtxRes {
    const float* base; float* out; int ldc; int pad;
    __device__ bool block_valid(int) const { return true; }
    __device__ size_t b_offset(int) const { return 0; }
    __device__ int a_row(int m) const { return m; }
    __device__ int b_row(int n) const { return n; }
    __device__ void store(int m, int n, float a, float) const { out[(size_t)m * ldc + n] = base[(size_t)m * ldc + n] + a; }
};
struct CtxSwiglu {
    bf16_t* O; int ldc; int pad;
    __device__ bool block_valid(int) const { return true; }
    __device__ size_t b_offset(int) const { return 0; }
    __device__ int a_row(int m) const { return m; }
    __device__ int b_row(int n) const { return 256 * (n >> 7) + (n & 127); }
    __device__ void store(int m, int n, float a, float b) const { O[(size_t)m * ldc + n] = f2bf(silu(a) * b); }
};
__device__ __forceinline__ void moe_tile(const unsigned* cnt, int tile, int& e, int& slot0, int& ntiles) {
    int tb = 0; e = -1; slot0 = 0;
#pragma unroll
    for (int i = 0; i < NE; ++i) { const int c = (int)cnt[64 * i], nt = (c + 255) >> 8; if (e < 0 && tile < tb + nt) { e = i; slot0 = (tile - tb) * 256; } tb += nt; }
    ntiles = tb;
}
struct CtxMoeGU {
    bf16_t* O; const unsigned* cnt; const int* ltok; int ldc, tile_lo, tile_hi, pad;
    __device__ bool block_valid(int m0) const { int e, s0, nt; const int t = tile_lo + (m0 >> 8); moe_tile(cnt, t, e, s0, nt); return t < tile_hi && t < nt && e >= 0; }
    __device__ size_t b_offset(int m0) const { int e, s0, nt; moe_tile(cnt, tile_lo + (m0 >> 8), e, s0, nt); return (size_t)e * 2 * FF * D; }
    __device__ int a_row(int m) const { int e, s0, nt; moe_tile(cnt, tile_lo + (m >> 8), e, s0, nt); const int slot = s0 + (m & 255); return slot < (int)cnt[64 * e] ? ltok[e * T + slot] : 0; }
    __device__ int b_row(int n) const { return 256 * (n >> 7) + (n & 127); }
    __device__ void store(int m, int n, float a, float b) const { O[(size_t)m * ldc + n] = f2bf(silu(a) * b); }
};
struct CtxMoeDn {
    bf16_t* O; const unsigned* cnt; const float* lgate; int tile_lo, tile_hi;
    __device__ bool block_valid(int m0) const { int e, s0, nt; const int t = tile_lo + (m0 >> 8); moe_tile(cnt, t, e, s0, nt); return t < tile_hi && t < nt && e >= 0; }
    __device__ size_t b_offset(int m0) const { int e, s0, nt; moe_tile(cnt, tile_lo + (m0 >> 8), e, s0, nt); return (size_t)e * D * FF; }
    __device__ int a_row(int m) const { return m; }
    __device__ int b_row(int n) const { return n; }
    __device__ void store(int m, int n, float a, float) const {
        int e, s0, nt; moe_tile(cnt, tile_lo + (m >> 8), e, s0, nt); const int slot = s0 + (m & 255);
        const float gt = slot < (int)cnt[64 * e] ? lgate[e * T + slot] : 0.f;
        O[(size_t)(tile_lo * 256 + m) * D + n] = f2bf(gt * a);
    }
};

__global__ void __launch_bounds__(256) k_mla_prep(const bf16_t* __restrict__ proj0, const float* __restrict__ qg, const float* __restrict__ kvg, const int* __restrict__ pos,
                                                  bf16_t* __restrict__ cqn, bf16_t* __restrict__ ckvn, bf16_t* __restrict__ krope) {
    const int tkn = blockIdx.x * 4 + (threadIdx.x >> 6), lane = threadIdx.x & 63;
    const bf16_t* pr = proj0 + (size_t)tkn * EVEN_INP;
    float q[6], s = 0.f;
#pragma unroll
    for (int j = 0; j < 6; ++j) { q[j] = bf2f(pr[P0_CQ + lane + 64 * j]); s += q[j] * q[j]; }
    float rs = rsqrtf(wave_sum(s) * (1.f / 384.f) + EPS);
#pragma unroll
    for (int j = 0; j < 6; ++j) cqn[(size_t)tkn * 384 + lane + 64 * j] = f2bf(q[j] * rs * qg[lane + 64 * j]);
    float c[4]; s = 0.f;
#pragma unroll
    for (int j = 0; j < 4; ++j) { c[j] = bf2f(pr[P0_CKV + lane + 64 * j]); s += c[j] * c[j]; }
    rs = rsqrtf(wave_sum(s) * (1.f / 256.f) + EPS);
#pragma unroll
    for (int j = 0; j < 4; ++j) ckvn[(size_t)tkn * 256 + lane + 64 * j] = f2bf(c[j] * rs * kvg[lane + 64 * j]);
    if (lane < 16) {
        const float p = (float)pos[tkn];
        const float inv = powf(10000.f, -(float)(2 * lane) / 32.f);
        const float ang = p * inv, cs = cosf(ang), sn = sinf(ang);
        const float t1 = bf2f(pr[P0_KR + lane]), t2 = bf2f(pr[P0_KR + 16 + lane]);
        krope[(size_t)tkn * 32 + lane] = f2bf(t1 * cs - t2 * sn);
        krope[(size_t)tkn * 32 + 16 + lane] = f2bf(t2 * cs + t1 * sn);
    }
}

__global__ void __launch_bounds__(64) k_swa(const bf16_t* __restrict__ proj0, const float* __restrict__ sinks, bf16_t* __restrict__ ymix) {
    const int idx = blockIdx.x * 64 + threadIdx.x;
    const int tkn = idx >> 3, h = idx & 7, hk = h >> 2;
    const int b = tkn / SEQ, s = tkn % SEQ, n = s / CHUNK, qi = s % CHUNK;
    const float slope = exp2f(-8.f * (float)(h + 1) / 8.f);
    float q[64], o[64];
#pragma unroll
    for (int d = 0; d < 64; ++d) { q[d] = bf2f(proj0[(size_t)tkn * EVEN_INP + P0_QA + h * 64 + d]); o[d] = 0.f; }
    const float sink = sinks[h];
    float m = sink, l = 1.f;
    const int k_lo = (n - 2) * CHUNK, k_hi = (n + 1) * CHUNK;
    for (int kp = (k_lo < 0 ? 0 : k_lo); kp < k_hi; ++kp) {
        const bf16_t* kr = proj0 + (size_t)(b * SEQ + kp) * EVEN_INP + P0_KA + hk * 64;
        float sc = 0.f;
#pragma unroll
        for (int d = 0; d < 64; ++d) sc += q[d] * bf2f(kr[d]);
        const int kk = kp - k_lo;
        const float dist = fabsf((float)(qi + 2 * CHUNK - kk));
        sc = sc * 0.125f - slope * dist;
        const float mn = fmaxf(m, sc), f = __expf(m - mn), p = __expf(sc - mn);
        l = l * f + p; m = mn;
        const bf16_t* vr = proj0 + (size_t)(b * SEQ + kp) * EVEN_INP + P0_VA + hk * 64;
#pragma unroll
        for (int d = 0; d < 64; ++d) o[d] = o[d] * f + p * bf2f(vr[d]);
    }
    const float il = 1.f / l;
#pragma unroll
    for (int d = 0; d < 64; ++d) ymix[(size_t)tkn * D + h * 64 + d] = f2bf(o[d] * il);
}

__global__ void __launch_bounds__(64) k_mla(const bf16_t* __restrict__ qm, const bf16_t* __restrict__ kvm, const bf16_t* __restrict__ krope, const int* __restrict__ pos, bf16_t* __restrict__ ymix) {
    const int idx = blockIdx.x * 64 + threadIdx.x;
    const int tkn = idx >> 3, h = idx & 7;
    const int b = tkn / SEQ, s = tkn % SEQ, c = s / CHUNK;
    float q[96], o[64];
#pragma unroll
    for (int d = 0; d < 96; ++d) q[d] = bf2f(qm[(size_t)tkn * 768 + h * 96 + d]);
    {
        const float p = (float)pos[tkn];
#pragma unroll
        for (int i = 0; i < 16; ++i) {
            const float inv = powf(10000.f, -(float)(2 * i) / 32.f), ang = p * inv, cs = cosf(ang), sn = sinf(ang);
            const float t1 = q[64 + i], t2 = q[80 + i];
            q[64 + i] = t1 * cs - t2 * sn; q[80 + i] = t2 * cs + t1 * sn;
        }
    }
#pragma unroll
    for (int d = 0; d < 64; ++d) o[d] = 0.f;
    const float scale = 0.10206207261596577f;
    float m = -1e30f, l = 0.f;
    const int nk = (c + 1) * CHUNK;
    for (int kp = 0; kp < nk; ++kp) {
        const bf16_t* kr = kvm + (size_t)(b * SEQ + kp) * 1024 + h * 128;
        const bf16_t* rr = krope + (size_t)(b * SEQ + kp) * 32;
        float sc = 0.f;
#pragma unroll
        for (int d = 0; d < 64; ++d) sc += q[d] * bf2f(kr[d]);
#pragma unroll
        for (int d = 0; d < 32; ++d) sc += q[64 + d] * bf2f(rr[d]);
        sc *= scale;
        const float mn = fmaxf(m, sc), f = __expf(m - mn), p = __expf(sc - mn);
        l = l * f + p; m = mn;
#pragma unroll
        for (int d = 0; d < 64; ++d) o[d] = o[d] * f + p * bf2f(kr[64 + d]);
    }
    const float il = 1.f / l;
#pragma unroll
    for (int d = 0; d < 64; ++d) ymix[(size_t)tkn * D + 512 + h * 64 + d] = f2bf(o[d] * il);
}

__global__ void __launch_bounds__(128) k_ret(const bf16_t* __restrict__ proj1, float* __restrict__ yr) {
    const int bh = blockIdx.x, b = bh >> 2, h = bh & 3, dv = threadIdx.x;
    const float g = 1.f - exp2f(-5.f - (float)h);
    const float ks = 0.08838834764831845f;
    float S[128];
#pragma unroll
    for (int d = 0; d < 128; ++d) S[d] = 0.f;
    __shared__ float qs[128], kss[128];
    for (int s = 0; s < SEQ; ++s) {
        const bf16_t* pr = proj1 + (size_t)(b * SEQ + s) * ODD_IN;
        __syncthreads();
        qs[dv] = bf2f(pr[P1_Q + h * 128 + dv]); kss[dv] = bf2f(pr[P1_K + h * 128 + dv]) * ks;
        __syncthreads();
        const float v = bf2f(pr[P1_V + h * 128 + dv]);
        float o = 0.f;
#pragma unroll
        for (int d = 0; d < 128; ++d) { S[d] = g * S[d] + kss[d] * v; o += qs[d] * S[d]; }
        yr[(size_t)(b * SEQ + s) * 512 + h * 128 + dv] = o;
    }
}
__global__ void __launch_bounds__(256) k_ret_gn(const float* __restrict__ yr, const bf16_t* __restrict__ proj1, const float* __restrict__ gn, bf16_t* __restrict__ ymix) {
    const int w = blockIdx.x * 4 + (threadIdx.x >> 6), lane = threadIdx.x & 63;
    const int tkn = w >> 2, h = w & 3;
    const float a = yr[(size_t)tkn * 512 + h * 128 + lane], c = yr[(size_t)tkn * 512 + h * 128 + 64 + lane];
    const float mu = wave_sum(a + c) * (1.f / 128.f);
    const float da = a - mu, dc = c - mu;
    const float var = wave_sum(da * da + dc * dc) * (1.f / 128.f);
    const float rs = rsqrtf(var + EPS);
    const float g0 = bf2f(proj1[(size_t)tkn * ODD_IN + P1_G + h * 128 + lane]), g1 = bf2f(proj1[(size_t)tkn * ODD_IN + P1_G + h * 128 + 64 + lane]);
    ymix[(size_t)tkn * D + h * 128 + lane] = f2bf(silu(g0) * da * rs * gn[h * 128 + lane]);
    ymix[(size_t)tkn * D + h * 128 + 64 + lane] = f2bf(silu(g1) * dc * rs * gn[h * 128 + 64 + lane]);
}
__global__ void __launch_bounds__(256) k_conv(const bf16_t* __restrict__ proj1, const float* __restrict__ w, bf16_t* __restrict__ ymix) {
    const size_t i = (size_t)blockIdx.x * 256 + threadIdx.x;
    const int tkn = (int)(i >> 9), c = (int)(i & 511), s = tkn % SEQ;
    float y = 0.f;
#pragma unroll
    for (int j = 0; j < 3; ++j) {
        const int sp = s - 2 + j;
        if (sp >= 0) { const bf16_t* pr = proj1 + (size_t)(tkn - 2 + j) * ODD_IN; y += w[j * 512 + c] * bf2f(pr[P1_C + c]) * bf2f(pr[P1_H + c]); }
    }
    ymix[(size_t)tkn * D + 512 + c] = f2bf(bf2f(proj1[(size_t)tkn * ODD_IN + P1_B + c]) * y);
}

__global__ void __launch_bounds__(512) k_route(const float* __restrict__ x, const float* __restrict__ g, const float* __restrict__ router, bf16_t* __restrict__ xnm,
                                               unsigned* __restrict__ ctl, unsigned char* __restrict__ tab) {
    __shared__ unsigned lcnt[NE], lbase[NE];
    __shared__ int se[64][2], ss[64][2]; __shared__ float sg[64][2];
    const int wave = threadIdx.x >> 6, lane = threadIdx.x & 63;
    if (threadIdx.x < NE) lcnt[threadIdx.x] = 0u;
    __syncthreads();
    for (int it = 0; it < 8; ++it) {
        const int lt = wave * 8 + it, tkn = blockIdx.x * 64 + lt;
        const float* xr = x + (size_t)tkn * D;
        float v[16]; float s = 0.f;
#pragma unroll
        for (int j = 0; j < 16; ++j) { v[j] = xr[lane + 64 * j]; s += v[j] * v[j]; }
        const float rs = rsqrtf(wave_sum(s) * (1.f / D) + EPS);
        float lg[NE];
#pragma unroll
        for (int e = 0; e < NE; ++e) lg[e] = 0.f;
#pragma unroll
        for (int j = 0; j < 16; ++j) {
            const float hv = v[j] * rs * g[lane + 64 * j];
            xnm[(size_t)tkn * D + lane + 64 * j] = f2bf(hv);
#pragma unroll
            for (int e = 0; e < NE; ++e) lg[e] += hv * router[(size_t)(lane + 64 * j) * NE + e];
        }
#pragma unroll
        for (int e = 0; e < NE; ++e) lg[e] = wave_sum(lg[e]);
        int e0 = 0; float v0 = lg[0];
#pragma unroll
        for (int e = 1; e < NE; ++e) if (lg[e] > v0) { v0 = lg[e]; e0 = e; }
        int e1 = -1; float v1 = -INFINITY;
#pragma unroll
        for (int e = 0; e < NE; ++e) if (e != e0 && lg[e] > v1) { v1 = lg[e]; e1 = e; }
        const float p1 = __expf(v1 - v0), g0 = 1.f / (1.f + p1), g1 = p1 / (1.f + p1);
        if (lane == 0) { se[lt][0] = e0; se[lt][1] = e1; sg[lt][0] = g0; sg[lt][1] = g1; ss[lt][0] = (int)atomicAdd(&lcnt[e0], 1u); ss[lt][1] = (int)atomicAdd(&lcnt[e1], 1u); }
    }
    __syncthreads();
    if (threadIdx.x < NE) lbase[threadIdx.x] = atomicAdd(&ctl[CW_CNT + 64 * threadIdx.x], lcnt[threadIdx.x]);
    __syncthreads();
    if (threadIdx.x < 64) {
        const int lt = threadIdx.x, tkn = blockIdx.x * 64 + lt;
        int* ltok = (int*)(tab + TAB_LTOK); float* lgate = (float*)(tab + TAB_LGATE); int* tsel = (int*)(tab + TAB_TSEL);
#pragma unroll
        for (int k = 0; k < 2; ++k) { const int e = se[lt][k], slot = (int)lbase[e] + ss[lt][k]; ltok[e * T + slot] = tkn; lgate[e * T + slot] = sg[lt][k]; tsel[tkn * 4 + 2 * k] = e; tsel[tkn * 4 + 2 * k + 1] = slot; }
    }
}

__global__ void __launch_bounds__(256) k_final(const float* x3, const bf16_t* __restrict__ yp0, const bf16_t* __restrict__ yp1, const unsigned* __restrict__ ctl,
                                               const unsigned char* __restrict__ tab, const float* __restrict__ g, float* out) {
    const int tkn = blockIdx.x * 4 + (threadIdx.x >> 6), lane = threadIdx.x & 63;
    const int* tsel = (const int*)(tab + TAB_TSEL);
    size_t row[2];
#pragma unroll
    for (int k = 0; k < 2; ++k) {
        const int e = tsel[tkn * 4 + 2 * k], slot = tsel[tkn * 4 + 2 * k + 1];
        int tb = 0;
        for (int i = 0; i < e; ++i) tb += ((int)ctl[CW_CNT + 64 * i] + 255) >> 8;
        row[k] = (size_t)tb * 256 + slot;
    }
    float v[16]; float s = 0.f;
#pragma unroll
    for (int j = 0; j < 16; ++j) {
        const int c = lane + 64 * j;
        v[j] = x3[(size_t)tkn * D + c] + bf2f(yp0[row[0] * D + c]) + bf2f(yp1[row[0] * D + c]) + bf2f(yp0[row[1] * D + c]) + bf2f(yp1[row[1] * D + c]);
        s += v[j] * v[j];
    }
    const float rs = rsqrtf(wave_sum(s) * (1.f / D) + EPS);
#pragma unroll
    for (int j = 0; j < 16; ++j) out[(size_t)tkn * D + lane + 64 * j] = v[j] * rs * g[lane + 64 * j];
}


namespace pg8 {
#define PG8_LAS __attribute__((address_space(3)))
typedef short bf16x8 __attribute__((ext_vector_type(8)));
typedef float f32x4 __attribute__((ext_vector_type(4)));
typedef unsigned u32x4 __attribute__((ext_vector_type(4)));
constexpr int BM = 256, BK = 64, HALF = 128, HTB = HALF * BK * 2  , STAGE_BYTES = 8 * HTB, NXCD = 8, WGM = 8;
__host__ __device__ __forceinline__ int lds_byte(int r, int c) { const int st = (r >> 4) * 2 + (c >> 5), rr = r & 15, cc = c & 31, ob = rr * 64 + cc * 2; return st * 1024 + (ob ^ (((ob >> 9) & 1) << 5)); }
__host__ __device__ __forceinline__ void stage_rc(int b, int& R, int& C) { const int st = b / 1024, sb = b % 1024, swz = sb ^ (((sb >> 9) & 1) << 5); R = (st >> 1) * 16 + swz / 64; C = (st & 1) * 32 + (swz % 64) / 2; }
__host__ __device__ __forceinline__ int perm32(int rho) { const int n = rho >> 4, i = rho & 15; return 8 * (i >> 2) + 4 * n + (i & 3); }

struct Unit { int pm, pn, be, s0, ko; };
struct Gemm { const bf16_t* A; const bf16_t* Bt; int lda, ldb, K; size_t bgroup; };

struct StaticOrder {
    int nM, nN, nwg, G, c;
    __device__ void init(int nM_, int nN_, int G_, int c_) { nM = nM_; nN = nN_; nwg = nM * nN; G = G_; c = c_; }
    __device__ bool next(int i, Unit& u) const {
        const long L = (long)i * G + c; if (L >= nwg) return false;
        int wgid = (int)L; { const int q = nwg / NXCD, r = nwg % NXCD, xcd = wgid % NXCD, off = wgid / NXCD; wgid = (xcd < r ? xcd * (q + 1) : r * (q + 1) + (xcd - r) * q) + off; }
        const int nig = WGM * nN, gid = wgid / nig, fm = gid * WGM, gsz = (nM - fm) < WGM ? (nM - fm) : WGM;
        u.pm = fm + ((wgid % nig) % gsz); u.pn = (wgid % nig) / gsz; u.be = 0; u.s0 = 0; u.ko = 0; return true;
    }
};
struct MoeOrder {
    StaticOrder so; int tlo, nNr, kper; unsigned tbp0, tbp1;
    __device__ void init(const unsigned* cnt, int tlo_, int thi_, int nN, int ksplit, int kper_, int G, int c) {
        int t = 0; tbp0 = 0u; tbp1 = 0u;
#pragma unroll
        for (int e = 0; e < NE; ++e) { if (e < 4) tbp0 |= (unsigned)t << (8 * e); else tbp1 |= (unsigned)t << (8 * (e - 4));
            t += ((int)__hip_atomic_load(cnt + 64 * e, __ATOMIC_RELAXED, __HIP_MEMORY_SCOPE_AGENT) + 255) >> 8; }
        tlo = tlo_; nNr = nN; kper = kper_; const int hi = thi_ < t ? thi_ : t; so.init(hi > tlo_ ? hi - tlo_ : 0, nN * ksplit, G, c);
    }
    __device__ bool next(int i, Unit& u) const {
        if (!so.next(i, u)) return false;
        const int tile = tlo + u.pm; int e = 0, tbe = 0;
#pragma unroll
        for (int k = 1; k < NE; ++k) { const int tk = (int)(((k < 4 ? tbp0 : tbp1) >> (8 * (k & 3))) & 0xffu); if (tile >= tk) { e = k; tbe = tk; } }
        u.be = e; u.s0 = (tile - tbe) * 256; const int kh = u.pn / nNr; u.pn -= kh * nNr; u.ko = kh * kper; return true;
    }
};
struct ARowIdent {
    __device__ __forceinline__ unsigned direct(const Unit& u, int r) const { return (unsigned)(u.pm * BM + r); }
    __device__ __forceinline__ void prefetch(const Unit&, PG8_LAS unsigned*) const {}
    __device__ __forceinline__ unsigned get(const Unit& u, int r, const PG8_LAS unsigned*) const { return (unsigned)(u.pm * BM + r); }
};
struct ARowMoe {
    const int* ltok; const unsigned* cnt;
    __device__ __forceinline__ unsigned direct(const Unit& u, int r) const {
        const int slot = u.s0 + r, n = (int)__hip_atomic_load(cnt + 64 * u.be, __ATOMIC_RELAXED, __HIP_MEMORY_SCOPE_AGENT);
        return slot < n ? (unsigned)ltok[u.be * T + slot] : 0u;
    }
    __device__ __forceinline__ void prefetch(const Unit& u, PG8_LAS unsigned* tab) const { if (threadIdx.x < BM) tab[threadIdx.x] = direct(u, (int)threadIdx.x); }
    __device__ __forceinline__ unsigned get(const Unit&, int r, const PG8_LAS unsigned* tab) const { return tab[r]; }
};

__device__ __forceinline__ unsigned cvt_pk_bf16(float lo, float hi) { unsigned r; asm volatile("v_cvt_pk_bf16_f32 %0, %1, %2" : "=v"(r) : "v"(lo), "v"(hi)); return r; }
struct EpiBf16 {
    static constexpr bool PERM = true;
    bf16_t* O; int ldc;
    __device__ __forceinline__ void operator()(const f32x4 (&acc)[2][2][4][2], const Unit& u, int wr, int wc, int fr, int fq) const {
        const int row0 = u.pm * BM + wr * 64 + fr, col0 = u.pn * BM + wc * 32 + 8 * fq;
#pragma unroll
        for (int ai = 0; ai < 2; ++ai)
#pragma unroll
            for (int m = 0; m < 4; ++m) { bf16_t* rowp = O + (size_t)(row0 + ai * HALF + m * 16) * ldc + col0;
#pragma unroll
                for (int bj = 0; bj < 2; ++bj) { const f32x4 v0 = acc[ai][bj][m][0], v1 = acc[ai][bj][m][1];
                    u32x4 w; w.x = cvt_pk_bf16(v0[0], v0[1]); w.y = cvt_pk_bf16(v0[2], v0[3]); w.z = cvt_pk_bf16(v1[0], v1[1]); w.w = cvt_pk_bf16(v1[2], v1[3]);
                    *(u32x4*)(rowp + bj * HALF) = w; } }
    }
};
struct EpiRes {
    static constexpr bool PERM = false;
    const float* base; float* out; int ldc;
    __device__ __forceinline__ void operator()(const f32x4 (&acc)[2][2][4][2], const Unit& u, int wr, int wc, int fr, int fq) const {
        const int row0 = u.pm * BM + wr * 64 + fr, col0 = u.pn * BM + wc * 32 + 4 * fq;
#pragma unroll
        for (int ai = 0; ai < 2; ++ai) {
            f32x4 b[4][2][2];
#pragma unroll
            for (int m = 0; m < 4; ++m) { const size_t off = (size_t)(row0 + ai * HALF + m * 16) * ldc + col0;
#pragma unroll
                for (int bj = 0; bj < 2; ++bj)
#pragma unroll
                    for (int n = 0; n < 2; ++n) b[m][bj][n] = *(const f32x4*)(base + off + bj * HALF + n * 16); }
            asm volatile("" ::: "memory");
#pragma unroll
            for (int m = 0; m < 4; ++m) { const size_t off = (size_t)(row0 + ai * HALF + m * 16) * ldc + col0;
#pragma unroll
                for (int bj = 0; bj < 2; ++bj)
#pragma unroll
                    for (int n = 0; n < 2; ++n) *(f32x4*)(out + off + bj * HALF + n * 16) = b[m][bj][n] + acc[ai][bj][m][n]; }
            asm volatile("" ::: "memory");
        }
    }
};
__device__ __forceinline__ float silu_f(float v) { return v * __builtin_amdgcn_rcpf(1.f + __expf(-v)); }
struct EpiSwiglu {
    static constexpr bool PERM = true;
    bf16_t* O; int ldc;
    __device__ __forceinline__ void operator()(const f32x4 (&acc)[2][2][4][2], const Unit& u, int wr, int wc, int fr, int fq) const {
        const int row0 = u.pm * BM + wr * 64 + fr, col0 = u.pn * HALF + wc * 32 + 8 * fq;
#pragma unroll
        for (int ai = 0; ai < 2; ++ai)
#pragma unroll
            for (int m = 0; m < 4; ++m) { bf16_t* rowp = O + (size_t)(row0 + ai * HALF + m * 16) * ldc + col0;
                const f32x4 g0 = acc[ai][0][m][0], g1 = acc[ai][0][m][1], u0 = acc[ai][1][m][0], u1 = acc[ai][1][m][1];
                u32x4 w; w.x = cvt_pk_bf16(silu_f(g0[0]) * u0[0], silu_f(g0[1]) * u0[1]); w.y = cvt_pk_bf16(silu_f(g0[2]) * u0[2], silu_f(g0[3]) * u0[3]);
                w.z = cvt_pk_bf16(silu_f(g1[0]) * u1[0], silu_f(g1[1]) * u1[1]); w.w = cvt_pk_bf16(silu_f(g1[2]) * u1[2], silu_f(g1[3]) * u1[3]);
                *(u32x4*)rowp = w; }
    }
};
struct EpiMoeDn {
    static constexpr bool PERM = true;
    bf16_t* O0; bf16_t* O1; const float* lgate; const unsigned* cnt; int tlo;
    __device__ __forceinline__ void operator()(const f32x4 (&acc)[2][2][4][2], const Unit& u, int wr, int wc, int fr, int fq) const {
        const int r0 = wr * 64 + fr, col0 = u.pn * BM + wc * 32 + 8 * fq;
        const int n = (int)__hip_atomic_load(cnt + 64 * u.be, __ATOMIC_RELAXED, __HIP_MEMORY_SCOPE_AGENT);
#pragma unroll
        for (int ai = 0; ai < 2; ++ai)
#pragma unroll
            for (int m = 0; m < 4; ++m) { const int r = r0 + ai * HALF + m * 16, slot = u.s0 + r; const float gt = slot < n ? lgate[u.be * T + slot] : 0.f;
                bf16_t* rowp = (u.ko ? O1 : O0) + (size_t)((tlo + u.pm) * BM + r) * D + col0;
#pragma unroll
                for (int bj = 0; bj < 2; ++bj) { const f32x4 v0 = acc[ai][bj][m][0] * gt, v1 = acc[ai][bj][m][1] * gt;
                    u32x4 w; w.x = cvt_pk_bf16(v0[0], v0[1]); w.y = cvt_pk_bf16(v0[2], v0[3]); w.z = cvt_pk_bf16(v1[0], v1[1]); w.w = cvt_pk_bf16(v1[2], v1[3]);
                    *(u32x4*)(rowp + bj * HALF) = w; } }
    }
};

template <class Epi, class Sched, class ARow, bool ALIGN_EPI>
__device__ __forceinline__ void gemm_phase(PG8_LAS unsigned char* lds, PG8_LAS unsigned* rowtab, const Gemm g, const Sched& S, const ARow& AR, const Epi& E) {
    const int tid = threadIdx.x, wid = __builtin_amdgcn_readfirstlane(tid >> 6), lane = tid & 63, wr = wid >> 2, wc = wid & 3, fr = lane & 15, fq = lane >> 4;
    const int nt = g.K / BK;
    int Rr[2]; unsigned Cb[2], voffB[2];
#pragma unroll
    for (int i = 0; i < 2; ++i) { int R, C; stage_rc(tid * 16 + i * 8192, R, C); const int Rb = Epi::PERM ? ((R & ~31) + perm32(R & 31)) : R;
        Rr[i] = R; Cb[i] = (unsigned)C * 2u; voffB[i] = (unsigned)(Rb * g.ldb + C) * 2u; }
    const size_t kstep = (size_t)(BK * 2);
    const size_t hstepB = (size_t)HALF * g.ldb * 2;
    const unsigned lda2 = (unsigned)g.lda * 2u;
    const unsigned ldsw = (unsigned)wid * 1024u;
    const int aoff = lds_byte(wr * 64 + fr, fq * 8), boff = lds_byte(wc * 32 + fr, fq * 8);
#define PG8_SA(b, h) (((b) * 2 + (h)) * HTB)
#define PG8_SB(b, h) ((4 + (b) * 2 + (h)) * HTB)
#define PG8_STAGE(bufoff, gbase, voff) do { _Pragma("unroll") for (int _i = 0; _i < 2; ++_i) \
        __builtin_amdgcn_global_load_lds((const unsigned*)((const char*)(gbase) + (voff)[_i]), (PG8_LAS unsigned*)(lds + (bufoff) + ldsw + _i * 8192), 16, 0, 0); } while (0)
#define PG8_LDA(dst, b, h) do { _Pragma("unroll") for (int m = 0; m < 4; ++m) _Pragma("unroll") for (int k = 0; k < 2; ++k) dst[m][k] = *(const PG8_LAS bf16x8*)(lds + PG8_SA(b, h) + aoff + m * 2048 + k * 1024); } while (0)
#define PG8_LDB(dst, b, h) do { _Pragma("unroll") for (int n = 0; n < 2; ++n) _Pragma("unroll") for (int k = 0; k < 2; ++k) dst[n][k] = *(const PG8_LAS bf16x8*)(lds + PG8_SB(b, h) + boff + n * 2048 + k * 1024); } while (0)
#define PG8_MMA(ai, bj, At, Bt) do { __builtin_amdgcn_s_setprio(1); _Pragma("unroll") for (int m = 0; m < 4; ++m) _Pragma("unroll") for (int n = 0; n < 2; ++n) _Pragma("unroll") for (int k = 0; k < 2; ++k) \
        acc[ai][bj][m][n] = __builtin_amdgcn_mfma_f32_16x16x32_bf16(Bt[n][k], At[m][k], acc[ai][bj][m][n], 0, 0, 0); __builtin_amdgcn_s_setprio(0); } while (0)
#define PG8_WAIT_V(n) asm volatile("s_waitcnt vmcnt(" #n ")" ::: "memory")
#define PG8_WAIT_L(n) asm volatile("s_waitcnt lgkmcnt(" #n ")" ::: "memory")
#define PG8_BAR __builtin_amdgcn_s_barrier()
#define PG8_SCHED __builtin_amdgcn_sched_barrier(0)
    Unit cur, nxt; int ui = 0;
    if (!S.next(0, cur)) return;
    f32x4 acc[2][2][4][2];
#pragma unroll
    for (int a = 0; a < 2; ++a)
#pragma unroll
        for (int b = 0; b < 2; ++b)
#pragma unroll
            for (int m = 0; m < 4; ++m)
#pragma unroll
                for (int n = 0; n < 2; ++n) acc[a][b][m][n] = (f32x4){0.f, 0.f, 0.f, 0.f};
    bf16x8 At[4][2], B0[2][2], B1[2][2];
    unsigned offC[2][2];
#pragma unroll
    for (int h = 0; h < 2; ++h)
#pragma unroll
        for (int i = 0; i < 2; ++i) offC[h][i] = AR.direct(cur, h * HALF + Rr[i]) * lda2 + Cb[i];
    const char* cA = (const char*)g.A + (size_t)cur.ko * 2;
    const char* cB = (const char*)g.Bt + ((size_t)cur.be * g.bgroup + (size_t)cur.pn * BM * g.ldb + cur.ko) * 2;
    PG8_STAGE(PG8_SB(0, 0), cB, voffB); PG8_STAGE(PG8_SB(0, 1), cB + hstepB, voffB); PG8_STAGE(PG8_SA(0, 0), cA, offC[0]); PG8_STAGE(PG8_SA(0, 1), cA, offC[1]);
    if (wr == 1) PG8_BAR;
    PG8_WAIT_V(2); PG8_BAR;
    PG8_STAGE(PG8_SB(1, 0), cB + kstep, voffB); PG8_STAGE(PG8_SA(1, 0), cA + kstep, offC[0]); PG8_STAGE(PG8_SB(1, 1), cB + hstepB + kstep, voffB);
    PG8_WAIT_V(6); PG8_BAR;
    for (;;) {
        const bool has_next = S.next(ui + 1, nxt);
        if (has_next) AR.prefetch(nxt, rowtab);
        const char* nA = has_next ? (const char*)g.A + (size_t)nxt.ko * 2 : cA;
        const char* nB = has_next ? (const char*)g.Bt + ((size_t)nxt.be * g.bgroup + (size_t)nxt.pn * BM * g.ldb + nxt.ko) * 2 : cB;
        for (int t = 0; t < nt; t += 2) {
            const bool last = (t == nt - 2);
            const char* a1 = cA + (size_t)(t + 1) * kstep;
            const char* a2 = last ? nA : cA + (size_t)(t + 2) * kstep; const char* b2 = last ? nB : cB + (size_t)(t + 2) * kstep;
            const char* a3 = a2 + kstep; const char* b3 = b2 + kstep;
            PG8_LDB(B0, 0, 0); PG8_LDB(B1, 0, 1); PG8_SCHED; PG8_LDA(At, 0, 0); PG8_STAGE(PG8_SA(1, 1), a1, offC[1]);
            if (last && has_next) {
#pragma unroll
                for (int h = 0; h < 2; ++h)
#pragma unroll
                    for (int i = 0; i < 2; ++i) offC[h][i] = AR.get(nxt, h * HALF + Rr[i], rowtab) * lda2 + Cb[i]; }
            PG8_WAIT_V(8); PG8_WAIT_L(0); PG8_BAR; PG8_MMA(0, 0, At, B0); PG8_MMA(0, 1, At, B1); PG8_BAR; PG8_SCHED;
            PG8_LDA(At, 0, 1); PG8_STAGE(PG8_SB(0, 0), b2, voffB); PG8_STAGE(PG8_SB(0, 1), b2 + hstepB, voffB); PG8_STAGE(PG8_SA(0, 0), a2, offC[0]);
            PG8_WAIT_V(8); PG8_WAIT_L(0); PG8_BAR; PG8_MMA(1, 0, At, B0); PG8_MMA(1, 1, At, B1); PG8_BAR; PG8_SCHED;
            PG8_LDB(B0, 1, 0); PG8_LDB(B1, 1, 1); PG8_SCHED; PG8_LDA(At, 1, 0); PG8_STAGE(PG8_SA(0, 1), a2, offC[1]);
            PG8_WAIT_V(8); PG8_WAIT_L(0); PG8_BAR; PG8_MMA(0, 0, At, B0); PG8_MMA(0, 1, At, B1); PG8_BAR; PG8_SCHED;
            PG8_LDA(At, 1, 1); PG8_STAGE(PG8_SB(1, 0), b3, voffB); PG8_STAGE(PG8_SB(1, 1), b3 + hstepB, voffB); PG8_STAGE(PG8_SA(1, 0), a3, offC[0]);
            PG8_WAIT_V(8); PG8_WAIT_L(0); PG8_BAR; PG8_MMA(1, 0, At, B0); PG8_MMA(1, 1, At, B1); PG8_BAR; PG8_SCHED;
        }
        if constexpr (ALIGN_EPI) { if (wr == 0) PG8_BAR; }
        E(acc, cur, wr, wc, fr, fq);
        if (!has_next) break;
#pragma unroll
        for (int a = 0; a < 2; ++a)
#pragma unroll
            for (int b = 0; b < 2; ++b)
#pragma unroll
                for (int m = 0; m < 4; ++m)
#pragma unroll
                    for (int n = 0; n < 2; ++n) acc[a][b][m][n] = (f32x4){0.f, 0.f, 0.f, 0.f};
        cur = nxt; cA = nA; cB = nB; ++ui;
        if constexpr (ALIGN_EPI) { if (wr == 1) PG8_BAR; }
    }
    PG8_WAIT_V(0);
    if constexpr (!ALIGN_EPI) { if (wr == 0) PG8_BAR; }
    PG8_BAR;
#undef PG8_SA
#undef PG8_SB
#undef PG8_STAGE
#undef PG8_LDA
#undef PG8_LDB
#undef PG8_MMA
#undef PG8_WAIT_V
#undef PG8_WAIT_L
#undef PG8_BAR
#undef PG8_SCHED
}
}

#define LAS __attribute__((address_space(3)))
#define GAS __attribute__((address_space(1)))
typedef unsigned v4u __attribute__((ext_vector_type(4)));
#define LDS_WAIT() asm volatile("s_waitcnt lgkmcnt(0)" ::: "memory")
__device__ __forceinline__ unsigned pk2(float lo, float hi) { return (unsigned)f2bf(lo) | ((unsigned)f2bf(hi) << 16); }
constexpr int NWAVES = 8, LDS_BYTES = 147456, RING_BYTES = 131072, MISC_OFF = RING_BYTES + 320, ROWTAB_OFF = RING_BYTES + 1024;
constexpr int CW_BAR = 4096;

#define XB_TMO      128
#define XB_XCNT(j)  (256  + 64 * (j))
#define XB_XSUB(j)  (1280 + 64 * (j))
#define XB_XGEN(j)  (2304 + 64 * (j))
#define XB_TOP      3328
#define XB_TOPGEN   3392
#define XCD_BAR_WORDS 3456
#define XB_SPIN_CAP (1u << 18)
__device__ __forceinline__ unsigned xb_ld(unsigned* p)              { return __hip_atomic_load(p, __ATOMIC_RELAXED, __HIP_MEMORY_SCOPE_AGENT); }
__device__ __forceinline__ unsigned xb_add(unsigned* p, unsigned v) { return __hip_atomic_fetch_add(p, v, __ATOMIC_RELAXED, __HIP_MEMORY_SCOPE_AGENT); }
__device__ __forceinline__ unsigned xb_xcc_id() { return (unsigned)__builtin_amdgcn_s_getreg((3 << 11) | 20) & 0xFu; }
#define XB_SPIN(cond, bar) do { unsigned _sp = 0; while (cond) { __builtin_amdgcn_s_sleep(1); \
    if ((++_sp & 255u) == 0u) { if (xb_ld(&(bar)[XB_TMO])) break; if (_sp > XB_SPIN_CAP) { atomicAdd(&(bar)[XB_TMO], 1u); break; } } } } while (0)
struct XcdBarrier {
    unsigned* bar; unsigned x;
    volatile LAS unsigned* st;
};
__device__ __forceinline__ XcdBarrier xcd_barrier_post(unsigned* bar, volatile LAS unsigned* st) {
    XcdBarrier b; b.bar = bar; b.x = xb_xcc_id(); b.st = st;
    if (threadIdx.x == 0) (void)xb_add(&bar[XB_XCNT(b.x)], 1u);
    return b;
}
__device__ __forceinline__ void xcd_barrier_complete(unsigned* bar, unsigned x, unsigned& nloc, unsigned& nx) {
    const unsigned G = gridDim.x * gridDim.y * gridDim.z;
    unsigned sum, cnt, mine, sp = 0u;
    for (;;) {
        sum = 0u; cnt = 0u; mine = 0u;
#pragma unroll
        for (unsigned j = 0; j < 16; ++j) { const unsigned c = xb_ld(&bar[XB_XCNT(j)]); sum += c; cnt += (c > 0u) ? 1u : 0u; mine = (j == x) ? c : mine; }
        if (sum == G) break;
        __builtin_amdgcn_s_sleep(1);
        if ((++sp & 255u) == 0u) { if (xb_ld(&bar[XB_TMO])) break; if (sp > XB_SPIN_CAP) { atomicAdd(&bar[XB_TMO], 1u); break; } }
    }
    nloc = mine > 0u ? mine : 1u; nx = cnt > 0u ? cnt : 1u;
}
__device__ __forceinline__ void xcd_barrier(const XcdBarrier& b) {
    asm volatile("s_waitcnt vmcnt(0)" ::: "memory");
    __syncthreads();
    if (threadIdx.x == 0) {
        unsigned* bar = b.bar;
        __builtin_amdgcn_s_waitcnt(0);
        unsigned nloc = b.st[0], nx = b.st[1];
        if (nloc == 0u) { xcd_barrier_complete(bar, b.x, nloc, nx); b.st[0] = nloc; b.st[1] = nx; }
        const unsigned old = xb_add(&bar[XB_XSUB(b.x)], 1u);
        const unsigned gen = old / nloc;
        if (old + 1u == (gen + 1u) * nloc) {
            __builtin_amdgcn_fence(__ATOMIC_RELEASE, "agent");
            asm volatile("s_waitcnt vmcnt(0)" ::: "memory");
            const unsigned og = xb_add(&bar[XB_TOP], 1u);
            const unsigned tg = og / nx;
            if (og + 1u == (tg + 1u) * nx) xb_add(&bar[XB_TOPGEN], 1u);
            else XB_SPIN(xb_ld(&bar[XB_TOPGEN]) == tg, bar);
            __builtin_amdgcn_fence(__ATOMIC_ACQUIRE, "agent");
            xb_add(&bar[XB_XGEN(b.x)], 1u);
            asm volatile("s_waitcnt vmcnt(0)" ::: "memory");
        } else {
            XB_SPIN(xb_ld(&bar[XB_XGEN(b.x)]) == gen, bar);
            __builtin_amdgcn_fence(__ATOMIC_ACQUIRE, "agent");
            asm volatile("s_waitcnt vmcnt(0)" ::: "memory");
        }
    }
    __syncthreads();
}

template <class RM>
__device__ __forceinline__ void p0_item(const float* W, int K, int N, bf16_t* WT, RM rm, LAS float* scr, int item, int lane) {
    const int nblk = N / 32, kb = item / nblk, nb = item % nblk, k0 = 64 * kb, n0 = 32 * nb;
#pragma unroll 8
    for (int i = 0; i < 32; ++i) { const int kk = 2 * i + (lane >> 5); scr[kk * 33 + (lane & 31)] = W[(size_t)(k0 + kk) * N + n0 + (lane & 31)]; }
    LDS_WAIT(); asm volatile("" ::: "memory");
    const int c = lane & 7;
#pragma unroll
    for (int j = 0; j < 4; ++j) { const int n = (lane >> 3) + 8 * j; const LAS float* sp = scr + (8 * c) * 33 + n;
        v4u o; o.x = pk2(sp[0 * 33], sp[1 * 33]); o.y = pk2(sp[2 * 33], sp[3 * 33]); o.z = pk2(sp[4 * 33], sp[5 * 33]); o.w = pk2(sp[6 * 33], sp[7 * 33]);
        *(v4u*)(WT + (size_t)rm(n0 + n) * K + k0 + 8 * c) = o; }
    LDS_WAIT(); asm volatile("" ::: "memory");
}
__device__ __forceinline__ void norm_rows(const float* x, const float* g, bf16_t* o, int gw, int NGW, int lane) {
    typedef float f32x4 __attribute__((ext_vector_type(4)));
    f32x4 gv[4];
#pragma unroll
    for (int j = 0; j < 4; ++j) gv[j] = *((const f32x4*)g + lane + 64 * j);
    for (int m = gw; m < T; m += NGW) {
        const f32x4* xr = (const f32x4*)(x + (size_t)m * D) + lane;
        f32x4 v[4]; float s = 0.f;
#pragma unroll
        for (int j = 0; j < 4; ++j) { v[j] = xr[64 * j]; s += (v[j].x * v[j].x + v[j].y * v[j].y) + (v[j].z * v[j].z + v[j].w * v[j].w); }
        const float rs = rsqrtf(wave_sum(s) * (1.f / D) + EPS);
        unsigned long long* o8 = (unsigned long long*)(o + (size_t)m * D) + lane;
#pragma unroll
        for (int j = 0; j < 4; ++j) o8[64 * j] = (unsigned long long)pk2(v[j].x * rs * gv[j].x, v[j].y * rs * gv[j].y) | ((unsigned long long)pk2(v[j].z * rs * gv[j].z, v[j].w * rs * gv[j].w) << 32);
    }
}
__device__ __forceinline__ void mla_prep_rows(const bf16_t* proj0, const float* qg, const float* kvg, const int* pos, bf16_t* cqn, bf16_t* ckvn, bf16_t* krope, int gw, int NGW, int lane) {
    for (int tkn = gw; tkn < T; tkn += NGW) {
        const bf16_t* pr = proj0 + (size_t)tkn * EVEN_INP;
        float q[6], s = 0.f;
#pragma unroll
        for (int j = 0; j < 6; ++j) { q[j] = bf2f(pr[P0_CQ + lane + 64 * j]); s += q[j] * q[j]; }
        float rs = rsqrtf(wave_sum(s) * (1.f / 384.f) + EPS);
#pragma unroll
        for (int j = 0; j < 6; ++j) cqn[(size_t)tkn * 384 + lane + 64 * j] = f2bf(q[j] * rs * qg[lane + 64 * j]);
        float c[4]; s = 0.f;
#pragma unroll
        for (int j = 0; j < 4; ++j) { c[j] = bf2f(pr[P0_CKV + lane + 64 * j]); s += c[j] * c[j]; }
        rs = rsqrtf(wave_sum(s) * (1.f / 256.f) + EPS);
#pragma unroll
        for (int j = 0; j < 4; ++j) ckvn[(size_t)tkn * 256 + lane + 64 * j] = f2bf(c[j] * rs * kvg[lane + 64 * j]);
        if (lane < 16) {
            const float p = (float)pos[tkn];
            const float inv = powf(10000.f, -(float)(2 * lane) / 32.f);
            const float ang = p * inv, cs = cosf(ang), sn = sinf(ang);
            const float t1 = bf2f(pr[P0_KR + lane]), t2 = bf2f(pr[P0_KR + 16 + lane]);
            krope[(size_t)tkn * 32 + lane] = f2bf(t1 * cs - t2 * sn);
            krope[(size_t)tkn * 32 + 16 + lane] = f2bf(t2 * cs + t1 * sn);
        }
    }
}
__device__ __forceinline__ void swa_naive(const bf16_t* proj0, const float* sinks, bf16_t* ymix, int gt, int NGT) {
    for (int idx = gt; idx < T * 8; idx += NGT) {
        const int tkn = idx >> 3, h = idx & 7, hk = h >> 2;
        const int b = tkn / SEQ, sq = tkn % SEQ, n = sq / CHUNK, qi = sq % CHUNK;
        const float slope = exp2f(-(float)(h + 1));
        float q[64], o[64];
#pragma unroll
        for (int d = 0; d < 64; ++d) { q[d] = bf2f(proj0[(size_t)tkn * EVEN_INP + P0_QA + h * 64 + d]); o[d] = 0.f; }
        float m = sinks[h], l = 1.f;
        const int k_lo = (n - 2) * CHUNK, k_hi = (n + 1) * CHUNK;
        for (int kp = (k_lo < 0 ? 0 : k_lo); kp < k_hi; ++kp) {
            const bf16_t* kr = proj0 + (size_t)(b * SEQ + kp) * EVEN_INP + P0_KA + hk * 64;
            float sc = 0.f;
#pragma unroll
            for (int d = 0; d < 64; ++d) sc += q[d] * bf2f(kr[d]);
            const float dist = fabsf((float)(qi + 2 * CHUNK - (kp - k_lo)));
            sc = sc * 0.125f - slope * dist;
            const float mn = fmaxf(m, sc), f = __expf(m - mn), pz = __expf(sc - mn);
            l = l * f + pz; m = mn;
            const bf16_t* vr = kr + (P0_VA - P0_KA);
#pragma unroll
            for (int d = 0; d < 64; ++d) o[d] = o[d] * f + pz * bf2f(vr[d]);
        }
        const float il = 1.f / l;
#pragma unroll
        for (int d = 0; d < 64; ++d) ymix[(size_t)tkn * D + h * 64 + d] = f2bf(o[d] * il);
    }
}
__device__ __forceinline__ void mla_naive(const bf16_t* qm, const bf16_t* kvm, const bf16_t* krope, const int* pos, bf16_t* ymix, int gt, int NGT) {
    for (int idx = gt; idx < T * 8; idx += NGT) {
        const int tkn = idx >> 3, h = idx & 7;
        const int b = tkn / SEQ, sq = tkn % SEQ, c = sq / CHUNK;
        float q[96], o[64];
#pragma unroll
        for (int d = 0; d < 96; ++d) q[d] = bf2f(qm[(size_t)tkn * 768 + h * 96 + d]);
        { const float p = (float)pos[tkn];
#pragma unroll
          for (int i = 0; i < 16; ++i) { const float inv = powf(10000.f, -(float)(2 * i) / 32.f), ang = p * inv, cs = cosf(ang), sn = sinf(ang);
              const float t1 = q[64 + i], t2 = q[80 + i]; q[64 + i] = t1 * cs - t2 * sn; q[80 + i] = t2 * cs + t1 * sn; } }
#pragma unroll
        for (int d = 0; d < 64; ++d) o[d] = 0.f;
        float m = -1e30f, l = 0.f;
        const int nk = (c + 1) * CHUNK;
        for (int kp = 0; kp < nk; ++kp) {
            const bf16_t* kr = kvm + (size_t)(b * SEQ + kp) * 1024 + h * 128;
            const bf16_t* rr = krope + (size_t)(b * SEQ + kp) * 32;
            float sc = 0.f;
#pragma unroll
            for (int d = 0; d < 64; ++d) sc += q[d] * bf2f(kr[d]);
#pragma unroll
            for (int d = 0; d < 32; ++d) sc += q[64 + d] * bf2f(rr[d]);
            sc *= 0.10206207261596577f;
            const float mn = fmaxf(m, sc), f = __expf(m - mn), pz = __expf(sc - mn);
            l = l * f + pz; m = mn;
#pragma unroll
            for (int d = 0; d < 64; ++d) o[d] = o[d] * f + pz * bf2f(kr[64 + d]);
        }
        const float il = 1.f / l;
#pragma unroll
        for (int d = 0; d < 64; ++d) ymix[(size_t)tkn * D + 512 + h * 64 + d] = f2bf(o[d] * il);
    }
}
__device__ __forceinline__ void ret_naive(const bf16_t* proj1, float* yr, LAS float* sm, int bx, int G, int tid) {
    for (int bh = bx; bh < BATCH * 4; bh += G) {
        const int b = bh >> 2, h = bh & 3, dv = tid & 127;
        const float g = 1.f - exp2f(-5.f - (float)h);
        float S[128];
#pragma unroll
        for (int d = 0; d < 128; ++d) S[d] = 0.f;
        for (int sq = 0; sq < SEQ; ++sq) {
            const bf16_t* pr = proj1 + (size_t)(b * SEQ + sq) * ODD_IN;
            __syncthreads();
            if (tid < 128) { sm[dv] = bf2f(pr[P1_Q + h * 128 + dv]); sm[128 + dv] = bf2f(pr[P1_K + h * 128 + dv]) * 0.08838834764831845f; }
            __syncthreads();
            if (tid < 128) {
                const float v = bf2f(pr[P1_V + h * 128 + dv]); float o = 0.f;
#pragma unroll
                for (int d = 0; d < 128; ++d) { S[d] = g * S[d] + sm[128 + d] * v; o += sm[d] * S[d]; }
                yr[(size_t)(b * SEQ + sq) * 512 + h * 128 + dv] = o;
            }
        }
    }
}
__device__ __forceinline__ void ret_gn_rows(const float* yr, const bf16_t* proj1, const float* gn, bf16_t* ymix, int gw, int NGW, int lane) {
    for (int w = gw; w < T * 4; w += NGW) {
        const int tkn = w >> 2, h = w & 3;
        const float a = yr[(size_t)tkn * 512 + h * 128 + lane], c = yr[(size_t)tkn * 512 + h * 128 + 64 + lane];
        const float mu = wave_sum(a + c) * (1.f / 128.f);
        const float da = a - mu, dc = c - mu;
        const float rs = rsqrtf(wave_sum(da * da + dc * dc) * (1.f / 128.f) + EPS);
        const float g0 = bf2f(proj1[(size_t)tkn * ODD_IN + P1_G + h * 128 + lane]), g1 = bf2f(proj1[(size_t)tkn * ODD_IN + P1_G + h * 128 + 64 + lane]);
        ymix[(size_t)tkn * D + h * 128 + lane] = f2bf(silu(g0) * da * rs * gn[h * 128 + lane]);
        ymix[(size_t)tkn * D + h * 128 + 64 + lane] = f2bf(silu(g1) * dc * rs * gn[h * 128 + 64 + lane]);
    }
}
__device__ __forceinline__ void conv_elems(const bf16_t* proj1, const float* w, bf16_t* ymix, int gt, int NGT) {
    for (int i = gt; i < T * 512; i += NGT) {
        const int tkn = i >> 9, c = i & 511, sq = tkn % SEQ;
        float y = 0.f;
#pragma unroll
        for (int j = 0; j < 3; ++j) { if (sq - 2 + j >= 0) { const bf16_t* pr = proj1 + (size_t)(tkn - 2 + j) * ODD_IN; y += w[j * 512 + c] * bf2f(pr[P1_C + c]) * bf2f(pr[P1_H + c]); } }
        ymix[(size_t)tkn * D + 512 + c] = f2bf(bf2f(proj1[(size_t)tkn * ODD_IN + P1_B + c]) * y);
    }
}
__device__ __forceinline__ void route_tokens(const float* x, const float* g, const float* router, bf16_t* xnm, unsigned* ctl, unsigned char* tab, LAS unsigned* sm, int bx, int G, int tid) {
    const int wave = tid >> 6, lane = tid & 63;
    LAS unsigned* lcnt = sm; LAS unsigned* lbase = sm + 8; LAS int* se = (LAS int*)(sm + 16); LAS int* ss = (LAS int*)(sm + 16 + 128); LAS float* sg = (LAS float*)(sm + 16 + 256);
    for (int blk = bx; blk < T / 64; blk += G) {
        __syncthreads();
        if (tid < NE) lcnt[tid] = 0u;
        __syncthreads();
        for (int it = 0; it < 8; ++it) {
            const int lt = wave * 8 + it, tkn = blk * 64 + lt;
            const float* xr = x + (size_t)tkn * D;
            float v[16]; float s = 0.f;
#pragma unroll
            for (int j = 0; j < 16; ++j) { v[j] = xr[lane + 64 * j]; s += v[j] * v[j]; }
            const float rs = rsqrtf(wave_sum(s) * (1.f / D) + EPS);
            float lg[NE];
#pragma unroll
            for (int e = 0; e < NE; ++e) lg[e] = 0.f;
#pragma unroll
            for (int j = 0; j < 16; ++j) {
                const float hv = v[j] * rs * g[lane + 64 * j];
                xnm[(size_t)tkn * D + lane + 64 * j] = f2bf(hv);
                const float* rr = router + (size_t)(lane + 64 * j) * NE;
#pragma unroll
                for (int e = 0; e < NE; ++e) lg[e] += hv * rr[e];
            }
#pragma unroll
            for (int e = 0; e < NE; ++e) lg[e] = wave_sum(lg[e]);
            int e0 = 0; float v0 = lg[0];
#pragma unroll
            for (int e = 1; e < NE; ++e) if (lg[e] > v0) { v0 = lg[e]; e0 = e; }
            int e1 = -1; float v1 = -INFINITY;
#pragma unroll
            for (int e = 0; e < NE; ++e) if (e != e0 && lg[e] > v1) { v1 = lg[e]; e1 = e; }
            const float p1 = __expf(v1 - v0), g0 = 1.f / (1.f + p1), g1 = p1 / (1.f + p1);
            if (lane == 0) { se[lt * 2] = e0; se[lt * 2 + 1] = e1; sg[lt * 2] = g0; sg[lt * 2 + 1] = g1; ss[lt * 2] = (int)__hip_atomic_fetch_add(&lcnt[e0], 1u, __ATOMIC_RELAXED, __HIP_MEMORY_SCOPE_WORKGROUP); ss[lt * 2 + 1] = (int)__hip_atomic_fetch_add(&lcnt[e1], 1u, __ATOMIC_RELAXED, __HIP_MEMORY_SCOPE_WORKGROUP); }
        }
        __syncthreads();
        if (tid < NE) lbase[tid] = __hip_atomic_fetch_add(&ctl[CW_CNT + 64 * tid], lcnt[tid], __ATOMIC_RELAXED, __HIP_MEMORY_SCOPE_AGENT);
        __syncthreads();
        if (tid < 64) {
            const int lt = tid, tkn = blk * 64 + lt;
            int* ltok = (int*)(tab + TAB_LTOK); float* lgate = (float*)(tab + TAB_LGATE); int* tsel = (int*)(tab + TAB_TSEL);
#pragma unroll
            for (int k = 0; k < 2; ++k) { const int e = se[lt * 2 + k], slot = (int)lbase[e] + ss[lt * 2 + k]; ltok[e * T + slot] = tkn; lgate[e * T + slot] = sg[lt * 2 + k]; tsel[tkn * 4 + 2 * k] = e; tsel[tkn * 4 + 2 * k + 1] = slot; }
        }
    }
}
__device__ __forceinline__ void final_rows(const float* x3, const bf16_t* yp0, const bf16_t* yp1, const unsigned* cnt, const unsigned char* tab, const float* g, float* out, int gw, int NGW, int lane) {
    const int* tsel = (const int*)(tab + TAB_TSEL);
    int tb[NE]; { int t = 0;
#pragma unroll
      for (int e = 0; e < NE; ++e) { tb[e] = t; t += ((int)__hip_atomic_load(cnt + 64 * e, __ATOMIC_RELAXED, __HIP_MEMORY_SCOPE_AGENT) + 255) >> 8; } }
    for (int tkn = gw; tkn < T; tkn += NGW) {
        size_t row[2];
#pragma unroll
        for (int k = 0; k < 2; ++k) { const int e = tsel[tkn * 4 + 2 * k], slot = tsel[tkn * 4 + 2 * k + 1]; int tbe = 0;
#pragma unroll
            for (int i = 0; i < NE; ++i) tbe = (i == e) ? tb[i] : tbe;
            row[k] = (size_t)tbe * 256 + slot; }
        float v[16]; float s = 0.f;
#pragma unroll
        for (int j = 0; j < 16; ++j) { const int c = lane + 64 * j;
            v[j] = x3[(size_t)tkn * D + c] + bf2f(yp0[row[0] * D + c]) + bf2f(yp1[row[0] * D + c]) + bf2f(yp0[row[1] * D + c]) + bf2f(yp1[row[1] * D + c]);
            s += v[j] * v[j]; }
        const float rs = rsqrtf(wave_sum(s) * (1.f / D) + EPS);
#pragma unroll
        for (int j = 0; j < 16; ++j) out[(size_t)tkn * D + lane + 64 * j] = v[j] * rs * g[lane + 64 * j];
    }
}

#ifndef MK_ONE_LAUNCH
#define MK_ONE_LAUNCH 1
#endif
constexpr int NPHASE = 21;
enum Phase { PH_P0 = 0, PH_G1, PH_MP, PH_G2, PH_ATT, PH_G3, PH_N2, PH_G4, PH_G5, PH_N3, PH_G6, PH_RET1, PH_RET2, PH_RET3, PH_G7, PH_ROUTE, PH_G8A, PH_G9A, PH_G8B, PH_G9B, PH_FINAL };
struct Args { const float* in[25]; float* out; unsigned char* ws; int ph_lo, ph_hi; };
static_assert(sizeof(Args) == 25 * 8 + 8 + 8 + 8, "Args has no padding");
enum In { I_X = 0, I_POS, I_ENORM_MIX, I_EW_IN, I_ESINKS, I_EQ_NORM, I_EW_UQ, I_EKV_NORM, I_EW_UKV, I_EW_OUT, I_ENORM_FFN, I_EW_GATE, I_EW_UP, I_EW_DOWN,
          I_ONORM_MIX, I_OW_IN, I_ORET_GN, I_OCONV_W, I_OW_OUT, I_ONORM_FFN, I_OROUTER, I_OWE_GATE, I_OWE_UP, I_OWE_DOWN, I_FINAL_NORM };

__global__ void __launch_bounds__(NWAVES * 64, 2) skel_fwd(Args args) {
    extern __shared__ __attribute__((aligned(16))) unsigned char lds_raw[];
    LAS unsigned char* lds = (LAS unsigned char*)lds_raw;
    LAS unsigned* rowtab = (LAS unsigned*)(lds + ROWTAB_OFF);
    volatile LAS unsigned* MISC = (volatile LAS unsigned*)(lds + MISC_OFF);
    const int G = gridDim.x, bx = blockIdx.x, tid = threadIdx.x, lane = tid & 63, wave = __builtin_amdgcn_readfirstlane(tid >> 6);
    const int gw = bx * NWAVES + wave, NGW = G * NWAVES, gt = bx * NWAVES * 64 + tid, NGT = G * NWAVES * 64;
    unsigned char* ws = args.ws; float* out = args.out;
    unsigned* ctl = (unsigned*)(ws + WS_CTL);
    const unsigned* cnt = ctl + CW_CNT;
    bf16_t* XN = (bf16_t*)(ws + WS_XN); bf16_t* YMIX = (bf16_t*)(ws + WS_YMIX); bf16_t* PROJ0 = (bf16_t*)(ws + WS_PROJ0); bf16_t* CQN = (bf16_t*)(ws + WS_CQN);
    bf16_t* CKVN = (bf16_t*)(ws + WS_CKVN); bf16_t* KROPE = (bf16_t*)(ws + WS_KROPE); bf16_t* QM = (bf16_t*)(ws + WS_QM); bf16_t* KVM = (bf16_t*)(ws + WS_KVM);
    bf16_t* ACT = (bf16_t*)(ws + WS_ACT); bf16_t* PROJ1 = (bf16_t*)(ws + WS_PROJ1); float* YR = (float*)(ws + WS_YR);
    bf16_t* ACTM = (bf16_t*)(ws + WS_ACTM); bf16_t* YP0 = (bf16_t*)(ws + WS_YP0); bf16_t* YP1 = (bf16_t*)(ws + WS_YP1); bf16_t* XNM = (bf16_t*)(ws + WS_XNM);
    unsigned char* TAB = ws + WS_TAB;
    const int* ltok = (const int*)(TAB + TAB_LTOK); const float* lgate = (const float*)(TAB + TAB_LGATE);
    const int lo = args.ph_lo, hi = args.ph_hi;
    for (int u = tid; u < (LDS_BYTES - RING_BYTES) / 4; u += NWAVES * 64) ((LAS unsigned*)(lds + RING_BYTES))[u] = 0u;
    __syncthreads();
    XcdBarrier bar; bar.bar = (unsigned*)(ctl + CW_BAR); bar.x = 0; bar.st = nullptr;
    if (hi - lo > 1) bar = xcd_barrier_post((unsigned*)(ctl + CW_BAR), MISC + 8);
#define IN(k) (lo <= (k) && (k) < hi)
#define SEAM(k) do { if (IN(k) && IN((k) + 1)) xcd_barrier(bar); } while (0)
    using namespace pg8;

    if (IN(PH_P0)) {
        LAS float* scr = (LAS float*)(lds + wave * 16384);
        constexpr int I_IN0 = 16 * 45, I_UQ = 6 * 24, I_UKV = 4 * 32, I_SQ = 16 * 32, I_FF = 16 * 112, I_DN = 56 * 32;
        constexpr int NDENSE = I_IN0 + I_UQ + I_UKV + I_SQ + 2 * I_FF + I_DN + I_FF + I_SQ, NITEMS = NDENSE + NE * 3 * I_FF;
        static_assert(I_DN == I_FF, "expert item arithmetic assumes equal item counts");
        for (int it = gw; it < NITEMS; it += NGW) {
            int r = it;
            if (r < I_IN0) { p0_item(args.in[I_EW_IN], D, EVEN_IN, (bf16_t*)(ws + WS_W_IN0), RowIdent{0}, scr, r, lane); continue; } r -= I_IN0;
            if (r < I_UQ) { p0_item(args.in[I_EW_UQ], 384, 768, (bf16_t*)(ws + WS_W_UQ), RowIdent{0}, scr, r, lane); continue; } r -= I_UQ;
            if (r < I_UKV) { p0_item(args.in[I_EW_UKV], 256, 1024, (bf16_t*)(ws + WS_W_UKV), RowIdent{0}, scr, r, lane); continue; } r -= I_UKV;
            if (r < I_SQ) { p0_item(args.in[I_EW_OUT], D, D, (bf16_t*)(ws + WS_W_OUT0), RowIdent{0}, scr, r, lane); continue; } r -= I_SQ;
            if (r < I_FF) { p0_item(args.in[I_EW_GATE], D, FF, (bf16_t*)(ws + WS_W_GU0), RowGU{0}, scr, r, lane); continue; } r -= I_FF;
            if (r < I_FF) { p0_item(args.in[I_EW_UP], D, FF, (bf16_t*)(ws + WS_W_GU0), RowGU{1}, scr, r, lane); continue; } r -= I_FF;
            if (r < I_DN) { p0_item(args.in[I_EW_DOWN], FF, D, (bf16_t*)(ws + WS_W_DN0), RowIdent{0}, scr, r, lane); continue; } r -= I_DN;
            if (r < I_FF) { p0_item(args.in[I_OW_IN], D, ODD_IN, (bf16_t*)(ws + WS_W_IN1), RowIdent{0}, scr, r, lane); continue; } r -= I_FF;
            if (r < I_SQ) { p0_item(args.in[I_OW_OUT], D, D, (bf16_t*)(ws + WS_W_OUT1), RowIdent{0}, scr, r, lane); continue; } r -= I_SQ;
            const int e = r / (3 * I_FF), q = r % (3 * I_FF), which = q / I_FF, item = q % I_FF;
            if (which == 0) p0_item(args.in[I_OWE_GATE] + (size_t)e * D * FF, D, FF, (bf16_t*)(ws + WS_WE_GU) + (size_t)e * 2 * FF * D, RowGU{0}, scr, item, lane);
            else if (which == 1) p0_item(args.in[I_OWE_UP] + (size_t)e * D * FF, D, FF, (bf16_t*)(ws + WS_WE_GU) + (size_t)e * 2 * FF * D, RowGU{1}, scr, item, lane);
            else p0_item(args.in[I_OWE_DOWN] + (size_t)e * FF * D, FF, D, (bf16_t*)(ws + WS_WE_DN) + (size_t)e * D * FF, RowIdent{0}, scr, item, lane);
        }
        { v4u* z = (v4u*)((bf16_t*)(ws + WS_W_IN0) + (size_t)EVEN_IN * D); for (int i = gt; i < (EVEN_INP - EVEN_IN) * D / 8; i += NGT) z[i] = (v4u){0u, 0u, 0u, 0u}; }
        norm_rows(args.in[I_X], args.in[I_ENORM_MIX], XN, gw, NGW, lane);
    }
    SEAM(PH_P0);
    if (IN(PH_G1)) {
        Gemm g{XN, (const bf16_t*)(ws + WS_W_IN0), D, D, D, 0}; StaticOrder S; S.init(T / 256, EVEN_INP / 256, G, bx);
        gemm_phase<EpiBf16, StaticOrder, ARowIdent, true>(lds, rowtab, g, S, ARowIdent{}, EpiBf16{PROJ0, EVEN_INP});
    }
    SEAM(PH_G1);
    if (IN(PH_MP)) mla_prep_rows(PROJ0, args.in[I_EQ_NORM], args.in[I_EKV_NORM], (const int*)args.in[I_POS], CQN, CKVN, KROPE, gw, NGW, lane);
    SEAM(PH_MP);
    if (IN(PH_G2)) {
        { Gemm g{CQN, (const bf16_t*)(ws + WS_W_UQ), 384, 384, 384, 0}; StaticOrder S; S.init(T / 256, 768 / 256, G, bx);
          gemm_phase<EpiBf16, StaticOrder, ARowIdent, true>(lds, rowtab, g, S, ARowIdent{}, EpiBf16{QM, 768}); }
        { Gemm g{CKVN, (const bf16_t*)(ws + WS_W_UKV), 256, 256, 256, 0}; StaticOrder S; S.init(T / 256, 1024 / 256, G, bx);
          gemm_phase<EpiBf16, StaticOrder, ARowIdent, true>(lds, rowtab, g, S, ARowIdent{}, EpiBf16{KVM, 1024}); }
    }
    SEAM(PH_G2);
    if (IN(PH_ATT)) {
        swa_naive(PROJ0, args.in[I_ESINKS], YMIX, gt, NGT);
        mla_naive(QM, KVM, KROPE, (const int*)args.in[I_POS], YMIX, gt, NGT);
    }
    SEAM(PH_ATT);
    if (IN(PH_G3)) {
        Gemm g{YMIX, (const bf16_t*)(ws + WS_W_OUT0), D, D, D, 0}; StaticOrder S; S.init(T / 256, D / 256, G, bx);
        gemm_phase<EpiRes, StaticOrder, ARowIdent, true>(lds, rowtab, g, S, ARowIdent{}, EpiRes{args.in[I_X], out, D});
    }
    SEAM(PH_G3);
    if (IN(PH_N2)) norm_rows(out, args.in[I_ENORM_FFN], XN, gw, NGW, lane);
    SEAM(PH_N2);
    if (IN(PH_G4)) {
        Gemm g{XN, (const bf16_t*)(ws + WS_W_GU0), D, D, D, 0}; StaticOrder S; S.init(T / 256, 2 * FF / 256, G, bx);
        gemm_phase<EpiSwiglu, StaticOrder, ARowIdent, true>(lds, rowtab, g, S, ARowIdent{}, EpiSwiglu{ACT, FF});
    }
    SEAM(PH_G4);
    if (IN(PH_G5)) {
        Gemm g{ACT, (const bf16_t*)(ws + WS_W_DN0), FF, FF, FF, 0}; StaticOrder S; S.init(T / 256, D / 256, G, bx);
        gemm_phase<EpiRes, StaticOrder, ARowIdent, true>(lds, rowtab, g, S, ARowIdent{}, EpiRes{out, out, D});
    }
    SEAM(PH_G5);
    if (IN(PH_N3)) norm_rows(out, args.in[I_ONORM_MIX], XN, gw, NGW, lane);
    SEAM(PH_N3);
    if (IN(PH_G6)) {
        Gemm g{XN, (const bf16_t*)(ws + WS_W_IN1), D, D, D, 0}; StaticOrder S; S.init(T / 256, ODD_IN / 256, G, bx);
        gemm_phase<EpiBf16, StaticOrder, ARowIdent, true>(lds, rowtab, g, S, ARowIdent{}, EpiBf16{PROJ1, ODD_IN});
    }
    SEAM(PH_G6);
    if (IN(PH_RET1)) { ret_naive(PROJ1, YR, (LAS float*)lds, bx, G, tid); conv_elems(PROJ1, args.in[I_OCONV_W], YMIX, gt, NGT); }
    SEAM(PH_RET1);
    SEAM(PH_RET2);
    if (IN(PH_RET3)) ret_gn_rows(YR, PROJ1, args.in[I_ORET_GN], YMIX, gw, NGW, lane);
    SEAM(PH_RET3);
    if (IN(PH_G7)) {
        Gemm g{YMIX, (const bf16_t*)(ws + WS_W_OUT1), D, D, D, 0}; StaticOrder S; S.init(T / 256, D / 256, G, bx);
        gemm_phase<EpiRes, StaticOrder, ARowIdent, true>(lds, rowtab, g, S, ARowIdent{}, EpiRes{out, out, D});
    }
    SEAM(PH_G7);
    if (IN(PH_ROUTE)) route_tokens(out, args.in[I_ONORM_FFN], args.in[I_OROUTER], XNM, ctl, TAB, (LAS unsigned*)lds, bx, G, tid);
    SEAM(PH_ROUTE);
#define MOE_HALF(PH_GU, PH_DN, TLO) \
    if (IN(PH_GU)) { Gemm g{XNM, (const bf16_t*)(ws + WS_WE_GU), D, D, D, (size_t)2 * FF * D}; MoeOrder S; S.init(cnt, (TLO), (TLO) + MOE_HALFT, 2 * FF / 256, 1, 0, G, bx); \
        gemm_phase<EpiSwiglu, MoeOrder, ARowMoe, true>(lds, rowtab, g, S, ARowMoe{ltok, cnt}, EpiSwiglu{ACTM, FF}); } \
    SEAM(PH_GU); \
    if (IN(PH_DN)) { Gemm g{ACTM, (const bf16_t*)(ws + WS_WE_DN), FF, FF, FF / 2, (size_t)D * FF}; MoeOrder S; S.init(cnt, (TLO), (TLO) + MOE_HALFT, D / 256, 2, FF / 2, G, bx); \
        gemm_phase<EpiMoeDn, MoeOrder, ARowIdent, true>(lds, rowtab, g, S, ARowIdent{}, EpiMoeDn{YP0, YP1, lgate, cnt, (TLO)}); } \
    SEAM(PH_DN);
    MOE_HALF(PH_G8A, PH_G9A, 0)
    MOE_HALF(PH_G8B, PH_G9B, MOE_HALFT)
#undef MOE_HALF
    if (IN(PH_FINAL)) final_rows(out, YP0, YP1, cnt, TAB, args.in[I_FINAL_NORM], out, gw, NGW, lane);
#undef IN
#undef SEAM
}

template <class RM> static void wconv(const float* W, int K, int N, bf16_t* WT, RM rm, hipStream_t st) {
    hipLaunchKernelGGL((k_wconv<RM>), dim3((K / 32) * (N / 32)), dim3(256), 0, st, W, K, N, WT, rm);
}
template <bool DUAL, class Ctx> static void gemm(const bf16_t* A, int lda, const bf16_t* Bt, int ldb, int M, int N, int K, Ctx ctx, hipStream_t st) {
    GemmArgs g{A, Bt, lda, ldb, M, N, K, 0};
    hipLaunchKernelGGL((k_gemm<DUAL, Ctx>), dim3(N / 64, M / 64), dim3(256), 0, st, g, ctx);
}

extern "C" void kernel_launch(void* const* d_in, const int* in_sizes, int n_in, void* d_out, int out_size, void* d_ws, size_t ws_size, hipStream_t stream) {
    if (n_in != 25 || out_size != T * D || ws_size < WS_END) { fprintf(stderr, "kernel_launch: unexpected problem (n_in %d out %d ws %zu need %zu)\n", n_in, out_size, ws_size, (size_t)WS_END); return; }
    const float* x = (const float*)d_in[0]; const int* pos = (const int*)d_in[1];
    const float* e_norm_mix = (const float*)d_in[2]; const float* e_w_in = (const float*)d_in[3]; const float* e_sinks = (const float*)d_in[4];
    const float* e_q_norm = (const float*)d_in[5]; const float* e_w_uq = (const float*)d_in[6]; const float* e_kv_norm = (const float*)d_in[7]; const float* e_w_ukv = (const float*)d_in[8];
    const float* e_w_out = (const float*)d_in[9]; const float* e_norm_ffn = (const float*)d_in[10]; const float* e_w_gate = (const float*)d_in[11]; const float* e_w_up = (const float*)d_in[12];
    const float* e_w_down = (const float*)d_in[13]; const float* o_norm_mix = (const float*)d_in[14]; const float* o_w_in = (const float*)d_in[15]; const float* o_ret_gn = (const float*)d_in[16];
    const float* o_conv_w = (const float*)d_in[17]; const float* o_w_out = (const float*)d_in[18]; const float* o_norm_ffn = (const float*)d_in[19]; const float* o_router = (const float*)d_in[20];
    const float* o_we_gate = (const float*)d_in[21]; const float* o_we_up = (const float*)d_in[22]; const float* o_we_down = (const float*)d_in[23]; const float* final_norm = (const float*)d_in[24];
    unsigned char* ws = (unsigned char*)d_ws; float* out = (float*)d_out;
    unsigned* ctl = (unsigned*)(ws + WS_CTL);
    bf16_t* W_IN0 = (bf16_t*)(ws + WS_W_IN0); bf16_t* W_UQ = (bf16_t*)(ws + WS_W_UQ); bf16_t* W_UKV = (bf16_t*)(ws + WS_W_UKV); bf16_t* W_OUT0 = (bf16_t*)(ws + WS_W_OUT0);
    bf16_t* W_GU0 = (bf16_t*)(ws + WS_W_GU0); bf16_t* W_DN0 = (bf16_t*)(ws + WS_W_DN0); bf16_t* W_IN1 = (bf16_t*)(ws + WS_W_IN1); bf16_t* W_OUT1 = (bf16_t*)(ws + WS_W_OUT1);
    bf16_t* WE_GU = (bf16_t*)(ws + WS_WE_GU); bf16_t* WE_DN = (bf16_t*)(ws + WS_WE_DN);
    bf16_t* XN = (bf16_t*)(ws + WS_XN); bf16_t* YMIX = (bf16_t*)(ws + WS_YMIX); bf16_t* PROJ0 = (bf16_t*)(ws + WS_PROJ0); bf16_t* CQN = (bf16_t*)(ws + WS_CQN);
    bf16_t* CKVN = (bf16_t*)(ws + WS_CKVN); bf16_t* KROPE = (bf16_t*)(ws + WS_KROPE); bf16_t* QM = (bf16_t*)(ws + WS_QM); bf16_t* KVM = (bf16_t*)(ws + WS_KVM);
    bf16_t* ACT = (bf16_t*)(ws + WS_ACT); bf16_t* PROJ1 = (bf16_t*)(ws + WS_PROJ1); float* YR = (float*)(ws + WS_YR);
    bf16_t* ACTM = (bf16_t*)(ws + WS_ACTM); bf16_t* YP0 = (bf16_t*)(ws + WS_YP0); bf16_t* YP1 = (bf16_t*)(ws + WS_YP1); unsigned char* TAB = ws + WS_TAB; bf16_t* XNM = (bf16_t*)(ws + WS_XNM);

    static int grid = 0;
    if (grid == 0) {
        int dev = 0, cus = 0;
        if (hipGetDevice(&dev) != hipSuccess || hipDeviceGetAttribute(&cus, hipDeviceAttributeMultiprocessorCount, dev) != hipSuccess) { fprintf(stderr, "kernel_launch: device query failed\n"); grid = -1; return; }
        if (hipFuncSetAttribute((const void*)skel_fwd, hipFuncAttributeMaxDynamicSharedMemorySize, LDS_BYTES) != hipSuccess) { fprintf(stderr, "kernel_launch: hipFuncSetAttribute failed\n"); grid = -1; return; }
        grid = cus;
    }
    if (grid < 0) return;
    Args a{};
    for (int i = 0; i < 25; ++i) a.in[i] = (const float*)d_in[i];
    a.out = out; a.ws = ws;
    auto phase = [&](int lo, int hi) { a.ph_lo = lo; a.ph_hi = hi; hipLaunchKernelGGL(skel_fwd, dim3(grid), dim3(NWAVES * 64), LDS_BYTES, stream, a); };
    (void)hipMemsetAsync(ws + WS_CTL, 0, 1 * MiB, stream);
#if MK_ONE_LAUNCH
    phase(0, NPHASE);
#else
    for (int k = 0; k < NPHASE; ++k) if (k != PH_RET2) phase(k, k + 1);
#endif
}
```

```cpp
#include <hip/hip_runtime.h>
#include <cstdint>
#include <cstdio>
#include <cmath>

typedef unsigned short bf16_t;
constexpr int D = 1024, BATCH = 8, SEQ = 2048, T = BATCH * SEQ, CHUNK = 64;
constexpr int EVEN_IN = 1440, EVEN_INP = 1536, FF = 3584, ODD_IN = 3584, NE = 8;
constexpr float EPS = 1e-6f;
constexpr int P0_QA = 0, P0_KA = 512, P0_VA = 640, P0_CQ = 768, P0_CKV = 1152, P0_KR = 1408;
constexpr int P1_Q = 0, P1_K = 512, P1_V = 1024, P1_G = 1536, P1_B = 2048, P1_C = 2560, P1_H = 3072;

constexpr size_t MiB = 1u << 20;
constexpr size_t WS_CTL = 0;
constexpr size_t WS_W_IN0 = 1 * MiB;
constexpr size_t WS_W_UQ = WS_W_IN0 + (size_t)EVEN_INP * D * 2;
constexpr size_t WS_W_UKV = WS_W_UQ + (size_t)768 * 384 * 2;
constexpr size_t WS_W_OUT0 = WS_W_UKV + (size_t)1024 * 256 * 2;
constexpr size_t WS_W_GU0 = WS_W_OUT0 + (size_t)D * D * 2;
constexpr size_t WS_W_DN0 = WS_W_GU0 + (size_t)2 * FF * D * 2;
constexpr size_t WS_W_IN1 = WS_W_DN0 + (size_t)D * FF * 2;
constexpr size_t WS_W_OUT1 = WS_W_IN1 + (size_t)ODD_IN * D * 2;
constexpr size_t WS_WE_GU = 38 * MiB;
constexpr size_t WS_WE_DN = WS_WE_GU + (size_t)NE * 2 * FF * D;
constexpr size_t WS_ACT0 = WS_WE_DN + (size_t)NE * D * FF;
static_assert(WS_W_OUT1 + (size_t)D * D * 2 <= WS_WE_GU, "dense weights fit below 38 MiB");
static_assert(WS_ACT0 == 122 * MiB, "activation base");
constexpr size_t WS_XN = WS_ACT0;
constexpr size_t WS_YMIX = WS_ACT0 + 32 * MiB;
constexpr size_t WS_BIG = WS_ACT0 + 64 * MiB;
constexpr size_t WS_PROJ0 = WS_BIG;
constexpr size_t WS_CQN = WS_BIG + 48 * MiB;
constexpr size_t WS_CKVN = WS_BIG + 60 * MiB;
constexpr size_t WS_KROPE = WS_BIG + 68 * MiB;
constexpr size_t WS_QM = WS_BIG + 70 * MiB;
constexpr size_t WS_KVM = WS_BIG + 94 * MiB;
constexpr size_t WS_ROPE = WS_BIG + 126 * MiB;
constexpr size_t WS_ACT = WS_BIG;
constexpr size_t WS_PROJ1 = WS_BIG;
constexpr size_t WS_RKV = WS_BIG + 112 * MiB;
constexpr size_t WS_YR = WS_BIG + 144 * MiB;
constexpr int MOE_MAXT = 136;
constexpr size_t WS_ACTM = WS_ACT0;
constexpr size_t WS_YP0 = WS_ACT0 + 119 * MiB;
constexpr size_t WS_YP1 = WS_YP0 + 68 * MiB;
constexpr size_t WS_TAB = WS_YP1 + 68 * MiB;
constexpr size_t WS_XNM = 1 * MiB;
constexpr size_t WS_END = WS_TAB + 2 * MiB;
static_assert(WS_END <= 471 * MiB, "workspace budget");
constexpr size_t TAB_LTOK = 0;
constexpr size_t TAB_LGATE = 512 * 1024;
constexpr size_t TAB_TSEL = 1024 * 1024;
constexpr size_t TAB_TGATE = 1280 * 1024;
constexpr int CW_CNT = 64;

__device__ __forceinline__ float bf2f(bf16_t v) { return __uint_as_float((unsigned)v << 16); }
__device__ __forceinline__ bf16_t f2bf(float f) { unsigned u = __float_as_uint(f); return (bf16_t)((u + 0x7fffu + ((u >> 16) & 1u)) >> 16); }
__device__ __forceinline__ float wave_sum(float v) {
#pragma unroll
    for (int o = 1; o < 64; o <<= 1) v += __shfl_xor(v, o);
    return v;
}
__device__ __forceinline__ float silu(float v) { return v / (1.f + __expf(-v)); }

struct RowIdent { int off; __device__ int operator()(int n) const { return off + n; } };
struct RowGU { int half; __device__ int operator()(int n) const { return 256 * (n >> 7) + 128 * half + (n & 127); } };
template <class RM>
__global__ void __launch_bounds__(256) k_wconv(const float* __restrict__ W, int K, int N, bf16_t* __restrict__ WT, RM rm) {
    __shared__ float tile[32][33];
    const int nb = N / 32, kb = blockIdx.x / nb, n0 = (blockIdx.x % nb) * 32, k0 = kb * 32;
    const int tx = threadIdx.x & 31, ty = threadIdx.x >> 5;
    for (int i = ty; i < 32; i += 8) tile[i][tx] = W[(size_t)(k0 + i) * N + n0 + tx];
    __syncthreads();
    for (int i = ty; i < 32; i += 8) WT[(size_t)rm(n0 + i) * K + k0 + tx] = f2bf(tile[tx][i]);
}
__global__ void k_fill_bf16(bf16_t* p, size_t n, bf16_t v) { size_t i = (size_t)blockIdx.x * blockDim.x + threadIdx.x; if (i < n) p[i] = v; }

__global__ void __launch_bounds__(256) k_rmsnorm(const float* __restrict__ x, const float* __restrict__ g, bf16_t* __restrict__ o) {
    const int row = blockIdx.x * 4 + (threadIdx.x >> 6), lane = threadIdx.x & 63;
    const float* xr = x + (size_t)row * D;
    float v[16]; float s = 0.f;
#pragma unroll
    for (int j = 0; j < 16; ++j) { v[j] = xr[lane + 64 * j]; s += v[j] * v[j]; }
    const float rs = rsqrtf(wave_sum(s) * (1.f / D) + EPS);
#pragma unroll
    for (int j = 0; j < 16; ++j) o[(size_t)row * D + lane + 64 * j] = f2bf(v[j] * rs * g[lane + 64 * j]);
}

struct GemmArgs { const bf16_t* A; const bf16_t* Bt; int lda, ldb, M, N, K, pad; };
template <bool DUAL, class Ctx>
__global__ void __launch_bounds__(256) k_gemm(GemmArgs g, Ctx ctx) {
    __shared__ float As[16][68], Bs[16][68], B2[16][68];
    const int m0 = blockIdx.y * 64, n0 = blockIdx.x * 64;
    if (!ctx.block_valid(m0)) return;
    const bf16_t* Bt = g.Bt + ctx.b_offset(m0);
    const int tx = threadIdx.x & 15, ty = threadIdx.x >> 4;
    float acc[4][4], acc2[4][4];
#pragma unroll
    for (int i = 0; i < 4; ++i)
#pragma unroll
        for (int j = 0; j < 4; ++j) { acc[i][j] = 0.f; acc2[i][j] = 0.f; }
    const int lr = threadIdx.x >> 2, lk = (threadIdx.x & 3) * 4;
    const size_t arow = (size_t)ctx.a_row(m0 + lr) * g.lda;
    const size_t brow = (size_t)ctx.b_row(n0 + lr) * g.ldb;
    for (int k0 = 0; k0 < g.K; k0 += 16) {
#pragma unroll
        for (int j = 0; j < 4; ++j) {
            As[lk + j][lr] = bf2f(g.A[arow + k0 + lk + j]);
            Bs[lk + j][lr] = bf2f(Bt[brow + k0 + lk + j]);
            if (DUAL) B2[lk + j][lr] = bf2f(Bt[brow + (size_t)128 * g.ldb + k0 + lk + j]);
        }
        __syncthreads();
#pragma unroll
        for (int kk = 0; kk < 16; ++kk) {
            float a[4], b[4], b2[4];
#pragma unroll
            for (int i = 0; i < 4; ++i) { a[i] = As[kk][ty * 4 + i]; b[i] = Bs[kk][tx * 4 + i]; b2[i] = DUAL ? B2[kk][tx * 4 + i] : 0.f; }
#pragma unroll
            for (int i = 0; i < 4; ++i)
#pragma unroll
                for (int j = 0; j < 4; ++j) { acc[i][j] += a[i] * b[j]; if (DUAL) acc2[i][j] += a[i] * b2[j]; }
        }
        __syncthreads();
    }
#pragma unroll
    for (int i = 0; i < 4; ++i)
#pragma unroll
        for (int j = 0; j < 4; ++j) ctx.store(m0 + ty * 4 + i, n0 + tx * 4 + j, acc[i][j], acc2[i][j]);
}
struct CtxBf16 {
    bf16_t* O; int ldc; int pad;
    __device__ bool block_valid(int) const { return true; }
    __device__ size_t b_offset(int) const { return 0; }
    __device__ int a_row(int m) const { return m; }
    __device__ int b_row(int n) const { return n; }
    __device__ void store(int m, int n, float a, float) const { O[(size_t)m * ldc + n] = f2bf(a); }
};
struct CtxRes {
    const float* base; float* out; int ldc; int pad;
    __device__ bool block_valid(int) const { return true; }
    __device__ size_t b_offset(int) const { return 0; }
    __device__ int a_row(int m) const { return m; }
    __device__ int b_row(int n) const { return n; }
    __device__ void store(int m, int n, float a, float) const { out[(size_t)m * ldc + n] = base[(size_t)m * ldc + n] + a; }
};
struct CtxSwiglu {
    bf16_t* O; int ldc; int pad;
    __device__ bool block_valid(int) const { return true; }
    __device__ size_t b_offset(int) const { return 0; }
    __device__ int a_row(int m) const { return m; }
    __device__ int b_row(int n) const { return 256 * (n >> 7) + (n & 127); }
    __device__ void store(int m, int n, float a, float b) const { O[(size_t)m * ldc + n] = f2bf(silu(a) * b); }
};
__device__ __forceinline__ void moe_tile(const unsigned* cnt, int tile, int& e, int& slot0, int& ntiles) {
    int tb = 0; e = -1; slot0 = 0;
#pragma unroll
    for (int i = 0; i < NE; ++i) { const int c = (int)cnt[64 * i], nt = (c + 255) >> 8; if (e < 0 && tile < tb + nt) { e = i; slot0 = (tile - tb) * 256; } tb += nt; }
    ntiles = tb;
}
struct CtxMoeGU {
    bf16_t* O; const unsigned* cnt; const int* ltok; int ldc, tile_lo, tile_hi, pad;
    __device__ bool block_valid(int m0) const { int e, s0, nt; const int t = tile_lo + (m0 >> 8); moe_tile(cnt, t, e, s0, nt); return t < tile_hi && t < nt && e >= 0; }
    __device__ size_t b_offset(int m0) const { int e, s0, nt; moe_tile(cnt, tile_lo + (m0 >> 8), e, s0, nt); return (size_t)e * 2 * FF * D; }
    __device__ int a_row(int m) const { int e, s0, nt; moe_tile(cnt, tile_lo + (m >> 8), e, s0, nt); const int slot = s0 + (m & 255); return slot < (int)cnt[64 * e] ? ltok[e * T + slot] : 0; }
    __device__ int b_row(int n) const { return 256 * (n >> 7) + (n & 127); }
    __device__ void store(int m, int n, float a, float b) const { O[(size_t)m * ldc + n] = f2bf(silu(a) * b); }
};
struct CtxMoeDn {
    bf16_t* O; const unsigned* cnt; const float* lgate; int tile_lo, tile_hi;
    __device__ bool block_valid(int m0) const { int e, s0, nt; const int t = tile_lo + (m0 >> 8); moe_tile(cnt, t, e, s0, nt); return t < tile_hi && t < nt && e >= 0; }
    __device__ size_t b_offset(int m0) const { int e, s0, nt; moe_tile(cnt, tile_lo + (m0 >> 8), e, s0, nt); return (size_t)e * D * FF; }
    __device__ int a_row(int m) const { return m; }
    __device__ int b_row(int n) const { return n; }
    __device__ void store(int m, int n, float a, float) const {
        int e, s0, nt; moe_tile(cnt, tile_lo + (m >> 8), e, s0, nt); const int slot = s0 + (m & 255);
        const float gt = slot < (int)cnt[64 * e] ? lgate[e * T + slot] : 0.f;
        O[(size_t)(tile_lo * 256 + m) * D + n] = f2bf(gt * a);
    }
};

__global__ void __launch_bounds__(256) k_mla_prep(const bf16_t* __restrict__ proj0, const float* __restrict__ qg, const float* __restrict__ kvg, const int* __restrict__ pos,
                                                  bf16_t* __restrict__ cqn, bf16_t* __restrict__ ckvn, bf16_t* __restrict__ krope) {
    const int tkn = blockIdx.x * 4 + (threadIdx.x >> 6), lane = threadIdx.x & 63;
    const bf16_t* pr = proj0 + (size_t)tkn * EVEN_INP;
    float q[6], s = 0.f;
#pragma unroll
    for (int j = 0; j < 6; ++j) { q[j] = bf2f(pr[P0_CQ + lane + 64 * j]); s += q[j] * q[j]; }
    float rs = rsqrtf(wave_sum(s) * (1.f / 384.f) + EPS);
#pragma unroll
    for (int j = 0; j < 6; ++j) cqn[(size_t)tkn * 384 + lane + 64 * j] = f2bf(q[j] * rs * qg[lane + 64 * j]);
    float c[4]; s = 0.f;
#pragma unroll
    for (int j = 0; j < 4; ++j) { c[j] = bf2f(pr[P0_CKV + lane + 64 * j]); s += c[j] * c[j]; }
    rs = rsqrtf(wave_sum(s) * (1.f / 256.f) + EPS);
#pragma unroll
    for (int j = 0; j < 4; ++j) ckvn[(size_t)tkn * 256 + lane + 64 * j] = f2bf(c[j] * rs * kvg[lane + 64 * j]);
    if (lane < 16) {
        const float p = (float)pos[tkn];
        const float inv = powf(10000.f, -(float)(2 * lane) / 32.f);
        const float ang = p * inv, cs = cosf(ang), sn = sinf(ang);
        const float t1 = bf2f(pr[P0_KR + lane]), t2 = bf2f(pr[P0_KR + 16 + lane]);
        krope[(size_t)tkn * 32 + lane] = f2bf(t1 * cs - t2 * sn);
        krope[(size_t)tkn * 32 + 16 + lane] = f2bf(t2 * cs + t1 * sn);
    }
}

__global__ void __launch_bounds__(64) k_swa(const bf16_t* __restrict__ proj0, const float* __restrict__ sinks, bf16_t* __restrict__ ymix) {
    const int idx = blockIdx.x * 64 + threadIdx.x;
    const int tkn = idx >> 3, h = idx & 7, hk = h >> 2;
    const int b = tkn / SEQ, s = tkn % SEQ, n = s / CHUNK, qi = s % CHUNK;
    const float slope = exp2f(-8.f * (float)(h + 1) / 8.f);
    float q[64], o[64];
#pragma unroll
    for (int d = 0; d < 64; ++d) { q[d] = bf2f(proj0[(size_t)tkn * EVEN_INP + P0_QA + h * 64 + d]); o[d] = 0.f; }
    const float sink = sinks[h];
    float m = sink, l = 1.f;
    const int k_lo = (n - 2) * CHUNK, k_hi = (n + 1) * CHUNK;
    for (int kp = (k_lo < 0 ? 0 : k_lo); kp < k_hi; ++kp) {
        const bf16_t* kr = proj0 + (size_t)(b * SEQ + kp) * EVEN_INP + P0_KA + hk * 64;
        float sc = 0.f;
#pragma unroll
        for (int d = 0; d < 64; ++d) sc += q[d] * bf2f(kr[d]);
        const int kk = kp - k_lo;
        const float dist = fabsf((float)(qi + 2 * CHUNK - kk));
        sc = sc * 0.125f - slope * dist;
        const float mn = fmaxf(m, sc), f = __expf(m - mn), p = __expf(sc - mn);
        l = l * f + p; m = mn;
        const bf16_t* vr = proj0 + (size_t)(b * SEQ + kp) * EVEN_INP + P0_VA + hk * 64;
#pragma unroll
        for (int d = 0; d < 64; ++d) o[d] = o[d] * f + p * bf2f(vr[d]);
    }
    const float il = 1.f / l;
#pragma unroll
    for (int d = 0; d < 64; ++d) ymix[(size_t)tkn * D + h * 64 + d] = f2bf(o[d] * il);
}

__global__ void __launch_bounds__(64) k_mla(const bf16_t* __restrict__ qm, const bf16_t* __restrict__ kvm, const bf16_t* __restrict__ krope, const int* __restrict__ pos, bf16_t* __restrict__ ymix) {
    const int idx = blockIdx.x * 64 + threadIdx.x;
    const int tkn = idx >> 3, h = idx & 7;
    const int b = tkn / SEQ, s = tkn % SEQ, c = s / CHUNK;
    float q[96], o[64];
#pragma unroll
    for (int d = 0; d < 96; ++d) q[d] = bf2f(qm[(size_t)tkn * 768 + h * 96 + d]);
    {
        const float p = (float)pos[tkn];
#pragma unroll
        for (int i = 0; i < 16; ++i) {
            const float inv = powf(10000.f, -(float)(2 * i) / 32.f), ang = p * inv, cs = cosf(ang), sn = sinf(ang);
            const float t1 = q[64 + i], t2 = q[80 + i];
            q[64 + i] = t1 * cs - t2 * sn; q[80 + i] = t2 * cs + t1 * sn;
        }
    }
#pragma unroll
    for (int d = 0; d < 64; ++d) o[d] = 0.f;
    const float scale = 0.10206207261596577f;
    float m = -1e30f, l = 0.f;
    const int nk = (c + 1) * CHUNK;
    for (int kp = 0; kp < nk; ++kp) {
        const bf16_t* kr = kvm + (size_t)(b * SEQ + kp) * 1024 + h * 128;
        const bf16_t* rr = krope + (size_t)(b * SEQ + kp) * 32;
        float sc = 0.f;
#pragma unroll
        for (int d = 0; d < 64; ++d) sc += q[d] * bf2f(kr[d]);
#pragma unroll
        for (int d = 0; d < 32; ++d) sc += q[64 + d] * bf2f(rr[d]);
        sc *= scale;
        const float mn = fmaxf(m, sc), f = __expf(m - mn), p = __expf(sc - mn);
        l = l * f + p; m = mn;
#pragma unroll
        for (int d = 0; d < 64; ++d) o[d] = o[d] * f + p * bf2f(kr[64 + d]);
    }
    const float il = 1.f / l;
#pragma unroll
    for (int d = 0; d < 64; ++d) ymix[(size_t)tkn * D + 512 + h * 64 + d] = f2bf(o[d] * il);
}

__global__ void __launch_bounds__(128) k_ret(const bf16_t* __restrict__ proj1, float* __restrict__ yr) {
    const int bh = blockIdx.x, b = bh >> 2, h = bh & 3, dv = threadIdx.x;
    const float g = 1.f - exp2f(-5.f - (float)h);
    const float ks = 0.08838834764831845f;
    float S[128];
#pragma unroll
    for (int d = 0; d < 128; ++d) S[d] = 0.f;
    __shared__ float qs[128], kss[128];
    for (int s = 0; s < SEQ; ++s) {
        const bf16_t* pr = proj1 + (size_t)(b * SEQ + s) * ODD_IN;
        __syncthreads();
        qs[dv] = bf2f(pr[P1_Q + h * 128 + dv]); kss[dv] = bf2f(pr[P1_K + h * 128 + dv]) * ks;
        __syncthreads();
        const float v = bf2f(pr[P1_V + h * 128 + dv]);
        float o = 0.f;
#pragma unroll
        for (int d = 0; d < 128; ++d) { S[d] = g * S[d] + kss[d] * v; o += qs[d] * S[d]; }
        yr[(size_t)(b * SEQ + s) * 512 + h * 128 + dv] = o;
    }
}
__global__ void __launch_bounds__(256) k_ret_gn(const float* __restrict__ yr, const bf16_t* __restrict__ proj1, const float* __restrict__ gn, bf16_t* __restrict__ ymix) {
    const int w = blockIdx.x * 4 + (threadIdx.x >> 6), lane = threadIdx.x & 63;
    const int tkn = w >> 2, h = w & 3;
    const float a = yr[(size_t)tkn * 512 + h * 128 + lane], c = yr[(size_t)tkn * 512 + h * 128 + 64 + lane];
    const float mu = wave_sum(a + c) * (1.f / 128.f);
    const float da = a - mu, dc = c - mu;
    const float var = wave_sum(da * da + dc * dc) * (1.f / 128.f);
    const float rs = rsqrtf(var + EPS);
    const float g0 = bf2f(proj1[(size_t)tkn * ODD_IN + P1_G + h * 128 + lane]), g1 = bf2f(proj1[(size_t)tkn * ODD_IN + P1_G + h * 128 + 64 + lane]);
    ymix[(size_t)tkn * D + h * 128 + lane] = f2bf(silu(g0) * da * rs * gn[h * 128 + lane]);
    ymix[(size_t)tkn * D + h * 128 + 64 + lane] = f2bf(silu(g1) * dc * rs * gn[h * 128 + 64 + lane]);
}
__global__ void __launch_bounds__(256) k_conv(const bf16_t* __restrict__ proj1, const float* __restrict__ w, bf16_t* __restrict__ ymix) {
    const size_t i = (size_t)blockIdx.x * 256 + threadIdx.x;
    const int tkn = (int)(i >> 9), c = (int)(i & 511), s = tkn % SEQ;
    float y = 0.f;
#pragma unroll
    for (int j = 0; j < 3; ++j) {
        const int sp = s - 2 + j;
        if (sp >= 0) { const bf16_t* pr = proj1 + (size_t)(tkn - 2 + j) * ODD_IN; y += w[j * 512 + c] * bf2f(pr[P1_C + c]) * bf2f(pr[P1_H + c]); }
    }
    ymix[(size_t)tkn * D + 512 + c] = f2bf(bf2f(proj1[(size_t)tkn * ODD_IN + P1_B + c]) * y);
}

__global__ void __launch_bounds__(512) k_route(const float* __restrict__ x, const float* __restrict__ g, const float* __restrict__ router, bf16_t* __restrict__ xnm,
                                               unsigned* __restrict__ ctl, unsigned char* __restrict__ tab) {
    __shared__ unsigned lcnt[NE], lbase[NE];
    __shared__ int se[64][2], ss[64][2]; __shared__ float sg[64][2];
    const int wave = threadIdx.x >> 6, lane = threadIdx.x & 63;
    if (threadIdx.x < NE) lcnt[threadIdx.x] = 0u;
    __syncthreads();
    for (int it = 0; it < 8; ++it) {
        const int lt = wave * 8 + it, tkn = blockIdx.x * 64 + lt;
        const float* xr = x + (size_t)tkn * D;
        float v[16]; float s = 0.f;
#pragma unroll
        for (int j = 0; j < 16; ++j) { v[j] = xr[lane + 64 * j]; s += v[j] * v[j]; }
        const float rs = rsqrtf(wave_sum(s) * (1.f / D) + EPS);
        float lg[NE];
#pragma unroll
        for (int e = 0; e < NE; ++e) lg[e] = 0.f;
#pragma unroll
        for (int j = 0; j < 16; ++j) {
            const float hv = v[j] * rs * g[lane + 64 * j];
            xnm[(size_t)tkn * D + lane + 64 * j] = f2bf(hv);
#pragma unroll
            for (int e = 0; e < NE; ++e) lg[e] += hv * router[(size_t)(lane + 64 * j) * NE + e];
        }
#pragma unroll
        for (int e = 0; e < NE; ++e) lg[e] = wave_sum(lg[e]);
        int e0 = 0; float v0 = lg[0];
#pragma unroll
        for (int e = 1; e < NE; ++e) if (lg[e] > v0) { v0 = lg[e]; e0 = e; }
        int e1 = -1; float v1 = -INFINITY;
#pragma unroll
        for (int e = 0; e < NE; ++e) if (e != e0 && lg[e] > v1) { v1 = lg[e]; e1 = e; }
        const float p1 = __expf(v1 - v0), g0 = 1.f / (1.f + p1), g1 = p1 / (1.f + p1);
        if (lane == 0) { se[lt][0] = e0; se[lt][1] = e1; sg[lt][0] = g0; sg[lt][1] = g1; ss[lt][0] = (int)atomicAdd(&lcnt[e0], 1u); ss[lt][1] = (int)atomicAdd(&lcnt[e1], 1u); }
    }
    __syncthreads();
    if (threadIdx.x < NE) lbase[threadIdx.x] = atomicAdd(&ctl[CW_CNT + 64 * threadIdx.x], lcnt[threadIdx.x]);
    __syncthreads();
    if (threadIdx.x < 64) {
        const int lt = threadIdx.x, tkn = blockIdx.x * 64 + lt;
        int* ltok = (int*)(tab + TAB_LTOK); float* lgate = (float*)(tab + TAB_LGATE); int* tsel = (int*)(tab + TAB_TSEL);
#pragma unroll
        for (int k = 0; k < 2; ++k) { const int e = se[lt][k], slot = (int)lbase[e] + ss[lt][k]; ltok[e * T + slot] = tkn; lgate[e * T + slot] = sg[lt][k]; tsel[tkn * 4 + 2 * k] = e; tsel[tkn * 4 + 2 * k + 1] = slot; }
    }
}

__global__ void __launch_bounds__(256) k_final(const float* x3, const bf16_t* __restrict__ yp0, const bf16_t* __restrict__ yp1, const unsigned* __restrict__ ctl,
                                               const unsigned char* __restrict__ tab, const float* __restrict__ g, float* out) {
    const int tkn = blockIdx.x * 4 + (threadIdx.x >> 6), lane = threadIdx.x & 63;
    const int* tsel = (const int*)(tab + TAB_TSEL);
    size_t row[2];
#pragma unroll
    for (int k = 0; k < 2; ++k) {
        const int e = tsel[tkn * 4 + 2 * k], slot = tsel[tkn * 4 + 2 * k + 1];
        int tb = 0;
        for (int i = 0; i < e; ++i) tb += ((int)ctl[CW_CNT + 64 * i] + 255) >> 8;
        row[k] = (size_t)tb * 256 + slot;
    }
    float v[16]; float s = 0.f;
#pragma unroll
    for (int j = 0; j < 16; ++j) {
        const int c = lane + 64 * j;
        v[j] = x3[(size_t)tkn * D + c] + bf2f(yp0[row[0] * D + c]) + bf2f(yp1[row[0] * D + c]) + bf2f(yp0[row[1] * D + c]) + bf2f(yp1[row[1] * D + c]);
        s += v[j] * v[j];
    }
    const float rs = rsqrtf(wave_sum(s) * (1.f / D) + EPS);
#pragma unroll
    for (int j = 0; j < 16; ++j) out[(size_t)tkn * D + lane + 64 * j] = v[j] * rs * g[lane + 64 * j];
}


namespace pg8 {
#define PG8_LAS __attribute__((address_space(3)))
typedef short bf16x8 __attribute__((ext_vector_type(8)));
typedef float f32x4 __attribute__((ext_vector_type(4)));
typedef unsigned u32x4 __attribute__((ext_vector_type(4)));
typedef int i32x4 __attribute__((ext_vector_type(4)));
constexpr int BM = 256, BK = 64, HALF = 128, HTB = HALF * BK * 2  , STAGE_BYTES = 8 * HTB, NXCD = 8, WGM = 8;
__host__ __device__ __forceinline__ int lds_byte(int r, int c) { const int st = (r >> 4) * 2 + (c >> 5), rr = r & 15, cc = c & 31, ob = rr * 64 + cc * 2; return st * 1024 + (ob ^ (((ob >> 9) & 1) << 5)); }
__host__ __device__ __forceinline__ void stage_rc(int b, int& R, int& C) { const int st = b / 1024, sb = b % 1024, swz = sb ^ (((sb >> 9) & 1) << 5); R = (st >> 1) * 16 + swz / 64; C = (st & 1) * 32 + (swz % 64) / 2; }
__host__ __device__ __forceinline__ int perm32(int rho) { const int n = rho >> 4, i = rho & 15; return 8 * (i >> 2) + 4 * n + (i & 3); }

struct Unit { int pm, pn, be, s0, ko; };
struct Gemm { const void* A; const void* Bt; int lda, ldb, K; size_t bgroup; int sclA, sclB; };

struct StaticOrder {
    int nM, nN, nwg, G, c;
    __device__ void init(int nM_, int nN_, int G_, int c_) { nM = nM_; nN = nN_; nwg = nM * nN; G = G_; c = c_; }
    __device__ bool next(int i, Unit& u) const {
        const long L = (long)i * G + c; if (L >= nwg) return false;
        int wgid = (int)L; { const int q = nwg / NXCD, r = nwg % NXCD, xcd = wgid % NXCD, off = wgid / NXCD; wgid = (xcd < r ? xcd * (q + 1) : r * (q + 1) + (xcd - r) * q) + off; }
        const int nig = WGM * nN, gid = wgid / nig, fm = gid * WGM, gsz = (nM - fm) < WGM ? (nM - fm) : WGM;
        u.pm = fm + ((wgid % nig) % gsz); u.pn = (wgid % nig) / gsz; u.be = 0; u.s0 = 0; u.ko = 0; return true;
    }
};
struct MoeOrder {
    StaticOrder so; int tlo, nNr, kper; unsigned tbp0, tbp1;
    __device__ void init(const unsigned* cnt, int tlo_, int thi_, int nN, int ksplit, int kper_, int G, int c) {
        int t = 0; tbp0 = 0u; tbp1 = 0u;
#pragma unroll
        for (int e = 0; e < NE; ++e) { if (e < 4) tbp0 |= (unsigned)t << (8 * e); else tbp1 |= (unsigned)t << (8 * (e - 4));
            t += ((int)__hip_atomic_load(cnt + 64 * e, __ATOMIC_RELAXED, __HIP_MEMORY_SCOPE_AGENT) + 255) >> 8; }
        tlo = tlo_; nNr = nN; kper = kper_; const int hi = thi_ < t ? thi_ : t; so.init(hi > tlo_ ? hi - tlo_ : 0, nN * ksplit, G, c);
    }
    __device__ bool next(int i, Unit& u) const {
        if (!so.next(i, u)) return false;
        const int tile = tlo + u.pm; int e = 0, tbe = 0;
#pragma unroll
        for (int k = 1; k < NE; ++k) { const int tk = (int)(((k < 4 ? tbp0 : tbp1) >> (8 * (k & 3))) & 0xffu); if (tile >= tk) { e = k; tbe = tk; } }
        u.be = e; u.s0 = (tile - tbe) * 256; const int kh = u.pn / nNr; u.pn -= kh * nNr; u.ko = kh * kper; return true;
    }
};
struct ARowIdent {
    __device__ __forceinline__ unsigned direct(const Unit& u, int r) const { return (unsigned)(u.pm * BM + r); }
    __device__ __forceinline__ void prefetch(const Unit&, PG8_LAS unsigned*) const {}
    __device__ __forceinline__ unsigned get(const Unit& u, int r, const PG8_LAS unsigned*) const { return (unsigned)(u.pm * BM + r); }
};
struct ARowMoe {
    const int* ltok; const unsigned* cnt;
    __device__ __forceinline__ unsigned direct(const Unit& u, int r) const {
        const int slot = u.s0 + r, n = (int)__hip_atomic_load(cnt + 64 * u.be, __ATOMIC_RELAXED, __HIP_MEMORY_SCOPE_AGENT);
        return slot < n ? (unsigned)ltok[u.be * T + slot] : 0u;
    }
    __device__ __forceinline__ void prefetch(const Unit& u, PG8_LAS unsigned* tab) const { if (threadIdx.x < BM) tab[threadIdx.x] = direct(u, (int)threadIdx.x); }
    __device__ __forceinline__ unsigned get(const Unit&, int r, const PG8_LAS unsigned* tab) const { return tab[r]; }
};

__device__ __forceinline__ unsigned cvt_pk_bf16(float lo, float hi) { unsigned r; asm volatile("v_cvt_pk_bf16_f32 %0, %1, %2" : "=v"(r) : "v"(lo), "v"(hi)); return r; }
struct EpiBf16 {
    static constexpr bool PERM = true;
    bf16_t* O; int ldc;
    __device__ __forceinline__ void operator()(const f32x4 (&acc)[2][2][4][2], const Unit& u, int wr, int wc, int fr, int fq) const {
        const int row0 = u.pm * BM + wr * 64 + fr, col0 = u.pn * BM + wc * 32 + 8 * fq;
#pragma unroll
        for (int ai = 0; ai < 2; ++ai)
#pragma unroll
            for (int m = 0; m < 4; ++m) { bf16_t* rowp = O + (size_t)(row0 + ai * HALF + m * 16) * ldc + col0;
#pragma unroll
                for (int bj = 0; bj < 2; ++bj) { const f32x4 v0 = acc[ai][bj][m][0], v1 = acc[ai][bj][m][1];
                    u32x4 w; w.x = cvt_pk_bf16(v0[0], v0[1]); w.y = cvt_pk_bf16(v0[2], v0[3]); w.z = cvt_pk_bf16(v1[0], v1[1]); w.w = cvt_pk_bf16(v1[2], v1[3]);
                    *(u32x4*)(rowp + bj * HALF) = w; } }
    }
};
struct EpiRes {
    static constexpr bool PERM = false;
    const float* base; float* out; int ldc;
    __device__ __forceinline__ void operator()(const f32x4 (&acc)[2][2][4][2], const Unit& u, int wr, int wc, int fr, int fq) const {
        const int row0 = u.pm * BM + wr * 64 + fr, col0 = u.pn * BM + wc * 32 + 4 * fq;
#pragma unroll
        for (int ai = 0; ai < 2; ++ai) {
            f32x4 b[4][2][2];
#pragma unroll
            for (int m = 0; m < 4; ++m) { const size_t off = (size_t)(row0 + ai * HALF + m * 16) * ldc + col0;
#pragma unroll
                for (int bj = 0; bj < 2; ++bj)
#pragma unroll
                    for (int n = 0; n < 2; ++n) b[m][bj][n] = *(const f32x4*)(base + off + bj * HALF + n * 16); }
            asm volatile("" ::: "memory");
#pragma unroll
            for (int m = 0; m < 4; ++m) { const size_t off = (size_t)(row0 + ai * HALF + m * 16) * ldc + col0;
#pragma unroll
                for (int bj = 0; bj < 2; ++bj)
#pragma unroll
                    for (int n = 0; n < 2; ++n) *(f32x4*)(out + off + bj * HALF + n * 16) = b[m][bj][n] + acc[ai][bj][m][n]; }
            asm volatile("" ::: "memory");
        }
    }
};
__device__ __forceinline__ float silu_f(float v) { return v * __builtin_amdgcn_rcpf(1.f + __expf(-v)); }
struct EpiSwiglu {
    static constexpr bool PERM = true;
    bf16_t* O; int ldc;
    __device__ __forceinline__ void operator()(const f32x4 (&acc)[2][2][4][2], const Unit& u, int wr, int wc, int fr, int fq) const {
        const int row0 = u.pm * BM + wr * 64 + fr, col0 = u.pn * HALF + wc * 32 + 8 * fq;
#pragma unroll
        for (int ai = 0; ai < 2; ++ai)
#pragma unroll
            for (int m = 0; m < 4; ++m) { bf16_t* rowp = O + (size_t)(row0 + ai * HALF + m * 16) * ldc + col0;
                const f32x4 g0 = acc[ai][0][m][0], g1 = acc[ai][0][m][1], u0 = acc[ai][1][m][0], u1 = acc[ai][1][m][1];
                u32x4 w; w.x = cvt_pk_bf16(silu_f(g0[0]) * u0[0], silu_f(g0[1]) * u0[1]); w.y = cvt_pk_bf16(silu_f(g0[2]) * u0[2], silu_f(g0[3]) * u0[3]);
                w.z = cvt_pk_bf16(silu_f(g1[0]) * u1[0], silu_f(g1[1]) * u1[1]); w.w = cvt_pk_bf16(silu_f(g1[2]) * u1[2], silu_f(g1[3]) * u1[3]);
                *(u32x4*)rowp = w; }
    }
};
__device__ __forceinline__ float clamp448(float v) { return __builtin_fminf(__builtin_fmaxf(v, -448.f), 448.f); }
__device__ __forceinline__ unsigned pk4_fp8(float a, float b, float c, float d) { unsigned w = 0u; w = __builtin_amdgcn_cvt_pk_fp8_f32(clamp448(a), clamp448(b), w, false); w = __builtin_amdgcn_cvt_pk_fp8_f32(clamp448(c), clamp448(d), w, true); return w; }
struct EpiSwiglu8 {
    static constexpr bool PERM = true;
    unsigned char* O; int ldc; float oscale;
    __device__ __forceinline__ void operator()(const f32x4 (&acc)[2][2][4][2], const Unit& u, int wr, int wc, int fr, int fq) const {
        const int row0 = u.pm * BM + wr * 64 + fr, col0 = u.pn * HALF + wc * 32 + 8 * fq;
#pragma unroll
        for (int ai = 0; ai < 2; ++ai)
#pragma unroll
            for (int m = 0; m < 4; ++m) { unsigned char* rowp = O + (size_t)(row0 + ai * HALF + m * 16) * ldc + col0;
                const f32x4 g0 = acc[ai][0][m][0], g1 = acc[ai][0][m][1], u0 = acc[ai][1][m][0] * oscale, u1 = acc[ai][1][m][1] * oscale;
                typedef unsigned u32x2 __attribute__((ext_vector_type(2)));
                u32x2 w; w.x = pk4_fp8(silu_f(g0[0]) * u0[0], silu_f(g0[1]) * u0[1], silu_f(g0[2]) * u0[2], silu_f(g0[3]) * u0[3]);
                w.y = pk4_fp8(silu_f(g1[0]) * u1[0], silu_f(g1[1]) * u1[1], silu_f(g1[2]) * u1[2], silu_f(g1[3]) * u1[3]);
                *(u32x2*)rowp = w; }
    }
};
struct EpiMoeDn {
    static constexpr bool PERM = true;
    bf16_t* O0; bf16_t* O1; const float* lgate; const unsigned* cnt; int tlo;
    __device__ __forceinline__ void operator()(const f32x4 (&acc)[2][2][4][2], const Unit& u, int wr, int wc, int fr, int fq) const {
        const int r0 = wr * 64 + fr, col0 = u.pn * BM + wc * 32 + 8 * fq;
        const int n = (int)__hip_atomic_load(cnt + 64 * u.be, __ATOMIC_RELAXED, __HIP_MEMORY_SCOPE_AGENT);
#pragma unroll
        for (int ai = 0; ai < 2; ++ai)
#pragma unroll
            for (int m = 0; m < 4; ++m) { const int r = r0 + ai * HALF + m * 16, slot = u.s0 + r; const float gt = slot < n ? lgate[u.be * T + slot] : 0.f;
                bf16_t* rowp = (u.ko ? O1 : O0) + (size_t)((tlo + u.pm) * BM + r) * D + col0;
#pragma unroll
                for (int bj = 0; bj < 2; ++bj) { const f32x4 v0 = acc[ai][bj][m][0] * gt, v1 = acc[ai][bj][m][1] * gt;
                    u32x4 w; w.x = cvt_pk_bf16(v0[0], v0[1]); w.y = cvt_pk_bf16(v0[2], v0[3]); w.z = cvt_pk_bf16(v1[0], v1[1]); w.w = cvt_pk_bf16(v1[2], v1[3]);
                    *(u32x4*)(rowp + bj * HALF) = w; } }
    }
};

template <class Epi, class Sched, class ARow, bool ALIGN_EPI, bool F8 = false>
__device__ __forceinline__ void gemm_phase(PG8_LAS unsigned char* lds, PG8_LAS unsigned* rowtab, const Gemm g, const Sched& S, const ARow& AR, const Epi& E) {
    const int tid = threadIdx.x, wid = __builtin_amdgcn_readfirstlane(tid >> 6), lane = tid & 63, wr = wid >> 2, wc = wid & 3, fr = lane & 15, fq = lane >> 4;
    constexpr int ESZ = F8 ? 1 : 2;
    const int nt = g.K * ESZ / (BK * 2);
    int Rr[2]; unsigned Cb[2], voffB[2];
#pragma unroll
    for (int i = 0; i < 2; ++i) { int R, C; stage_rc(tid * 16 + i * 8192, R, C); const int Rb = Epi::PERM ? ((R & ~31) + perm32(R & 31)) : R;
        Rr[i] = R; Cb[i] = (unsigned)C * 2u; voffB[i] = (unsigned)(Rb * g.ldb * ESZ + C * 2); }
    const size_t kstep = (size_t)(BK * 2);
    const size_t hstepB = (size_t)HALF * g.ldb * ESZ;
    const unsigned lda2 = (unsigned)g.lda * ESZ;
    const unsigned ldsw = (unsigned)wid * 1024u;
    const int aoff = lds_byte(wr * 64 + fr, fq * 8), boff = lds_byte(wc * 32 + fr, fq * 8);
#define PG8_SA(b, h) (((b) * 2 + (h)) * HTB)
#define PG8_SB(b, h) ((4 + (b) * 2 + (h)) * HTB)
#define PG8_STAGE(bufoff, gbase, voff) do { _Pragma("unroll") for (int _i = 0; _i < 2; ++_i) \
        __builtin_amdgcn_global_load_lds((const unsigned*)((const char*)(gbase) + (voff)[_i]), (PG8_LAS unsigned*)(lds + (bufoff) + ldsw + _i * 8192), 16, 0, 0); } while (0)
#define PG8_LDA(dst, b, h) do { _Pragma("unroll") for (int m = 0; m < 4; ++m) _Pragma("unroll") for (int k = 0; k < 2; ++k) dst[m][k] = *(const PG8_LAS bf16x8*)(lds + PG8_SA(b, h) + aoff + m * 2048 + k * 1024); } while (0)
#define PG8_LDB(dst, b, h) do { _Pragma("unroll") for (int n = 0; n < 2; ++n) _Pragma("unroll") for (int k = 0; k < 2; ++k) dst[n][k] = *(const PG8_LAS bf16x8*)(lds + PG8_SB(b, h) + boff + n * 2048 + k * 1024); } while (0)
#define PG8_CAT(x) __builtin_shufflevector(__builtin_bit_cast(i32x4, x[0]), __builtin_bit_cast(i32x4, x[1]), 0, 1, 2, 3, 4, 5, 6, 7)
#define PG8_MMA(ai, bj, At, Bt) do { __builtin_amdgcn_s_setprio(1); _Pragma("unroll") for (int m = 0; m < 4; ++m) _Pragma("unroll") for (int n = 0; n < 2; ++n) { \
        if constexpr (F8) acc[ai][bj][m][n] = __builtin_amdgcn_mfma_scale_f32_16x16x128_f8f6f4(PG8_CAT(Bt[n]), PG8_CAT(At[m]), acc[ai][bj][m][n], 0, 0, 0, g.sclB, 0, g.sclA); \
        else { _Pragma("unroll") for (int k = 0; k < 2; ++k) acc[ai][bj][m][n] = __builtin_amdgcn_mfma_f32_16x16x32_bf16(Bt[n][k], At[m][k], acc[ai][bj][m][n], 0, 0, 0); } } \
        __builtin_amdgcn_s_setprio(0); } while (0)
#define PG8_WAIT_V(n) asm volatile("s_waitcnt vmcnt(" #n ")" ::: "memory")
#define PG8_WAIT_L(n) asm volatile("s_waitcnt lgkmcnt(" #n ")" ::: "memory")
#define PG8_BAR __builtin_amdgcn_s_barrier()
#define PG8_SCHED __builtin_amdgcn_sched_barrier(0)
    Unit cur, nxt; int ui = 0;
    if (!S.next(0, cur)) return;
    f32x4 acc[2][2][4][2];
#pragma unroll
    for (int a = 0; a < 2; ++a)
#pragma unroll
        for (int b = 0; b < 2; ++b)
#pragma unroll
            for (int m = 0; m < 4; ++m)
#pragma unroll
                for (int n = 0; n < 2; ++n) acc[a][b][m][n] = (f32x4){0.f, 0.f, 0.f, 0.f};
    bf16x8 At[4][2], B0[2][2], B1[2][2];
    unsigned offC[2][2];
#pragma unroll
    for (int h = 0; h < 2; ++h)
#pragma unroll
        for (int i = 0; i < 2; ++i) offC[h][i] = AR.direct(cur, h * HALF + Rr[i]) * lda2 + Cb[i];
    const char* cA = (const char*)g.A + (size_t)cur.ko * ESZ;
    const char* cB = (const char*)g.Bt + ((size_t)cur.be * g.bgroup + (size_t)cur.pn * BM * g.ldb + cur.ko) * ESZ;
    PG8_STAGE(PG8_SB(0, 0), cB, voffB); PG8_STAGE(PG8_SB(0, 1), cB + hstepB, voffB); PG8_STAGE(PG8_SA(0, 0), cA, offC[0]); PG8_STAGE(PG8_SA(0, 1), cA, offC[1]);
    if (wr == 1) PG8_BAR;
    PG8_WAIT_V(2); PG8_BAR;
    PG8_STAGE(PG8_SB(1, 0), cB + kstep, voffB); PG8_STAGE(PG8_SA(1, 0), cA + kstep, offC[0]); PG8_STAGE(PG8_SB(1, 1), cB + hstepB + kstep, voffB);
    PG8_WAIT_V(6); PG8_BAR;
    for (;;) {
        const bool has_next = S.next(ui + 1, nxt);
        if (has_next) AR.prefetch(nxt, rowtab);
        const char* nA = has_next ? (const char*)g.A + (size_t)nxt.ko * ESZ : cA;
        const char* nB = has_next ? (const char*)g.Bt + ((size_t)nxt.be * g.bgroup + (size_t)nxt.pn * BM * g.ldb + nxt.ko) * ESZ : cB;
        for (int t = 0; t < nt; t += 2) {
            const bool last = (t == nt - 2);
            const char* a1 = cA + (size_t)(t + 1) * kstep;
            const char* a2 = last ? nA : cA + (size_t)(t + 2) * kstep; const char* b2 = last ? nB : cB + (size_t)(t + 2) * kstep;
            const char* a3 = a2 + kstep; const char* b3 = b2 + kstep;
            PG8_LDB(B0, 0, 0); PG8_LDB(B1, 0, 1); PG8_SCHED; PG8_LDA(At, 0, 0); PG8_STAGE(PG8_SA(1, 1), a1, offC[1]);
            if (last && has_next) {
#pragma unroll
                for (int h = 0; h < 2; ++h)
#pragma unroll
                    for (int i = 0; i < 2; ++i) offC[h][i] = AR.get(nxt, h * HALF + Rr[i], rowtab) * lda2 + Cb[i]; }
            PG8_WAIT_V(8); PG8_WAIT_L(0); PG8_BAR; PG8_MMA(0, 0, At, B0); PG8_MMA(0, 1, At, B1); PG8_BAR; PG8_SCHED;
            PG8_LDA(At, 0, 1); PG8_STAGE(PG8_SB(0, 0), b2, voffB); PG8_STAGE(PG8_SB(0, 1), b2 + hstepB, voffB); PG8_STAGE(PG8_SA(0, 0), a2, offC[0]);
            PG8_WAIT_V(8); PG8_WAIT_L(0); PG8_BAR; PG8_MMA(1, 0, At, B0); PG8_MMA(1, 1, At, B1); PG8_BAR; PG8_SCHED;
            PG8_LDB(B0, 1, 0); PG8_LDB(B1, 1, 1); PG8_SCHED; PG8_LDA(At, 1, 0); PG8_STAGE(PG8_SA(0, 1), a2, offC[1]);
            PG8_WAIT_V(8); PG8_WAIT_L(0); PG8_BAR; PG8_MMA(0, 0, At, B0); PG8_MMA(0, 1, At, B1); PG8_BAR; PG8_SCHED;
            PG8_LDA(At, 1, 1); PG8_STAGE(PG8_SB(1, 0), b3, voffB); PG8_STAGE(PG8_SB(1, 1), b3 + hstepB, voffB); PG8_STAGE(PG8_SA(1, 0), a3, offC[0]);
            PG8_WAIT_V(8); PG8_WAIT_L(0); PG8_BAR; PG8_MMA(1, 0, At, B0); PG8_MMA(1, 1, At, B1); PG8_BAR; PG8_SCHED;
        }
        if constexpr (ALIGN_EPI) { if (wr == 0) PG8_BAR; }
        E(acc, cur, wr, wc, fr, fq);
        if (!has_next) break;
#pragma unroll
        for (int a = 0; a < 2; ++a)
#pragma unroll
            for (int b = 0; b < 2; ++b)
#pragma unroll
                for (int m = 0; m < 4; ++m)
#pragma unroll
                    for (int n = 0; n < 2; ++n) acc[a][b][m][n] = (f32x4){0.f, 0.f, 0.f, 0.f};
        cur = nxt; cA = nA; cB = nB; ++ui;
        if constexpr (ALIGN_EPI) { if (wr == 1) PG8_BAR; }
    }
    PG8_WAIT_V(0);
    if constexpr (!ALIGN_EPI) { if (wr == 0) PG8_BAR; }
    PG8_BAR;
#undef PG8_SA
#undef PG8_SB
#undef PG8_STAGE
#undef PG8_LDA
#undef PG8_LDB
#undef PG8_MMA
#undef PG8_CAT
#undef PG8_WAIT_V
#undef PG8_WAIT_L
#undef PG8_BAR
#undef PG8_SCHED
}
}


namespace att {
typedef float f32x16 __attribute__((ext_vector_type(16)));
typedef float f32x4 __attribute__((ext_vector_type(4)));
typedef short bf16x8 __attribute__((ext_vector_type(8)));
typedef short s16x4 __attribute__((ext_vector_type(4)));
typedef unsigned u32x4 __attribute__((ext_vector_type(4)));
#define ATT_LAS __attribute__((address_space(3)))
constexpr int KBUF = 13312, VBUF = 8192, L_K0 = 0, L_V0 = 2 * KBUF, L_SCR = L_V0 + 2 * VBUF, L_OST = L_SCR + 8 * 256, L_END = L_OST + 8 * 4096;
constexpr float LOG2E = 1.4426950408889634f;
__device__ __forceinline__ s16x4 trread(const ATT_LAS char* p) { return __builtin_bit_cast(s16x4, __builtin_amdgcn_ds_read_tr16_b64_v4i16((ATT_LAS s16x4*)p)); }
__device__ __forceinline__ unsigned cvtpk(float lo, float hi) { unsigned r; asm volatile("v_cvt_pk_bf16_f32 %0, %1, %2" : "=v"(r) : "v"(lo), "v"(hi)); return r; }
#define ATT_PACK8(P, B) __builtin_bit_cast(bf16x8, (u32x4){cvtpk(P[(B) + 0], P[(B) + 1]), cvtpk(P[(B) + 2], P[(B) + 3]), cvtpk(P[(B) + 4], P[(B) + 5]), cvtpk(P[(B) + 6], P[(B) + 7])})
__device__ __forceinline__ bf16x8 vfrag(const ATT_LAS char* vp) { const s16x4 lo = trread(vp), hi = trread(vp + 8 * 64); return (bf16x8){lo[0], lo[1], lo[2], lo[3], hi[0], hi[1], hi[2], hi[3]}; }

template <int NS, int KSTR, bool ALIBI>
__device__ __forceinline__ void tile(const ATT_LAS char* Kb, const ATT_LAS char* Vb, const bf16x8 (&qf)[NS], f32x16 (&o)[2], float& m, float& l, ATT_LAS float* scr, float c0, float slope2, float dq, int lane) {
    const int r32 = lane & 31, h = lane >> 5;
    f32x16 p0, p1;
#pragma unroll
    for (int i = 0; i < 16; ++i) { p0[i] = 0.f; p1[i] = 0.f; }
    const ATT_LAS char* ka = Kb + r32 * KSTR + h * 16;
#pragma unroll
    for (int s2 = 0; s2 < NS; ++s2) {
        const bf16x8 a0 = *(const ATT_LAS bf16x8*)(ka + s2 * 32), a1 = *(const ATT_LAS bf16x8*)(ka + 32 * KSTR + s2 * 32);
        p0 = __builtin_amdgcn_mfma_f32_32x32x16_bf16(a0, qf[s2], p0, 0, 0, 0);
        p1 = __builtin_amdgcn_mfma_f32_32x32x16_bf16(a1, qf[s2], p1, 0, 0, 0);
    }
    float mx = -INFINITY;
#pragma unroll
    for (int i = 0; i < 16; ++i) {
        float v0 = p0[i] * c0, v1 = p1[i] * c0;
        if (ALIBI) { const float kr = (float)((i & 3) + 8 * (i >> 2)); v0 -= slope2 * fabsf(dq - kr); v1 -= slope2 * fabsf(dq - 32.f - kr); }
        p0[i] = v0; p1[i] = v1; mx = fmaxf(mx, fmaxf(v0, v1));
    }
    mx = fmaxf(mx, __shfl_xor(mx, 32));
    const float mn = fmaxf(m, mx), alpha = __builtin_amdgcn_exp2f(m - mn); m = mn;
    float ps = 0.f;
#pragma unroll
    for (int i = 0; i < 16; ++i) { p0[i] = __builtin_amdgcn_exp2f(p0[i] - mn); p1[i] = __builtin_amdgcn_exp2f(p1[i] - mn); ps += p0[i] + p1[i]; }
    l = l * alpha + ps;
    if (h == 0) scr[r32] = alpha;
#pragma unroll
    for (int g = 0; g < 4; ++g) { const f32x4 a4 = *(const ATT_LAS f32x4*)(scr + 8 * g + 4 * h);
#pragma unroll
        for (int j = 0; j < 4; ++j) { o[0][4 * g + j] *= a4[j]; o[1][4 * g + j] *= a4[j]; } }
    const int i16 = lane & 15, g1 = (lane >> 4) & 1;
    const ATT_LAS char* vb = Vb + (4 * h + (i16 >> 2)) * 64 + (16 * g1 + 4 * (i16 & 3)) * 2;
    {   const bf16x8 A = ATT_PACK8(p0, 0);
        o[0] = __builtin_amdgcn_mfma_f32_32x32x16_bf16(A, vfrag(vb + 0 * 64), o[0], 0, 0, 0);
        o[1] = __builtin_amdgcn_mfma_f32_32x32x16_bf16(A, vfrag(vb + 4096 + 0 * 64), o[1], 0, 0, 0); }
    {   const bf16x8 A = ATT_PACK8(p0, 8);
        o[0] = __builtin_amdgcn_mfma_f32_32x32x16_bf16(A, vfrag(vb + 16 * 64), o[0], 0, 0, 0);
        o[1] = __builtin_amdgcn_mfma_f32_32x32x16_bf16(A, vfrag(vb + 4096 + 16 * 64), o[1], 0, 0, 0); }
    {   const bf16x8 A = ATT_PACK8(p1, 0);
        o[0] = __builtin_amdgcn_mfma_f32_32x32x16_bf16(A, vfrag(vb + 32 * 64), o[0], 0, 0, 0);
        o[1] = __builtin_amdgcn_mfma_f32_32x32x16_bf16(A, vfrag(vb + 4096 + 32 * 64), o[1], 0, 0, 0); }
    {   const bf16x8 A = ATT_PACK8(p1, 8);
        o[0] = __builtin_amdgcn_mfma_f32_32x32x16_bf16(A, vfrag(vb + 48 * 64), o[0], 0, 0, 0);
        o[1] = __builtin_amdgcn_mfma_f32_32x32x16_bf16(A, vfrag(vb + 4096 + 48 * 64), o[1], 0, 0, 0); }
}
__device__ __forceinline__ void finish(f32x16 (&o)[2], float l, ATT_LAS float* scr, ATT_LAS bf16_t* stg, bf16_t* O, int tok0, int lane) {
    const int r32 = lane & 31, h = lane >> 5;
    const float lt = l + __shfl_xor(l, 32);
    if (h == 0) scr[r32] = 1.f / lt;
#pragma unroll
    for (int g = 0; g < 4; ++g) { const f32x4 a4 = *(const ATT_LAS f32x4*)(scr + 8 * g + 4 * h);
#pragma unroll
        for (int j = 0; j < 4; ++j) { const int q = 8 * g + 4 * h + j;
            stg[q * 64 + r32] = f2bf(o[0][4 * g + j] * a4[j]); stg[q * 64 + 32 + r32] = f2bf(o[1][4 * g + j] * a4[j]); } }
#pragma unroll
    for (int it = 0; it < 4; ++it) { const int row = it * 8 + (lane >> 3), ch = lane & 7;
        const u32x4 v = *(const ATT_LAS u32x4*)(stg + row * 64 + ch * 8);
        *(u32x4*)(O + (size_t)(tok0 + row) * 1024 + ch * 8) = v; }
}

__device__ __forceinline__ void mla_unit(ATT_LAS char* sm, const bf16_t* QM, const bf16_t* KVM, const bf16_t* KROPE, const float* ropecs, bf16_t* YMIX, int b, int hd, int qb) {
    const int tid = threadIdx.x, lane = tid & 63, wave = __builtin_amdgcn_readfirstlane(tid >> 6), r32 = lane & 31, h = lane >> 5;
    const int q0 = 256 * qb, NT = 4 * qb + 4, cw = 4 * qb + (wave >> 1);
    const int tokw = b * SEQ + q0 + 32 * wave;
    ATT_LAS float* scr = (ATT_LAS float*)(sm + L_SCR + wave * 256);
    const size_t kvoff = (size_t)(b * SEQ + (tid >> 3)) * 1024 + hd * 128 + (tid & 7) * 8;
    const size_t kroff = (size_t)(b * SEQ + (tid >> 2)) * 32 + (tid & 3) * 8;
    const int kdst = (tid >> 3) * 208 + (tid & 7) * 16, krdst = (tid >> 2) * 208 + 128 + (tid & 3) * 16, vdst = ((tid & 7) >> 2) * 4096 + (tid >> 3) * 64 + (tid & 3) * 16;
    u32x4 kn, kr = (u32x4){0u, 0u, 0u, 0u}, vv;
#define MLA_GLOAD(t) do { kn = *(const u32x4*)(KVM + kvoff + (size_t)(t) * 64 * 1024); vv = *(const u32x4*)(KVM + kvoff + (size_t)(t) * 64 * 1024 + 64); \
        if (tid < 256) kr = *(const u32x4*)(KROPE + kroff + (size_t)(t) * 64 * 32); } while (0)
#define MLA_LWRITE(bufi) do { *(ATT_LAS u32x4*)(sm + L_K0 + (bufi) * KBUF + kdst) = kn; if (tid < 256) *(ATT_LAS u32x4*)(sm + L_K0 + (bufi) * KBUF + krdst) = kr; \
        *(ATT_LAS u32x4*)(sm + L_V0 + (bufi) * VBUF + vdst) = vv; } while (0)
    MLA_GLOAD(0);
    bf16x8 qf[6];
    const bf16_t* qp = QM + (size_t)(tokw + r32) * 768 + hd * 96 + 8 * h;
#pragma unroll
    for (int s2 = 0; s2 < 6; ++s2) qf[s2] = *(const bf16x8*)(qp + 16 * s2);
    {   const float* cs = ropecs + (size_t)(tokw + r32) * 32 + 8 * h;
        const f32x4 c0 = *(const f32x4*)cs, c1 = *(const f32x4*)(cs + 4), s0 = *(const f32x4*)(cs + 16), s1 = *(const f32x4*)(cs + 20);
        float t1[8], t2[8];
#pragma unroll
        for (int j = 0; j < 8; ++j) { t1[j] = bf2f((bf16_t)qf[4][j]); t2[j] = bf2f((bf16_t)qf[5][j]); }
#pragma unroll
        for (int j = 0; j < 8; ++j) { const float c = j < 4 ? c0[j & 3] : c1[j & 3], sn = j < 4 ? s0[j & 3] : s1[j & 3];
            qf[4][j] = (short)f2bf(t1[j] * c - t2[j] * sn); qf[5][j] = (short)f2bf(t2[j] * c + t1[j] * sn); } }
    f32x16 o[2];
#pragma unroll
    for (int i = 0; i < 16; ++i) { o[0][i] = 0.f; o[1][i] = 0.f; }
    float m = -1e30f, l = 0.f;
    MLA_LWRITE(0);
    __syncthreads();
    for (int t = 0; t < NT; ++t) {
        if (t + 1 < NT) MLA_GLOAD(t + 1);
        if (t <= cw) tile<6, 208, false>(sm + L_K0 + (t & 1) * KBUF, sm + L_V0 + (t & 1) * VBUF, qf, o, m, l, scr, 0.10206207261596577f * LOG2E, 0.f, 0.f, lane);
        if (t + 1 < NT) MLA_LWRITE((t + 1) & 1);
        __syncthreads();
    }
    finish(o, l, scr, (ATT_LAS bf16_t*)(sm + L_OST + wave * 4096), YMIX + 512 + hd * 64, tokw, lane);
#undef MLA_GLOAD
#undef MLA_LWRITE
}
__device__ __forceinline__ void swa_unit(ATT_LAS char* sm, const bf16_t* PROJ0, const float* sinks, bf16_t* YMIX, int b, int n, int hk) {
    const int tid = threadIdx.x, lane = tid & 63, wave = __builtin_amdgcn_readfirstlane(tid >> 6), r32 = lane & 31, h = lane >> 5;
    const int head = hk * 4 + (wave >> 1), qi0 = 32 * (wave & 1), tokw = b * SEQ + 64 * n + qi0;
    ATT_LAS float* scr = (ATT_LAS float*)(sm + L_SCR + wave * 256);
    const int t_lo = n >= 2 ? 0 : 2 - n;
    const size_t koff = (size_t)(b * SEQ + (tid >> 3)) * EVEN_INP + P0_KA + hk * 64 + (tid & 7) * 8;
    const int kdst = (tid >> 3) * 144 + (tid & 7) * 16, vdst = ((tid & 7) >> 2) * 4096 + (tid >> 3) * 64 + (tid & 3) * 16;
    u32x4 kn, vv;
#define SWA_GLOAD(t) do { const size_t o_ = koff + (size_t)(n - 2 + (t)) * 64 * EVEN_INP; kn = *(const u32x4*)(PROJ0 + o_); vv = *(const u32x4*)(PROJ0 + o_ + (P0_VA - P0_KA)); } while (0)
#define SWA_LWRITE(bufi) do { *(ATT_LAS u32x4*)(sm + L_K0 + (bufi) * KBUF + kdst) = kn; *(ATT_LAS u32x4*)(sm + L_V0 + (bufi) * VBUF + vdst) = vv; } while (0)
    SWA_GLOAD(t_lo);
    bf16x8 qf[4];
    const bf16_t* qp = PROJ0 + (size_t)(tokw + r32) * EVEN_INP + P0_QA + head * 64 + 8 * h;
#pragma unroll
    for (int s2 = 0; s2 < 4; ++s2) qf[s2] = *(const bf16x8*)(qp + 16 * s2);
    f32x16 o[2];
#pragma unroll
    for (int i = 0; i < 16; ++i) { o[0][i] = 0.f; o[1][i] = 0.f; }
    float m = sinks[head] * LOG2E, l = h == 0 ? 1.f : 0.f;
    const float slope2 = exp2f(-(float)(head + 1)) * LOG2E;
    SWA_LWRITE(t_lo & 1);
    __syncthreads();
    for (int t = t_lo; t < 3; ++t) {
        if (t + 1 < 3) SWA_GLOAD(t + 1);
        tile<4, 144, true>(sm + L_K0 + (t & 1) * KBUF, sm + L_V0 + (t & 1) * VBUF, qf, o, m, l, scr, 0.125f * LOG2E, slope2, (float)(qi0 + r32 + 128 - 64 * t - 4 * h), lane);
        if (t + 1 < 3) SWA_LWRITE((t + 1) & 1);
        __syncthreads();
    }
    finish(o, l, scr, (ATT_LAS bf16_t*)(sm + L_OST + wave * 4096), YMIX + head * 64, tokw, lane);
#undef SWA_GLOAD
#undef SWA_LWRITE
}
}


namespace ret {
using att::f32x16; using att::f32x4; using att::bf16x8; using att::s16x4; using att::u32x4; using att::trread; using att::cvtpk; using att::vfrag;
__device__ __forceinline__ bf16x8 nfrag(const ATT_LAS char* p) { const s16x4 lo = trread(p), hi = trread(p + 4 * 64); return (bf16x8){lo[0], lo[1], lo[2], lo[3], hi[0], hi[1], hi[2], hi[3]}; }
__device__ __forceinline__ float log2g(int hh) { return log2f(1.f - exp2f(-5.f - (float)hh)); }

__device__ __forceinline__ void ret1_unit(ATT_LAS char* sm, const bf16_t* PROJ1, bf16_t* RKV, int u) {
    const int tid = threadIdx.x, lane = tid & 63, wave = __builtin_amdgcn_readfirstlane(tid >> 6), r32 = lane & 31, h = lane >> 5, i16 = lane & 15, g1 = (lane >> 4) & 1;
    const int b = u >> 7, hh = (u >> 5) & 3, n = u & 31;
    const float lg = log2g(hh);
    __syncthreads();
#pragma unroll
    for (int k = 0; k < 2; ++k) {
        const int c = tid + 512 * k, t = c >> 4, ch = c & 15;
        const bf16_t* src = PROJ1 + (size_t)(b * SEQ + 64 * n + t) * ODD_IN + hh * 128 + ch * 8;
        const u32x4 kv = *(const u32x4*)(src + P1_K), vv = *(const u32x4*)(src + P1_V);
        const float fac = 0.08838834764831845f * exp2f(lg * (float)(63 - t));
        u32x4 ks;
#pragma unroll
        for (int j = 0; j < 4; ++j) { const unsigned w = kv[j]; ks[j] = cvtpk(__uint_as_float(w << 16) * fac, __uint_as_float(w & 0xffff0000u) * fac); }
        const int dst = (ch >> 2) * 4096 + t * 64 + (ch & 3) * 16;
        *(ATT_LAS u32x4*)(sm + dst) = ks; *(ATT_LAS u32x4*)(sm + 16384 + dst) = vv;
    }
    __syncthreads();
    const int dkb = wave >> 1, dvb = 2 * (wave & 1);
    f32x16 acc[2];
#pragma unroll
    for (int i = 0; i < 16; ++i) { acc[0][i] = 0.f; acc[1][i] = 0.f; }
    const int fo = (8 * h + (i16 >> 2)) * 64 + (16 * g1 + 4 * (i16 & 3)) * 2;
#pragma unroll
    for (int s2 = 0; s2 < 4; ++s2) {
        const bf16x8 A = nfrag(sm + dkb * 4096 + s2 * 16 * 64 + fo);
        acc[0] = __builtin_amdgcn_mfma_f32_32x32x16_bf16(A, nfrag(sm + 16384 + dvb * 4096 + s2 * 16 * 64 + fo), acc[0], 0, 0, 0);
        acc[1] = __builtin_amdgcn_mfma_f32_32x32x16_bf16(A, nfrag(sm + 16384 + (dvb + 1) * 4096 + s2 * 16 * 64 + fo), acc[1], 0, 0, 0);
    }
    bf16_t* dst = RKV + (size_t)u * 16384 + 32 * dvb + r32;
#pragma unroll
    for (int i = 0; i < 16; ++i) { const int dk = 32 * dkb + (i & 3) + 8 * (i >> 2) + 4 * h; dst[dk * 128] = f2bf(acc[0][i]); dst[dk * 128 + 32] = f2bf(acc[1][i]); }
}
__device__ __forceinline__ void ret2_elems(bf16_t* RKV, int gt, int NGT) {
    for (int e = gt; e < BATCH * 4 * 4096; e += NGT) {
        const int bh = e >> 12, el = (e & 4095) * 4;
        const float cd = exp2f(64.f * log2g(bh & 3));
        float st[4] = {0.f, 0.f, 0.f, 0.f};
        unsigned long long* p = (unsigned long long*)(RKV + (size_t)bh * 32 * 16384 + el);
#pragma unroll 8
        for (int n = 0; n < 32; ++n) {
            const unsigned long long x = p[(size_t)n * 4096];
            p[(size_t)n * 4096] = (unsigned long long)cvtpk(st[0], st[1]) | ((unsigned long long)cvtpk(st[2], st[3]) << 32);
            st[0] = cd * st[0] + __uint_as_float((unsigned)x << 16); st[1] = cd * st[1] + __uint_as_float((unsigned)x & 0xffff0000u);
            st[2] = cd * st[2] + __uint_as_float((unsigned)(x >> 32) << 16); st[3] = cd * st[3] + __uint_as_float((unsigned)(x >> 32) & 0xffff0000u);
        }
    }
}
constexpr int R3_Q = 0, R3_K = 17408, R3_V = 34816, R3_R = 51200, R3_O = 83968, R3_END = R3_O + 64 * 132 * 4;
__device__ __forceinline__ void ret3_unit(ATT_LAS char* sm, const bf16_t* PROJ1, const bf16_t* RKV, const float* gn, bf16_t* YMIX, int u) {
    const int tid = threadIdx.x, lane = tid & 63, wave = __builtin_amdgcn_readfirstlane(tid >> 6), r32 = lane & 31, h = lane >> 5, i16 = lane & 15, g1 = (lane >> 4) & 1;
    const int b = u >> 7, hh = (u >> 5) & 3, n = u & 31, tok0 = b * SEQ + 64 * n;
    const float lg = log2g(hh);
    __syncthreads();
#pragma unroll
    for (int k = 0; k < 2; ++k) {
        const int c = tid + 512 * k, t = c >> 4, ch = c & 15;
        const bf16_t* src = PROJ1 + (size_t)(tok0 + t) * ODD_IN + hh * 128 + ch * 8;
        *(ATT_LAS u32x4*)(sm + R3_Q + t * 272 + ch * 16) = *(const u32x4*)(src + P1_Q);
        *(ATT_LAS u32x4*)(sm + R3_K + t * 272 + ch * 16) = *(const u32x4*)(src + P1_K);
        *(ATT_LAS u32x4*)(sm + R3_V + (ch >> 2) * 4096 + t * 64 + (ch & 3) * 16) = *(const u32x4*)(src + P1_V);
    }
#pragma unroll
    for (int k = 0; k < 4; ++k) {
        const int c = tid + 512 * k, d = c >> 4, ch = c & 15;
        *(ATT_LAS u32x4*)(sm + R3_R + (ch >> 2) * 8192 + d * 64 + (ch & 3) * 16) = *(const u32x4*)(RKV + (size_t)u * 16384 + d * 128 + ch * 8);
    }
    __syncthreads();
    const int qb = wave >> 2, dvb = wave & 3;
    bf16x8 qf[8];
#pragma unroll
    for (int s2 = 0; s2 < 8; ++s2) qf[s2] = *(const ATT_LAS bf16x8*)(sm + R3_Q + (32 * qb + r32) * 272 + s2 * 32 + h * 16);
    f32x16 acc, accx;
#pragma unroll
    for (int i = 0; i < 16; ++i) { acc[i] = 0.f; accx[i] = 0.f; }
    const int fv = (4 * h + (i16 >> 2)) * 64 + (16 * g1 + 4 * (i16 & 3)) * 2;
    for (int kb = 0; kb <= qb; ++kb) {
        f32x16 p;
#pragma unroll
        for (int i = 0; i < 16; ++i) p[i] = 0.f;
#pragma unroll
        for (int s2 = 0; s2 < 8; ++s2) { const bf16x8 a = *(const ATT_LAS bf16x8*)(sm + R3_K + (32 * kb + r32) * 272 + s2 * 32 + h * 16); p = __builtin_amdgcn_mfma_f32_32x32x16_bf16(a, qf[s2], p, 0, 0, 0); }
        const int q = 32 * qb + r32;
#pragma unroll
        for (int i = 0; i < 16; ++i) { const int key = 32 * kb + (i & 3) + 8 * (i >> 2) + 4 * h, df = q - key; p[i] = df >= 0 ? p[i] * 0.08838834764831845f * exp2f(lg * (float)df) : 0.f; }
        { const bf16x8 A = ATT_PACK8(p, 0); acc = __builtin_amdgcn_mfma_f32_32x32x16_bf16(A, vfrag(sm + R3_V + dvb * 4096 + (32 * kb) * 64 + fv), acc, 0, 0, 0); }
        { const bf16x8 A = ATT_PACK8(p, 8); acc = __builtin_amdgcn_mfma_f32_32x32x16_bf16(A, vfrag(sm + R3_V + dvb * 4096 + (32 * kb + 16) * 64 + fv), acc, 0, 0, 0); }
    }
    const int fn = (8 * h + (i16 >> 2)) * 64 + (16 * g1 + 4 * (i16 & 3)) * 2;
#pragma unroll
    for (int s2 = 0; s2 < 8; ++s2) accx = __builtin_amdgcn_mfma_f32_32x32x16_bf16(qf[s2], nfrag(sm + R3_R + dvb * 8192 + s2 * 16 * 64 + fn), accx, 0, 0, 0);
    ATT_LAS float* Os = (ATT_LAS float*)(sm + R3_O);
#pragma unroll
    for (int i = 0; i < 16; ++i) { const int q = 32 * qb + (i & 3) + 8 * (i >> 2) + 4 * h; Os[q * 132 + 32 * dvb + r32] = acc[i] + accx[i] * exp2f(lg * (float)(q + 1)); }
    __syncthreads();
#pragma unroll
    for (int k = 0; k < 8; ++k) {
        const int q = 8 * wave + k, tkn = tok0 + q;
        const float a = Os[q * 132 + lane], c = Os[q * 132 + 64 + lane];
        const float mu = wave_sum(a + c) * (1.f / 128.f), da = a - mu, dc = c - mu;
        const float rs = rsqrtf(wave_sum(da * da + dc * dc) * (1.f / 128.f) + EPS);
        const bf16_t* gp = PROJ1 + (size_t)tkn * ODD_IN + P1_G + hh * 128;
        YMIX[(size_t)tkn * D + hh * 128 + lane] = f2bf(silu(bf2f(gp[lane])) * da * rs * gn[hh * 128 + lane]);
        YMIX[(size_t)tkn * D + hh * 128 + 64 + lane] = f2bf(silu(bf2f(gp[64 + lane])) * dc * rs * gn[hh * 128 + 64 + lane]);
    }
}
}

#define LAS __attribute__((address_space(3)))
#define GAS __attribute__((address_space(1)))
typedef unsigned v4u __attribute__((ext_vector_type(4)));
#define LDS_WAIT() asm volatile("s_waitcnt lgkmcnt(0)" ::: "memory")
__device__ __forceinline__ unsigned pk2(float lo, float hi) { return (unsigned)f2bf(lo) | ((unsigned)f2bf(hi) << 16); }
constexpr int NWAVES = 8, LDS_BYTES = 147456, RING_BYTES = 131072, MISC_OFF = RING_BYTES + 320, ROWTAB_OFF = RING_BYTES + 1024;
constexpr int CW_BAR = 4096;

#define XB_TMO      128
#define XB_XCNT(j)  (256  + 64 * (j))
#define XB_XSUB(j)  (1280 + 64 * (j))
#define XB_XGEN(j)  (2304 + 64 * (j))
#define XB_TOP      3328
#define XB_TOPGEN   3392
#define XCD_BAR_WORDS 3456
#define XB_SPIN_CAP (1u << 18)
__device__ __forceinline__ unsigned xb_ld(unsigned* p)              { return __hip_atomic_load(p, __ATOMIC_RELAXED, __HIP_MEMORY_SCOPE_AGENT); }
__device__ __forceinline__ unsigned xb_add(unsigned* p, unsigned v) { return __hip_atomic_fetch_add(p, v, __ATOMIC_RELAXED, __HIP_MEMORY_SCOPE_AGENT); }
__device__ __forceinline__ unsigned xb_xcc_id() { return (unsigned)__builtin_amdgcn_s_getreg((3 << 11) | 20) & 0xFu; }
#define XB_SPIN(cond, bar) do { unsigned _sp = 0; while (cond) { __builtin_amdgcn_s_sleep(1); \
    if ((++_sp & 255u) == 0u) { if (xb_ld(&(bar)[XB_TMO])) break; if (_sp > XB_SPIN_CAP) { atomicAdd(&(bar)[XB_TMO], 1u); break; } } } } while (0)
struct XcdBarrier {
    unsigned* bar; unsigned x;
    volatile LAS unsigned* st;
};
__device__ __forceinline__ XcdBarrier xcd_barrier_post(unsigned* bar, volatile LAS unsigned* st) {
    XcdBarrier b; b.bar = bar; b.x = xb_xcc_id(); b.st = st;
    if (threadIdx.x == 0) (void)xb_add(&bar[XB_XCNT(b.x)], 1u);
    return b;
}
__device__ __forceinline__ void xcd_barrier_complete(unsigned* bar, unsigned x, unsigned& nloc, unsigned& nx) {
    const unsigned G = gridDim.x * gridDim.y * gridDim.z;
    unsigned sum, cnt, mine, sp = 0u;
    for (;;) {
        sum = 0u; cnt = 0u; mine = 0u;
#pragma unroll
        for (unsigned j = 0; j < 16; ++j) { const unsigned c = xb_ld(&bar[XB_XCNT(j)]); sum += c; cnt += (c > 0u) ? 1u : 0u; mine = (j == x) ? c : mine; }
        if (sum == G) break;
        __builtin_amdgcn_s_sleep(1);
        if ((++sp & 255u) == 0u) { if (xb_ld(&bar[XB_TMO])) break; if (sp > XB_SPIN_CAP) { atomicAdd(&bar[XB_TMO], 1u); break; } }
    }
    nloc = mine > 0u ? mine : 1u; nx = cnt > 0u ? cnt : 1u;
}
__device__ __forceinline__ void xcd_barrier(const XcdBarrier& b) {
    asm volatile("s_waitcnt vmcnt(0)" ::: "memory");
    __syncthreads();
    if (threadIdx.x == 0) {
        unsigned* bar = b.bar;
        __builtin_amdgcn_s_waitcnt(0);
        unsigned nloc = b.st[0], nx = b.st[1];
        if (nloc == 0u) { xcd_barrier_complete(bar, b.x, nloc, nx); b.st[0] = nloc; b.st[1] = nx; }
        const unsigned old = xb_add(&bar[XB_XSUB(b.x)], 1u);
        const unsigned gen = old / nloc;
        if (old + 1u == (gen + 1u) * nloc) {
            __builtin_amdgcn_fence(__ATOMIC_RELEASE, "agent");
            asm volatile("s_waitcnt vmcnt(0)" ::: "memory");
            const unsigned og = xb_add(&bar[XB_TOP], 1u);
            const unsigned tg = og / nx;
            if (og + 1u == (tg + 1u) * nx) xb_add(&bar[XB_TOPGEN], 1u);
            else XB_SPIN(xb_ld(&bar[XB_TOPGEN]) == tg, bar);
            __builtin_amdgcn_fence(__ATOMIC_ACQUIRE, "agent");
            xb_add(&bar[XB_XGEN(b.x)], 1u);
            asm volatile("s_waitcnt vmcnt(0)" ::: "memory");
        } else {
            XB_SPIN(xb_ld(&bar[XB_XGEN(b.x)]) == gen, bar);
            __builtin_amdgcn_fence(__ATOMIC_ACQUIRE, "agent");
            asm volatile("s_waitcnt vmcnt(0)" ::: "memory");
        }
    }
    __syncthreads();
}

template <class RM>
__device__ __forceinline__ void p0_item(const float* W, int K, int N, bf16_t* WT, RM rm, LAS float* scr, int item, int lane) {
    const int nblk = N / 32, kb = item / nblk, nb = item % nblk, k0 = 64 * kb, n0 = 32 * nb;
#pragma unroll 8
    for (int i = 0; i < 32; ++i) { const int kk = 2 * i + (lane >> 5); scr[kk * 33 + (lane & 31)] = W[(size_t)(k0 + kk) * N + n0 + (lane & 31)]; }
    LDS_WAIT(); asm volatile("" ::: "memory");
    const int c = lane & 7;
#pragma unroll
    for (int j = 0; j < 4; ++j) { const int n = (lane >> 3) + 8 * j; const LAS float* sp = scr + (8 * c) * 33 + n;
        v4u o; o.x = pk2(sp[0 * 33], sp[1 * 33]); o.y = pk2(sp[2 * 33], sp[3 * 33]); o.z = pk2(sp[4 * 33], sp[5 * 33]); o.w = pk2(sp[6 * 33], sp[7 * 33]);
        *(v4u*)(WT + (size_t)rm(n0 + n) * K + k0 + 8 * c) = o; }
    LDS_WAIT(); asm volatile("" ::: "memory");
}
template <class RM>
__device__ __forceinline__ void p0_item8(const float* W, int K, int N, unsigned char* WT, RM rm, float scale, LAS float* scr, int item, int lane) {
    const int nblk = N / 32, kb = item / nblk, nb = item % nblk, k0 = 64 * kb, n0 = 32 * nb;
#pragma unroll 8
    for (int i = 0; i < 32; ++i) { const int kk = 2 * i + (lane >> 5); scr[kk * 33 + (lane & 31)] = W[(size_t)(k0 + kk) * N + n0 + (lane & 31)] * scale; }
    LDS_WAIT(); asm volatile("" ::: "memory");
    const int c = lane & 3;
#pragma unroll
    for (int j = 0; j < 2; ++j) { const int n = (lane >> 2) + 16 * j; const LAS float* sp = scr + (16 * c) * 33 + n;
        v4u o; o.x = pg8::pk4_fp8(sp[0 * 33], sp[1 * 33], sp[2 * 33], sp[3 * 33]); o.y = pg8::pk4_fp8(sp[4 * 33], sp[5 * 33], sp[6 * 33], sp[7 * 33]);
        o.z = pg8::pk4_fp8(sp[8 * 33], sp[9 * 33], sp[10 * 33], sp[11 * 33]); o.w = pg8::pk4_fp8(sp[12 * 33], sp[13 * 33], sp[14 * 33], sp[15 * 33]);
        *(v4u*)(WT + (size_t)rm(n0 + n) * K + k0 + 16 * c) = o; }
    LDS_WAIT(); asm volatile("" ::: "memory");
}
__device__ __forceinline__ void norm_rows(const float* x, const float* g, bf16_t* o, int gw, int NGW, int lane) {
    typedef float f32x4 __attribute__((ext_vector_type(4)));
    f32x4 gv[4];
#pragma unroll
    for (int j = 0; j < 4; ++j) gv[j] = *((const f32x4*)g + lane + 64 * j);
    for (int m = gw; m < T; m += NGW) {
        const f32x4* xr = (const f32x4*)(x + (size_t)m * D) + lane;
        f32x4 v[4]; float s = 0.f;
#pragma unroll
        for (int j = 0; j < 4; ++j) { v[j] = xr[64 * j]; s += (v[j].x * v[j].x + v[j].y * v[j].y) + (v[j].z * v[j].z + v[j].w * v[j].w); }
        const float rs = rsqrtf(wave_sum(s) * (1.f / D) + EPS);
        unsigned long long* o8 = (unsigned long long*)(o + (size_t)m * D) + lane;
#pragma unroll
        for (int j = 0; j < 4; ++j) o8[64 * j] = (unsigned long long)pk2(v[j].x * rs * gv[j].x, v[j].y * rs * gv[j].y) | ((unsigned long long)pk2(v[j].z * rs * gv[j].z, v[j].w * rs * gv[j].w) << 32);
    }
}
__device__ __forceinline__ void mla_prep_rows(const bf16_t* proj0, const float* qg, const float* kvg, const int* pos, bf16_t* cqn, bf16_t* ckvn, bf16_t* krope, float* ropecs, int gw, int NGW, int lane) {
    for (int tkn = gw; tkn < T; tkn += NGW) {
        const bf16_t* pr = proj0 + (size_t)tkn * EVEN_INP;
        float q[6], s = 0.f;
#pragma unroll
        for (int j = 0; j < 6; ++j) { q[j] = bf2f(pr[P0_CQ + lane + 64 * j]); s += q[j] * q[j]; }
        float rs = rsqrtf(wave_sum(s) * (1.f / 384.f) + EPS);
#pragma unroll
        for (int j = 0; j < 6; ++j) cqn[(size_t)tkn * 384 + lane + 64 * j] = f2bf(q[j] * rs * qg[lane + 64 * j]);
        float c[4]; s = 0.f;
#pragma unroll
        for (int j = 0; j < 4; ++j) { c[j] = bf2f(pr[P0_CKV + lane + 64 * j]); s += c[j] * c[j]; }
        rs = rsqrtf(wave_sum(s) * (1.f / 256.f) + EPS);
#pragma unroll
        for (int j = 0; j < 4; ++j) ckvn[(size_t)tkn * 256 + lane + 64 * j] = f2bf(c[j] * rs * kvg[lane + 64 * j]);
        if (lane < 16) {
            const float p = (float)pos[tkn];
            const float inv = powf(10000.f, -(float)(2 * lane) / 32.f);
            const float ang = p * inv, cs = cosf(ang), sn = sinf(ang);
            const float t1 = bf2f(pr[P0_KR + lane]), t2 = bf2f(pr[P0_KR + 16 + lane]);
            krope[(size_t)tkn * 32 + lane] = f2bf(t1 * cs - t2 * sn);
            krope[(size_t)tkn * 32 + 16 + lane] = f2bf(t2 * cs + t1 * sn);
            ropecs[(size_t)tkn * 32 + lane] = cs; ropecs[(size_t)tkn * 32 + 16 + lane] = sn;
        }
    }
}
__device__ __forceinline__ void swa_naive(const bf16_t* proj0, const float* sinks, bf16_t* ymix, int gt, int NGT) {
    for (int idx = gt; idx < T * 8; idx += NGT) {
        const int tkn = idx >> 3, h = idx & 7, hk = h >> 2;
        const int b = tkn / SEQ, sq = tkn % SEQ, n = sq / CHUNK, qi = sq % CHUNK;
        const float slope = exp2f(-(float)(h + 1));
        float q[64], o[64];
#pragma unroll
        for (int d = 0; d < 64; ++d) { q[d] = bf2f(proj0[(size_t)tkn * EVEN_INP + P0_QA + h * 64 + d]); o[d] = 0.f; }
        float m = sinks[h], l = 1.f;
        const int k_lo = (n - 2) * CHUNK, k_hi = (n + 1) * CHUNK;
        for (int kp = (k_lo < 0 ? 0 : k_lo); kp < k_hi; ++kp) {
            const bf16_t* kr = proj0 + (size_t)(b * SEQ + kp) * EVEN_INP + P0_KA + hk * 64;
            float sc = 0.f;
#pragma unroll
            for (int d = 0; d < 64; ++d) sc += q[d] * bf2f(kr[d]);
            const float dist = fabsf((float)(qi + 2 * CHUNK - (kp - k_lo)));
            sc = sc * 0.125f - slope * dist;
            const float mn = fmaxf(m, sc), f = __expf(m - mn), pz = __expf(sc - mn);
            l = l * f + pz; m = mn;
            const bf16_t* vr = kr + (P0_VA - P0_KA);
#pragma unroll
            for (int d = 0; d < 64; ++d) o[d] = o[d] * f + pz * bf2f(vr[d]);
        }
        const float il = 1.f / l;
#pragma unroll
        for (int d = 0; d < 64; ++d) ymix[(size_t)tkn * D + h * 64 + d] = f2bf(o[d] * il);
    }
}
__device__ __forceinline__ void mla_naive(const bf16_t* qm, const bf16_t* kvm, const bf16_t* krope, const int* pos, bf16_t* ymix, int gt, int NGT) {
    for (int idx = gt; idx < T * 8; idx += NGT) {
        const int tkn = idx >> 3, h = idx & 7;
        const int b = tkn / SEQ, sq = tkn % SEQ, c = sq / CHUNK;
        float q[96], o[64];
#pragma unroll
        for (int d = 0; d < 96; ++d) q[d] = bf2f(qm[(size_t)tkn * 768 + h * 96 + d]);
        { const float p = (float)pos[tkn];
#pragma unroll
          for (int i = 0; i < 16; ++i) { const float inv = powf(10000.f, -(float)(2 * i) / 32.f), ang = p * inv, cs = cosf(ang), sn = sinf(ang);
              const float t1 = q[64 + i], t2 = q[80 + i]; q[64 + i] = t1 * cs - t2 * sn; q[80 + i] = t2 * cs + t1 * sn; } }
#pragma unroll
        for (int d = 0; d < 64; ++d) o[d] = 0.f;
        float m = -1e30f, l = 0.f;
        const int nk = (c + 1) * CHUNK;
        for (int kp = 0; kp < nk; ++kp) {
            const bf16_t* kr = kvm + (size_t)(b * SEQ + kp) * 1024 + h * 128;
            const bf16_t* rr = krope + (size_t)(b * SEQ + kp) * 32;
            float sc = 0.f;
#pragma unroll
            for (int d = 0; d < 64; ++d) sc += q[d] * bf2f(kr[d]);
#pragma unroll
            for (int d = 0; d < 32; ++d) sc += q[64 + d] * bf2f(rr[d]);
            sc *= 0.10206207261596577f;
            const float mn = fmaxf(m, sc), f = __expf(m - mn), pz = __expf(sc - mn);
            l = l * f + pz; m = mn;
#pragma unroll
            for (int d = 0; d < 64; ++d) o[d] = o[d] * f + pz * bf2f(kr[64 + d]);
        }
        const float il = 1.f / l;
#pragma unroll
        for (int d = 0; d < 64; ++d) ymix[(size_t)tkn * D + 512 + h * 64 + d] = f2bf(o[d] * il);
    }
}
__device__ __forceinline__ void ret_naive(const bf16_t* proj1, float* yr, LAS float* sm, int bx, int G, int tid) {
    for (int bh = bx; bh < BATCH * 4; bh += G) {
        const int b = bh >> 2, h = bh & 3, dv = tid & 127;
        const float g = 1.f - exp2f(-5.f - (float)h);
        float S[128];
#pragma unroll
        for (int d = 0; d < 128; ++d) S[d] = 0.f;
        for (int sq = 0; sq < SEQ; ++sq) {
            const bf16_t* pr = proj1 + (size_t)(b * SEQ + sq) * ODD_IN;
            __syncthreads();
            if (tid < 128) { sm[dv] = bf2f(pr[P1_Q + h * 128 + dv]); sm[128 + dv] = bf2f(pr[P1_K + h * 128 + dv]) * 0.08838834764831845f; }
            __syncthreads();
            if (tid < 128) {
                const float v = bf2f(pr[P1_V + h * 128 + dv]); float o = 0.f;
#pragma unroll
                for (int d = 0; d < 128; ++d) { S[d] = g * S[d] + sm[128 + d] * v; o += sm[d] * S[d]; }
                yr[(size_t)(b * SEQ + sq) * 512 + h * 128 + dv] = o;
            }
        }
    }
}
__device__ __forceinline__ void ret_gn_rows(const float* yr, const bf16_t* proj1, const float* gn, bf16_t* ymix, int gw, int NGW, int lane) {
    for (int w = gw; w < T * 4; w += NGW) {
        const int tkn = w >> 2, h = w & 3;
        const float a = yr[(size_t)tkn * 512 + h * 128 + lane], c = yr[(size_t)tkn * 512 + h * 128 + 64 + lane];
        const float mu = wave_sum(a + c) * (1.f / 128.f);
        const float da = a - mu, dc = c - mu;
        const float rs = rsqrtf(wave_sum(da * da + dc * dc) * (1.f / 128.f) + EPS);
        const float g0 = bf2f(proj1[(size_t)tkn * ODD_IN + P1_G + h * 128 + lane]), g1 = bf2f(proj1[(size_t)tkn * ODD_IN + P1_G + h * 128 + 64 + lane]);
        ymix[(size_t)tkn * D + h * 128 + lane] = f2bf(silu(g0) * da * rs * gn[h * 128 + lane]);
        ymix[(size_t)tkn * D + h * 128 + 64 + lane] = f2bf(silu(g1) * dc * rs * gn[h * 128 + 64 + lane]);
    }
}
__device__ __forceinline__ void conv_elems(const bf16_t* proj1, const float* w, bf16_t* ymix, int gt, int NGT) {
    for (int i = gt; i < T * 512; i += NGT) {
        const int tkn = i >> 9, c = i & 511, sq = tkn % SEQ;
        float y = 0.f;
#pragma unroll
        for (int j = 0; j < 3; ++j) { if (sq - 2 + j >= 0) { const bf16_t* pr = proj1 + (size_t)(tkn - 2 + j) * ODD_IN; y += w[j * 512 + c] * bf2f(pr[P1_C + c]) * bf2f(pr[P1_H + c]); } }
        ymix[(size_t)tkn * D + 512 + c] = f2bf(bf2f(proj1[(size_t)tkn * ODD_IN + P1_B + c]) * y);
    }
}
__device__ __forceinline__ void route_tokens(const float* x, const float* g, const float* router, unsigned char* xnm8, unsigned* ctl, unsigned char* tab, LAS unsigned* sm, int bx, int G, int tid) {
    typedef float f32x4 __attribute__((ext_vector_type(4)));
    const int wave = tid >> 6, lane = tid & 63;
    LAS unsigned* lcnt = sm; LAS unsigned* lbase = sm + 8; LAS int* se = (LAS int*)(sm + 16); LAS int* ss = (LAS int*)(sm + 16 + 128); LAS float* sg = (LAS float*)(sm + 16 + 256);
    for (int blk = bx; blk < T / 64; blk += G) {
        __syncthreads();
        if (tid < NE) lcnt[tid] = 0u;
        __syncthreads();
        for (int it = 0; it < 8; ++it) {
            const int lt = wave * 8 + it, tkn = blk * 64 + lt;
            const f32x4* xr = (const f32x4*)(x + (size_t)tkn * D) + lane;
            f32x4 v[4]; float s = 0.f;
#pragma unroll
            for (int j = 0; j < 4; ++j) { v[j] = xr[64 * j]; s += (v[j].x * v[j].x + v[j].y * v[j].y) + (v[j].z * v[j].z + v[j].w * v[j].w); }
            const float rs = rsqrtf(wave_sum(s) * (1.f / D) + EPS);
            float lg[NE];
#pragma unroll
            for (int e = 0; e < NE; ++e) lg[e] = 0.f;
#pragma unroll
            for (int j = 0; j < 4; ++j) {
                const f32x4 gv = *((const f32x4*)g + lane + 64 * j);
                const f32x4 hv = v[j] * rs * gv;
                *(unsigned*)(xnm8 + (size_t)tkn * D + 4 * lane + 256 * j) = pg8::pk4_fp8(hv.x * 4.f, hv.y * 4.f, hv.z * 4.f, hv.w * 4.f);
                const f32x4* rr = (const f32x4*)(router + (size_t)(4 * lane + 256 * j) * NE);
#pragma unroll
                for (int q = 0; q < 4; ++q) { const f32x4 r0 = rr[2 * q], r1 = rr[2 * q + 1]; const float hq = hv[q];
                    lg[0] += hq * r0.x; lg[1] += hq * r0.y; lg[2] += hq * r0.z; lg[3] += hq * r0.w; lg[4] += hq * r1.x; lg[5] += hq * r1.y; lg[6] += hq * r1.z; lg[7] += hq * r1.w; }
            }
#pragma unroll
            for (int e = 0; e < NE; ++e) lg[e] = wave_sum(lg[e]);
            int e0 = 0; float v0 = lg[0];
#pragma unroll
            for (int e = 1; e < NE; ++e) if (lg[e] > v0) { v0 = lg[e]; e0 = e; }
            int e1 = -1; float v1 = -INFINITY;
#pragma unroll
            for (int e = 0; e < NE; ++e) if (e != e0 && lg[e] > v1) { v1 = lg[e]; e1 = e; }
            const float p1 = __expf(v1 - v0), g0 = 1.f / (1.f + p1), g1 = p1 / (1.f + p1);
            if (lane == 0) { se[lt * 2] = e0; se[lt * 2 + 1] = e1; sg[lt * 2] = g0; sg[lt * 2 + 1] = g1; ss[lt * 2] = (int)__hip_atomic_fetch_add(&lcnt[e0], 1u, __ATOMIC_RELAXED, __HIP_MEMORY_SCOPE_WORKGROUP); ss[lt * 2 + 1] = (int)__hip_atomic_fetch_add(&lcnt[e1], 1u, __ATOMIC_RELAXED, __HIP_MEMORY_SCOPE_WORKGROUP); }
        }
        __syncthreads();
        if (tid < NE) lbase[tid] = __hip_atomic_fetch_add(&ctl[CW_CNT + 64 * tid], lcnt[tid], __ATOMIC_RELAXED, __HIP_MEMORY_SCOPE_AGENT);
        __syncthreads();
        if (tid < 64) {
            const int lt = tid, tkn = blk * 64 + lt;
            int* ltok = (int*)(tab + TAB_LTOK); float* lgate = (float*)(tab + TAB_LGATE); int* tsel = (int*)(tab + TAB_TSEL);
#pragma unroll
            for (int k = 0; k < 2; ++k) { const int e = se[lt * 2 + k], slot = (int)lbase[e] + ss[lt * 2 + k]; ltok[e * T + slot] = tkn; lgate[e * T + slot] = sg[lt * 2 + k]; tsel[tkn * 4 + 2 * k] = e; tsel[tkn * 4 + 2 * k + 1] = slot; }
        }
    }
}
__device__ __forceinline__ void final_rows(const float* x3, const bf16_t* yp0, const bf16_t* yp1, const unsigned* cnt, const unsigned char* tab, const float* g, float* out, int gw, int NGW, int lane) {
    const int* tsel = (const int*)(tab + TAB_TSEL);
    int tb[NE]; { int t = 0;
#pragma unroll
      for (int e = 0; e < NE; ++e) { tb[e] = t; t += ((int)__hip_atomic_load(cnt + 64 * e, __ATOMIC_RELAXED, __HIP_MEMORY_SCOPE_AGENT) + 255) >> 8; } }
    for (int tkn = gw; tkn < T; tkn += NGW) {
        size_t row[2];
#pragma unroll
        for (int k = 0; k < 2; ++k) { const int e = tsel[tkn * 4 + 2 * k], slot = tsel[tkn * 4 + 2 * k + 1]; int tbe = 0;
#pragma unroll
            for (int i = 0; i < NE; ++i) tbe = (i == e) ? tb[i] : tbe;
            row[k] = (size_t)tbe * 256 + slot; }
        float v[16]; float s = 0.f;
#pragma unroll
        for (int j = 0; j < 16; ++j) { const int c = lane + 64 * j;
            v[j] = x3[(size_t)tkn * D + c] + bf2f(yp0[row[0] * D + c]) + bf2f(yp1[row[0] * D + c]) + bf2f(yp0[row[1] * D + c]) + bf2f(yp1[row[1] * D + c]);
            s += v[j] * v[j]; }
        const float rs = rsqrtf(wave_sum(s) * (1.f / D) + EPS);
#pragma unroll
        for (int j = 0; j < 16; ++j) out[(size_t)tkn * D + lane + 64 * j] = v[j] * rs * g[lane + 64 * j];
    }
}

#ifndef MK_ONE_LAUNCH
#define MK_ONE_LAUNCH 1
#endif
constexpr int NPHASE = 19;
enum Phase { PH_P0 = 0, PH_G1, PH_MP, PH_G2, PH_ATT, PH_G3, PH_N2, PH_G4, PH_G5, PH_N3, PH_G6, PH_RET1, PH_RET2, PH_RET3, PH_G7, PH_ROUTE, PH_G8, PH_G9, PH_FINAL };
struct Args { const float* in[25]; float* out; unsigned char* ws; int ph_lo, ph_hi; };
static_assert(sizeof(Args) == 25 * 8 + 8 + 8 + 8, "Args has no padding");
enum In { I_X = 0, I_POS, I_ENORM_MIX, I_EW_IN, I_ESINKS, I_EQ_NORM, I_EW_UQ, I_EKV_NORM, I_EW_UKV, I_EW_OUT, I_ENORM_FFN, I_EW_GATE, I_EW_UP, I_EW_DOWN,
          I_ONORM_MIX, I_OW_IN, I_ORET_GN, I_OCONV_W, I_OW_OUT, I_ONORM_FFN, I_OROUTER, I_OWE_GATE, I_OWE_UP, I_OWE_DOWN, I_FINAL_NORM };

__global__ void __launch_bounds__(NWAVES * 64, 2) skel_fwd(Args args) {
    extern __shared__ __attribute__((aligned(16))) unsigned char lds_raw[];
    LAS unsigned char* lds = (LAS unsigned char*)lds_raw;
    LAS unsigned* rowtab = (LAS unsigned*)(lds + ROWTAB_OFF);
    volatile LAS unsigned* MISC = (volatile LAS unsigned*)(lds + MISC_OFF);
    const int G = gridDim.x, bx = blockIdx.x, tid = threadIdx.x, lane = tid & 63, wave = __builtin_amdgcn_readfirstlane(tid >> 6);
    const int gw = bx * NWAVES + wave, NGW = G * NWAVES, gt = bx * NWAVES * 64 + tid, NGT = G * NWAVES * 64;
    unsigned char* ws = args.ws; float* out = args.out;
    unsigned* ctl = (unsigned*)(ws + WS_CTL);
    const unsigned* cnt = ctl + CW_CNT;
    bf16_t* XN = (bf16_t*)(ws + WS_XN); bf16_t* YMIX = (bf16_t*)(ws + WS_YMIX); bf16_t* PROJ0 = (bf16_t*)(ws + WS_PROJ0); bf16_t* CQN = (bf16_t*)(ws + WS_CQN);
    bf16_t* CKVN = (bf16_t*)(ws + WS_CKVN); bf16_t* KROPE = (bf16_t*)(ws + WS_KROPE); bf16_t* QM = (bf16_t*)(ws + WS_QM); bf16_t* KVM = (bf16_t*)(ws + WS_KVM);
    bf16_t* ACT = (bf16_t*)(ws + WS_ACT); bf16_t* PROJ1 = (bf16_t*)(ws + WS_PROJ1); float* YR = (float*)(ws + WS_YR);
    unsigned char* ACTM = ws + WS_ACTM; bf16_t* YP0 = (bf16_t*)(ws + WS_YP0); bf16_t* YP1 = (bf16_t*)(ws + WS_YP1); unsigned char* XNM = ws + WS_XNM;
    unsigned char* TAB = ws + WS_TAB;
    const int* ltok = (const int*)(TAB + TAB_LTOK); const float* lgate = (const float*)(TAB + TAB_LGATE);
    const int lo = args.ph_lo, hi = args.ph_hi;
    for (int u = tid; u < (LDS_BYTES - RING_BYTES) / 4; u += NWAVES * 64) ((LAS unsigned*)(lds + RING_BYTES))[u] = 0u;
    __syncthreads();
    XcdBarrier bar; bar.bar = (unsigned*)(ctl + CW_BAR); bar.x = 0; bar.st = nullptr;
    if (hi - lo > 1) bar = xcd_barrier_post((unsigned*)(ctl + CW_BAR), MISC + 8);
#define IN(k) (lo <= (k) && (k) < hi)
#define SEAM(k) do { if (IN(k) && IN((k) + 1)) xcd_barrier(bar); } while (0)
    using namespace pg8;

    if (IN(PH_P0)) {
        LAS float* scr = (LAS float*)(lds + wave * 16384);
        constexpr int I_IN0 = 16 * 45, I_UQ = 6 * 24, I_UKV = 4 * 32, I_SQ = 16 * 32, I_FF = 16 * 112, I_DN = 56 * 32;
        constexpr int NDENSE = I_IN0 + I_UQ + I_UKV + I_SQ + 2 * I_FF + I_DN + I_FF + I_SQ, NITEMS = NDENSE + NE * 3 * I_FF;
        static_assert(I_DN == I_FF, "expert item arithmetic assumes equal item counts");
        for (int it = gw; it < NITEMS; it += NGW) {
            int r = it;
            if (r < I_IN0) { p0_item(args.in[I_EW_IN], D, EVEN_IN, (bf16_t*)(ws + WS_W_IN0), RowIdent{0}, scr, r, lane); continue; } r -= I_IN0;
            if (r < I_UQ) { p0_item(args.in[I_EW_UQ], 384, 768, (bf16_t*)(ws + WS_W_UQ), RowIdent{0}, scr, r, lane); continue; } r -= I_UQ;
            if (r < I_UKV) { p0_item(args.in[I_EW_UKV], 256, 1024, (bf16_t*)(ws + WS_W_UKV), RowIdent{0}, scr, r, lane); continue; } r -= I_UKV;
            if (r < I_SQ) { p0_item(args.in[I_EW_OUT], D, D, (bf16_t*)(ws + WS_W_OUT0), RowIdent{0}, scr, r, lane); continue; } r -= I_SQ;
            if (r < I_FF) { p0_item(args.in[I_EW_GATE], D, FF, (bf16_t*)(ws + WS_W_GU0), RowGU{0}, scr, r, lane); continue; } r -= I_FF;
            if (r < I_FF) { p0_item(args.in[I_EW_UP], D, FF, (bf16_t*)(ws + WS_W_GU0), RowGU{1}, scr, r, lane); continue; } r -= I_FF;
            if (r < I_DN) { p0_item(args.in[I_EW_DOWN], FF, D, (bf16_t*)(ws + WS_W_DN0), RowIdent{0}, scr, r, lane); continue; } r -= I_DN;
            if (r < I_FF) { p0_item(args.in[I_OW_IN], D, ODD_IN, (bf16_t*)(ws + WS_W_IN1), RowIdent{0}, scr, r, lane); continue; } r -= I_FF;
            if (r < I_SQ) { p0_item(args.in[I_OW_OUT], D, D, (bf16_t*)(ws + WS_W_OUT1), RowIdent{0}, scr, r, lane); continue; } r -= I_SQ;
            const int e = r / (3 * I_FF), q = r % (3 * I_FF), which = q / I_FF, item = q % I_FF;
            if (which == 0) p0_item8(args.in[I_OWE_GATE] + (size_t)e * D * FF, D, FF, ws + WS_WE_GU + (size_t)e * 2 * FF * D, RowGU{0}, 128.f, scr, item, lane);
            else if (which == 1) p0_item8(args.in[I_OWE_UP] + (size_t)e * D * FF, D, FF, ws + WS_WE_GU + (size_t)e * 2 * FF * D, RowGU{1}, 128.f, scr, item, lane);
            else p0_item8(args.in[I_OWE_DOWN] + (size_t)e * FF * D, FF, D, ws + WS_WE_DN + (size_t)e * D * FF, RowIdent{0}, 256.f, scr, item, lane);
        }
        { v4u* z = (v4u*)((bf16_t*)(ws + WS_W_IN0) + (size_t)EVEN_IN * D); for (int i = gt; i < (EVEN_INP - EVEN_IN) * D / 8; i += NGT) z[i] = (v4u){0u, 0u, 0u, 0u}; }
        norm_rows(args.in[I_X], args.in[I_ENORM_MIX], XN, gw, NGW, lane);
    }
    SEAM(PH_P0);
    if (IN(PH_G1)) {
        Gemm g{XN, (const bf16_t*)(ws + WS_W_IN0), D, D, D, 0}; StaticOrder S; S.init(T / 256, EVEN_INP / 256, G, bx);
        gemm_phase<EpiBf16, StaticOrder, ARowIdent, true>(lds, rowtab, g, S, ARowIdent{}, EpiBf16{PROJ0, EVEN_INP});
    }
    SEAM(PH_G1);
    if (IN(PH_MP)) mla_prep_rows(PROJ0, args.in[I_EQ_NORM], args.in[I_EKV_NORM], (const int*)args.in[I_POS], CQN, CKVN, KROPE, (float*)(ws + WS_ROPE), gw, NGW, lane);
    SEAM(PH_MP);
    if (IN(PH_G2)) {
        { Gemm g{CQN, (const bf16_t*)(ws + WS_W_UQ), 384, 384, 384, 0}; StaticOrder S; S.init(T / 256, 768 / 256, G, bx);
          gemm_phase<EpiBf16, StaticOrder, ARowIdent, true>(lds, rowtab, g, S, ARowIdent{}, EpiBf16{QM, 768}); }
        { Gemm g{CKVN, (const bf16_t*)(ws + WS_W_UKV), 256, 256, 256, 0}; StaticOrder S; S.init(T / 256, 1024 / 256, G, bx);
          gemm_phase<EpiBf16, StaticOrder, ARowIdent, true>(lds, rowtab, g, S, ARowIdent{}, EpiBf16{KVM, 1024}); }
    }
    SEAM(PH_G2);
    if (IN(PH_ATT)) {
        static_assert(att::L_END <= RING_BYTES, "attention LDS map");
        const int vcu = (G % 8 == 0) ? (bx % 8) * (G / 8) + bx / 8 : bx;
        for (int pr = vcu; pr < BATCH * 8 * 4; pr += G) {
            const int bh = pr >> 2, sI = pr & 3;
            att::mla_unit((LAS char*)lds, QM, KVM, KROPE, (const float*)(ws + WS_ROPE), YMIX, bh >> 3, bh & 7, sI);
            att::mla_unit((LAS char*)lds, QM, KVM, KROPE, (const float*)(ws + WS_ROPE), YMIX, bh >> 3, bh & 7, 7 - sI);
        }
        for (int u = vcu; u < BATCH * 32 * 2; u += G) att::swa_unit((LAS char*)lds, PROJ0, args.in[I_ESINKS], YMIX, u >> 6, (u & 63) >> 1, u & 1);
    }
    SEAM(PH_ATT);
    if (IN(PH_G3)) {
        Gemm g{YMIX, (const bf16_t*)(ws + WS_W_OUT0), D, D, D, 0}; StaticOrder S; S.init(T / 256, D / 256, G, bx);
        gemm_phase<EpiRes, StaticOrder, ARowIdent, true>(lds, rowtab, g, S, ARowIdent{}, EpiRes{args.in[I_X], out, D});
    }
    SEAM(PH_G3);
    if (IN(PH_N2)) norm_rows(out, args.in[I_ENORM_FFN], XN, gw, NGW, lane);
    SEAM(PH_N2);
    if (IN(PH_G4)) {
        Gemm g{XN, (const bf16_t*)(ws + WS_W_GU0), D, D, D, 0}; StaticOrder S; S.init(T / 256, 2 * FF / 256, G, bx);
        gemm_phase<EpiSwiglu, StaticOrder, ARowIdent, true>(lds, rowtab, g, S, ARowIdent{}, EpiSwiglu{ACT, FF});
    }
    SEAM(PH_G4);
    if (IN(PH_G5)) {
        Gemm g{ACT, (const bf16_t*)(ws + WS_W_DN0), FF, FF, FF, 0}; StaticOrder S; S.init(T / 256, D / 256, G, bx);
        gemm_phase<EpiRes, StaticOrder, ARowIdent, true>(lds, rowtab, g, S, ARowIdent{}, EpiRes{out, out, D});
    }
    SEAM(PH_G5);
    if (IN(PH_N3)) norm_rows(out, args.in[I_ONORM_MIX], XN, gw, NGW, lane);
    SEAM(PH_N3);
    if (IN(PH_G6)) {
        Gemm g{XN, (const bf16_t*)(ws + WS_W_IN1), D, D, D, 0}; StaticOrder S; S.init(T / 256, ODD_IN / 256, G, bx);
        gemm_phase<EpiBf16, StaticOrder, ARowIdent, true>(lds, rowtab, g, S, ARowIdent{}, EpiBf16{PROJ1, ODD_IN});
    }
    SEAM(PH_G6);
    if (IN(PH_RET1)) {
        for (int u = bx; u < BATCH * 4 * 32; u += G) ret::ret1_unit((LAS char*)lds, PROJ1, (bf16_t*)(ws + WS_RKV), u);
        conv_elems(PROJ1, args.in[I_OCONV_W], YMIX, gt, NGT);
    }
    SEAM(PH_RET1);
    if (IN(PH_RET2)) ret::ret2_elems((bf16_t*)(ws + WS_RKV), gt, NGT);
    SEAM(PH_RET2);
    if (IN(PH_RET3)) { static_assert(ret::R3_END <= RING_BYTES, "retention LDS map");
        for (int u = bx; u < BATCH * 4 * 32; u += G) ret::ret3_unit((LAS char*)lds, PROJ1, (const bf16_t*)(ws + WS_RKV), args.in[I_ORET_GN], YMIX, u); }
    SEAM(PH_RET3);
    if (IN(PH_G7)) {
        Gemm g{YMIX, (const bf16_t*)(ws + WS_W_OUT1), D, D, D, 0}; StaticOrder S; S.init(T / 256, D / 256, G, bx);
        gemm_phase<EpiRes, StaticOrder, ARowIdent, true>(lds, rowtab, g, S, ARowIdent{}, EpiRes{out, out, D});
    }
    SEAM(PH_G7);
    if (IN(PH_ROUTE)) route_tokens(out, args.in[I_ONORM_FFN], args.in[I_OROUTER], XNM, ctl, TAB, (LAS unsigned*)lds, bx, G, tid);
    SEAM(PH_ROUTE);
    if (IN(PH_G8)) {
        Gemm g{XNM, ws + WS_WE_GU, D, D, D, (size_t)2 * FF * D, 0x7D7D7D7D, 0x78787878}; MoeOrder S; S.init(cnt, 0, MOE_MAXT, 2 * FF / 256, 1, 0, G, bx);
        gemm_phase<EpiSwiglu8, MoeOrder, ARowMoe, true, true>(lds, rowtab, g, S, ARowMoe{ltok, cnt}, EpiSwiglu8{ACTM, FF, 8.f});
    }
    SEAM(PH_G8);
    if (IN(PH_G9)) {
        Gemm g{ACTM, ws + WS_WE_DN, FF, FF, FF / 2, (size_t)D * FF, 0x7C7C7C7C, 0x77777777}; MoeOrder S; S.init(cnt, 0, MOE_MAXT, D / 256, 2, FF / 2, G, bx);
        gemm_phase<EpiMoeDn, MoeOrder, ARowIdent, true, true>(lds, rowtab, g, S, ARowIdent{}, EpiMoeDn{YP0, YP1, lgate, cnt, 0});
    }
    SEAM(PH_G9);
    if (IN(PH_FINAL)) final_rows(out, YP0, YP1, cnt, TAB, args.in[I_FINAL_NORM], out, gw, NGW, lane);
#undef IN
#undef SEAM
}

template <class RM> static void wconv(const float* W, int K, int N, bf16_t* WT, RM rm, hipStream_t st) {
    hipLaunchKernelGGL((k_wconv<RM>), dim3((K / 32) * (N / 32)), dim3(256), 0, st, W, K, N, WT, rm);
}
template <bool DUAL, class Ctx> static void gemm(const bf16_t* A, int lda, const bf16_t* Bt, int ldb, int M, int N, int K, Ctx ctx, hipStream_t st) {
    GemmArgs g{A, Bt, lda, ldb, M, N, K, 0};
    hipLaunchKernelGGL((k_gemm<DUAL, Ctx>), dim3(N / 64, M / 64), dim3(256), 0, st, g, ctx);
}

extern "C" void kernel_launch(void* const* d_in, const int* in_sizes, int n_in, void* d_out, int out_size, void* d_ws, size_t ws_size, hipStream_t stream) {
    if (n_in != 25 || out_size != T * D || ws_size < WS_END) { fprintf(stderr, "kernel_launch: unexpected problem (n_in %d out %d ws %zu need %zu)\n", n_in, out_size, ws_size, (size_t)WS_END); return; }
    const float* x = (const float*)d_in[0]; const int* pos = (const int*)d_in[1];
    const float* e_norm_mix = (const float*)d_in[2]; const float* e_w_in = (const float*)d_in[3]; const float* e_sinks = (const float*)d_in[4];
    const float* e_q_norm = (const float*)d_in[5]; const float* e_w_uq = (const float*)d_in[6]; const float* e_kv_norm = (const float*)d_in[7]; const float* e_w_ukv = (const float*)d_in[8];
    const float* e_w_out = (const float*)d_in[9]; const float* e_norm_ffn = (const float*)d_in[10]; const float* e_w_gate = (const float*)d_in[11]; const float* e_w_up = (const float*)d_in[12];
    const float* e_w_down = (const float*)d_in[13]; const float* o_norm_mix = (const float*)d_in[14]; const float* o_w_in = (const float*)d_in[15]; const float* o_ret_gn = (const float*)d_in[16];
    const float* o_conv_w = (const float*)d_in[17]; const float* o_w_out = (const float*)d_in[18]; const float* o_norm_ffn = (const float*)d_in[19]; const float* o_router = (const float*)d_in[20];
    const float* o_we_gate = (const float*)d_in[21]; const float* o_we_up = (const float*)d_in[22]; const float* o_we_down = (const float*)d_in[23]; const float* final_norm = (const float*)d_in[24];
    unsigned char* ws = (unsigned char*)d_ws; float* out = (float*)d_out;
    unsigned* ctl = (unsigned*)(ws + WS_CTL);
    bf16_t* W_IN0 = (bf16_t*)(ws + WS_W_IN0); bf16_t* W_UQ = (bf16_t*)(ws + WS_W_UQ); bf16_t* W_UKV = (bf16_t*)(ws + WS_W_UKV); bf16_t* W_OUT0 = (bf16_t*)(ws + WS_W_OUT0);
    bf16_t* W_GU0 = (bf16_t*)(ws + WS_W_GU0); bf16_t* W_DN0 = (bf16_t*)(ws + WS_W_DN0); bf16_t* W_IN1 = (bf16_t*)(ws + WS_W_IN1); bf16_t* W_OUT1 = (bf16_t*)(ws + WS_W_OUT1);
    bf16_t* WE_GU = (bf16_t*)(ws + WS_WE_GU); bf16_t* WE_DN = (bf16_t*)(ws + WS_WE_DN);
    bf16_t* XN = (bf16_t*)(ws + WS_XN); bf16_t* YMIX = (bf16_t*)(ws + WS_YMIX); bf16_t* PROJ0 = (bf16_t*)(ws + WS_PROJ0); bf16_t* CQN = (bf16_t*)(ws + WS_CQN);
    bf16_t* CKVN = (bf16_t*)(ws + WS_CKVN); bf16_t* KROPE = (bf16_t*)(ws + WS_KROPE); bf16_t* QM = (bf16_t*)(ws + WS_QM); bf16_t* KVM = (bf16_t*)(ws + WS_KVM);
    bf16_t* ACT = (bf16_t*)(ws + WS_ACT); bf16_t* PROJ1 = (bf16_t*)(ws + WS_PROJ1); float* YR = (float*)(ws + WS_YR);
    bf16_t* ACTM = (bf16_t*)(ws + WS_ACTM); bf16_t* YP0 = (bf16_t*)(ws + WS_YP0); bf16_t* YP1 = (bf16_t*)(ws + WS_YP1); unsigned char* TAB = ws + WS_TAB; bf16_t* XNM = (bf16_t*)(ws + WS_XNM);

    static int grid = 0;
    if (grid == 0) {
        int dev = 0, cus = 0;
        if (hipGetDevice(&dev) != hipSuccess || hipDeviceGetAttribute(&cus, hipDeviceAttributeMultiprocessorCount, dev) != hipSuccess) { fprintf(stderr, "kernel_launch: device query failed\n"); grid = -1; return; }
        if (hipFuncSetAttribute((const void*)skel_fwd, hipFuncAttributeMaxDynamicSharedMemorySize, LDS_BYTES) != hipSuccess) { fprintf(stderr, "kernel_launch: hipFuncSetAttribute failed\n"); grid = -1; return; }
        grid = cus;
    }
    if (grid < 0) return;
    Args a{};
    for (int i = 0; i < 25; ++i) a.in[i] = (const float*)d_in[i];
    a.out = out; a.ws = ws;
    auto phase = [&](int lo, int hi) { a.ph_lo = lo; a.ph_hi = hi; hipLaunchKernelGGL(skel_fwd, dim3(grid), dim3(NWAVES * 64), LDS_BYTES, stream, a); };
    (void)hipMemsetAsync(ws + WS_CTL, 0, 1 * MiB, stream);
#if MK_ONE_LAUNCH
    phase(0, NPHASE);
#else
    for (int k = 0; k < NPHASE; ++k) if (k != PH_RET2) phase(k, k + 1);
#endif
}
```

```cpp
#include <hip/hip_runtime.h>
#include <cstdint>
#include <cstdio>
#include <cmath>

typedef unsigned short bf16_t;
constexpr int D = 1024, BATCH = 8, SEQ = 2048, T = BATCH * SEQ, CHUNK = 64;
constexpr int EVEN_IN = 1440, EVEN_INP = 1536, FF = 3584, ODD_IN = 3584, NE = 8;
constexpr float EPS = 1e-6f;
constexpr int P0_QA = 0, P0_KA = 512, P0_VA = 640, P0_CQ = 768, P0_CKV = 1152, P0_KR = 1408;
constexpr int P1_Q = 0, P1_K = 512, P1_V = 1024, P1_G = 1536, P1_B = 2048, P1_C = 2560, P1_H = 3072;

constexpr size_t MiB = 1u << 20;
constexpr size_t WS_CTL = 0;
constexpr size_t WS_W_IN0 = 1 * MiB;
constexpr size_t WS_W_UQ = WS_W_IN0 + (size_t)EVEN_INP * D * 2;
constexpr size_t WS_W_UKV = WS_W_UQ + (size_t)768 * 384 * 2;
constexpr size_t WS_W_OUT0 = WS_W_UKV + (size_t)1024 * 256 * 2;
constexpr size_t WS_W_GU0 = WS_W_OUT0 + (size_t)D * D * 2;
constexpr size_t WS_W_DN0 = WS_W_GU0 + (size_t)2 * FF * D * 2;
constexpr size_t WS_W_IN1 = WS_W_DN0 + (size_t)D * FF * 2;
constexpr size_t WS_W_OUT1 = WS_W_IN1 + (size_t)ODD_IN * D * 2;
constexpr size_t WS_WE_GU = 38 * MiB;
constexpr size_t WS_WE_DN = WS_WE_GU + (size_t)NE * 2 * FF * D;
constexpr size_t WS_ACT0 = WS_WE_DN + (size_t)NE * D * FF;
static_assert(WS_W_OUT1 + (size_t)D * D * 2 <= WS_WE_GU, "dense weights fit below 38 MiB");
static_assert(WS_ACT0 == 122 * MiB, "activation base");
constexpr size_t WS_XN = WS_ACT0;
constexpr size_t WS_YMIX = WS_ACT0 + 32 * MiB;
constexpr size_t WS_BIG = WS_ACT0 + 64 * MiB;
constexpr size_t WS_PROJ0 = WS_BIG;
constexpr size_t WS_CQN = WS_BIG + 48 * MiB;
constexpr size_t WS_CKVN = WS_BIG + 60 * MiB;
constexpr size_t WS_KROPE = WS_BIG + 68 * MiB;
constexpr size_t WS_QM = WS_BIG + 70 * MiB;
constexpr size_t WS_KVM = WS_BIG + 94 * MiB;
constexpr size_t WS_ROPE = WS_BIG + 126 * MiB;
constexpr size_t WS_ACT = WS_BIG;
constexpr size_t WS_PROJ1 = WS_BIG;
constexpr size_t WS_RKV = WS_BIG + 112 * MiB;
constexpr size_t WS_YR = WS_BIG + 144 * MiB;
constexpr int MOE_MAXT = 136;
constexpr size_t WS_ACTM = WS_ACT0;
constexpr size_t WS_YP0 = WS_ACT0 + 119 * MiB;
constexpr size_t WS_YP1 = WS_YP0 + 68 * MiB;
constexpr size_t WS_TAB = WS_YP1 + 68 * MiB;
constexpr size_t WS_XNM = 1 * MiB;
constexpr size_t WS_END = WS_TAB + 2 * MiB;
static_assert(WS_END <= 471 * MiB, "workspace budget");
constexpr size_t TAB_LTOK = 0;
constexpr size_t TAB_LGATE = 512 * 1024;
constexpr size_t TAB_TSEL = 1024 * 1024;
constexpr size_t TAB_TGATE = 1280 * 1024;
constexpr int CW_CNT = 64;

__device__ __forceinline__ float bf2f(bf16_t v) { return __uint_as_float((unsigned)v << 16); }
__device__ __forceinline__ bf16_t f2bf(float f) { unsigned u = __float_as_uint(f); return (bf16_t)((u + 0x7fffu + ((u >> 16) & 1u)) >> 16); }
__device__ __forceinline__ float wave_sum(float v) {
#pragma unroll
    for (int o = 1; o < 64; o <<= 1) v += __shfl_xor(v, o);
    return v;
}
__device__ __forceinline__ float silu(float v) { return v / (1.f + __expf(-v)); }

struct RowIdent { int off; __device__ int operator()(int n) const { return off + n; } };
struct RowGU { int half; __device__ int operator()(int n) const { return 256 * (n >> 7) + 128 * half + (n & 127); } };
constexpr float LOG2E_F = 1.4426950408889634f, RLOG2E_F = 0.6931471805599453f;
template <class RM>
__global__ void __launch_bounds__(256) k_wconv(const float* __restrict__ W, int K, int N, bf16_t* __restrict__ WT, RM rm) {
    __shared__ float tile[32][33];
    const int nb = N / 32, kb = blockIdx.x / nb, n0 = (blockIdx.x % nb) * 32, k0 = kb * 32;
    const int tx = threadIdx.x & 31, ty = threadIdx.x >> 5;
    for (int i = ty; i < 32; i += 8) tile[i][tx] = W[(size_t)(k0 + i) * N + n0 + tx];
    __syncthreads();
    for (int i = ty; i < 32; i += 8) WT[(size_t)rm(n0 + i) * K + k0 + tx] = f2bf(tile[tx][i]);
}
__global__ void k_fill_bf16(bf16_t* p, size_t n, bf16_t v) { size_t i = (size_t)blockIdx.x * blockDim.x + threadIdx.x; if (i < n) p[i] = v; }

__global__ void __launch_bounds__(256) k_rmsnorm(const float* __restrict__ x, const float* __restrict__ g, bf16_t* __restrict__ o) {
    const int row = blockIdx.x * 4 + (threadIdx.x >> 6), lane = threadIdx.x & 63;
    const float* xr = x + (size_t)row * D;
    float v[16]; float s = 0.f;
#pragma unroll
    for (int j = 0; j < 16; ++j) { v[j] = xr[lane + 64 * j]; s += v[j] * v[j]; }
    const float rs = rsqrtf(wave_sum(s) * (1.f / D) + EPS);
#pragma unroll
    for (int j = 0; j < 16; ++j) o[(size_t)row * D + lane + 64 * j] = f2bf(v[j] * rs * g[lane + 64 * j]);
}

struct GemmArgs { const bf16_t* A; const bf16_t* Bt; int lda, ldb, M, N, K, pad; };
template <bool DUAL, class Ctx>
__global__ void __launch_bounds__(256) k_gemm(GemmArgs g, Ctx ctx) {
    __shared__ float As[16][68], Bs[16][68], B2[16][68];
    const int m0 = blockIdx.y * 64, n0 = blockIdx.x * 64;
    if (!ctx.block_valid(m0)) return;
    const bf16_t* Bt = g.Bt + ctx.b_offset(m0);
    const int tx = threadIdx.x & 15, ty = threadIdx.x >> 4;
    float acc[4][4], acc2[4][4];
#pragma unroll
    for (int i = 0; i < 4; ++i)
#pragma unroll
        for (int j = 0; j < 4; ++j) { acc[i][j] = 0.f; acc2[i][j] = 0.f; }
    const int lr = threadIdx.x >> 2, lk = (threadIdx.x & 3) * 4;
    const size_t arow = (size_t)ctx.a_row(m0 + lr) * g.lda;
    const size_t brow = (size_t)ctx.b_row(n0 + lr) * g.ldb;
    for (int k0 = 0; k0 < g.K; k0 += 16) {
#pragma unroll
        for (int j = 0; j < 4; ++j) {
            As[lk + j][lr] = bf2f(g.A[arow + k0 + lk + j]);
            Bs[lk + j][lr] = bf2f(Bt[brow + k0 + lk + j]);
            if (DUAL) B2[lk + j][lr] = bf2f(Bt[brow + (size_t)128 * g.ldb + k0 + lk + j]);
        }
        __syncthreads();
#pragma unroll
        for (int kk = 0; kk < 16; ++kk) {
            float a[4], b[4], b2[4];
#pragma unroll
            for (int i = 0; i < 4; ++i) { a[i] = As[kk][ty * 4 + i]; b[i] = Bs[kk][tx * 4 + i]; b2[i] = DUAL ? B2[kk][tx * 4 + i] : 0.f; }
#pragma unroll
            for (int i = 0; i < 4; ++i)
#pragma unroll
                for (int j = 0; j < 4; ++j) { acc[i][j] += a[i] * b[j]; if (DUAL) acc2[i][j] += a[i] * b2[j]; }
        }
        __syncthreads();
    }
#pragma unroll
    for (int i = 0; i < 4; ++i)
#pragma unroll
        for (int j = 0; j < 4; ++j) ctx.store(m0 + ty * 4 + i, n0 + tx * 4 + j, acc[i][j], acc2[i][j]);
}
struct CtxBf16 {
    bf16_t* O; int ldc; int pad;
    __device__ bool block_valid(int) const { return true; }
    __device__ size_t b_offset(int) const { return 0; }
    __device__ int a_row(int m) const { return m; }
    __device__ int b_row(int n) const { return n; }
    __device__ void store(int m, int n, float a, float) const { O[(size_t)m * ldc + n] = f2bf(a); }
};
struct CtxRes {
    const float* base; float* out; int ldc; int pad;
    __device__ bool block_valid(int) const { return true; }
    __device__ size_t b_offset(int) const { return 0; }
    __device__ int a_row(int m) const { return m; }
    __device__ int b_row(int n) const { return n; }
    __device__ void store(int m, int n, float a, float) const { out[(size_t)m * ldc + n] = base[(size_t)m * ldc + n] + a; }
};
struct CtxSwiglu {
    bf16_t* O; int ldc; int pad;
    __device__ bool block_valid(int) const { return true; }
    __device__ size_t b_offset(int) const { return 0; }
    __device__ int a_row(int m) const { return m; }
    __device__ int b_row(int n) const { return 256 * (n >> 7) + (n & 127); }
    __device__ void store(int m, int n, float a, float b) const { O[(size_t)m * ldc + n] = f2bf(silu(a) * b); }
};
__device__ __forceinline__ void moe_tile(const unsigned* cnt, int tile, int& e, int& slot0, int& ntiles) {
    int tb = 0; e = -1; slot0 = 0;
#pragma unroll
    for (int i = 0; i < NE; ++i) { const int c = (int)cnt[64 * i], nt = (c + 255) >> 8; if (e < 0 && tile < tb + nt) { e = i; slot0 = (tile - tb) * 256; } tb += nt; }
    ntiles = tb;
}
struct CtxMoeGU {
    bf16_t* O; const unsigned* cnt; const int* ltok; int ldc, tile_lo, tile_hi, pad;
    __device__ bool block_valid(int m0) const { int e, s0, nt; const int t = tile_lo + (m0 >> 8); moe_tile(cnt, t, e, s0, nt); return t < tile_hi && t < nt && e >= 0; }
    __device__ size_t b_offset(int m0) const { int e, s0, nt; moe_tile(cnt, tile_lo + (m0 >> 8), e, s0, nt); return (size_t)e * 2 * FF * D; }
    __device__ int a_row(int m) const { int e, s0, nt; moe_tile(cnt, tile_lo + (m >> 8), e, s0, nt); const int slot = s0 + (m & 255); return slot < (int)cnt[64 * e] ? ltok[e * T + slot] : 0; }
    __device__ int b_row(int n) const { return 256 * (n >> 7) + (n & 127); }
    __device__ void store(int m, int n, float a, float b) const { O[(size_t)m * ldc + n] = f2bf(silu(a) * b); }
};
struct CtxMoeDn {
    bf16_t* O; const unsigned* cnt; const float* lgate; int tile_lo, tile_hi;
    __device__ bool block_valid(int m0) const { int e, s0, nt; const int t = tile_lo + (m0 >> 8); moe_tile(cnt, t, e, s0, nt); return t < tile_hi && t < nt && e >= 0; }
    __device__ size_t b_offset(int m0) const { int e, s0, nt; moe_tile(cnt, tile_lo + (m0 >> 8), e, s0, nt); return (size_t)e * D * FF; }
    __device__ int a_row(int m) const { return m; }
    __device__ int b_row(int n) const { return n; }
    __device__ void store(int m, int n, float a, float) const {
        int e, s0, nt; moe_tile(cnt, tile_lo + (m >> 8), e, s0, nt); const int slot = s0 + (m & 255);
        const float gt = slot < (int)cnt[64 * e] ? lgate[e * T + slot] : 0.f;
        O[(size_t)(tile_lo * 256 + m) * D + n] = f2bf(gt * a);
    }
};

__global__ void __launch_bounds__(256) k_mla_prep(const bf16_t* __restrict__ proj0, const float* __restrict__ qg, const float* __restrict__ kvg, const int* __restrict__ pos,
                                                  bf16_t* __restrict__ cqn, bf16_t* __restrict__ ckvn, bf16_t* __restrict__ krope) {
    const int tkn = blockIdx.x * 4 + (threadIdx.x >> 6), lane = threadIdx.x & 63;
    const bf16_t* pr = proj0 + (size_t)tkn * EVEN_INP;
    float q[6], s = 0.f;
#pragma unroll
    for (int j = 0; j < 6; ++j) { q[j] = bf2f(pr[P0_CQ + lane + 64 * j]); s += q[j] * q[j]; }
    float rs = rsqrtf(wave_sum(s) * (1.f / 384.f) + EPS);
#pragma unroll
    for (int j = 0; j < 6; ++j) cqn[(size_t)tkn * 384 + lane + 64 * j] = f2bf(q[j] * rs * qg[lane + 64 * j]);
    float c[4]; s = 0.f;
#pragma unroll
    for (int j = 0; j < 4; ++j) { c[j] = bf2f(pr[P0_CKV + lane + 64 * j]); s += c[j] * c[j]; }
    rs = rsqrtf(wave_sum(s) * (1.f / 256.f) + EPS);
#pragma unroll
    for (int j = 0; j < 4; ++j) ckvn[(size_t)tkn * 256 + lane + 64 * j] = f2bf(c[j] * rs * kvg[lane + 64 * j]);
    if (lane < 16) {
        const float p = (float)pos[tkn];
        const float inv = powf(10000.f, -(float)(2 * lane) / 32.f);
        const float ang = p * inv, cs = cosf(ang), sn = sinf(ang);
        const float t1 = bf2f(pr[P0_KR + lane]), t2 = bf2f(pr[P0_KR + 16 + lane]);
        krope[(size_t)tkn * 32 + lane] = f2bf(t1 * cs - t2 * sn);
        krope[(size_t)tkn * 32 + 16 + lane] = f2bf(t2 * cs + t1 * sn);
    }
}

__global__ void __launch_bounds__(64) k_swa(const bf16_t* __restrict__ proj0, const float* __restrict__ sinks, bf16_t* __restrict__ ymix) {
    const int idx = blockIdx.x * 64 + threadIdx.x;
    const int tkn = idx >> 3, h = idx & 7, hk = h >> 2;
    const int b = tkn / SEQ, s = tkn % SEQ, n = s / CHUNK, qi = s % CHUNK;
    const float slope = exp2f(-8.f * (float)(h + 1) / 8.f);
    float q[64], o[64];
#pragma unroll
    for (int d = 0; d < 64; ++d) { q[d] = bf2f(proj0[(size_t)tkn * EVEN_INP + P0_QA + h * 64 + d]); o[d] = 0.f; }
    const float sink = sinks[h];
    float m = sink, l = 1.f;
    const int k_lo = (n - 2) * CHUNK, k_hi = (n + 1) * CHUNK;
    for (int kp = (k_lo < 0 ? 0 : k_lo); kp < k_hi; ++kp) {
        const bf16_t* kr = proj0 + (size_t)(b * SEQ + kp) * EVEN_INP + P0_KA + hk * 64;
        float sc = 0.f;
#pragma unroll
        for (int d = 0; d < 64; ++d) sc += q[d] * bf2f(kr[d]);
        const int kk = kp - k_lo;
        const float dist = fabsf((float)(qi + 2 * CHUNK - kk));
        sc = sc * 0.125f - slope * dist;
        const float mn = fmaxf(m, sc), f = __expf(m - mn), p = __expf(sc - mn);
        l = l * f + p; m = mn;
        const bf16_t* vr = proj0 + (size_t)(b * SEQ + kp) * EVEN_INP + P0_VA + hk * 64;
#pragma unroll
        for (int d = 0; d < 64; ++d) o[d] = o[d] * f + p * bf2f(vr[d]);
    }
    const float il = 1.f / l;
#pragma unroll
    for (int d = 0; d < 64; ++d) ymix[(size_t)tkn * D + h * 64 + d] = f2bf(o[d] * il);
}

__global__ void __launch_bounds__(64) k_mla(const bf16_t* __restrict__ qm, const bf16_t* __restrict__ kvm, const bf16_t* __restrict__ krope, const int* __restrict__ pos, bf16_t* __restrict__ ymix) {
    const int idx = blockIdx.x * 64 + threadIdx.x;
    const int tkn = idx >> 3, h = idx & 7;
    const int b = tkn / SEQ, s = tkn % SEQ, c = s / CHUNK;
    float q[96], o[64];
#pragma unroll
    for (int d = 0; d < 96; ++d) q[d] = bf2f(qm[(size_t)tkn * 768 + h * 96 + d]);
    {
        const float p = (float)pos[tkn];
#pragma unroll
        for (int i = 0; i < 16; ++i) {
            const float inv = powf(10000.f, -(float)(2 * i) / 32.f), ang = p * inv, cs = cosf(ang), sn = sinf(ang);
            const float t1 = q[64 + i], t2 = q[80 + i];
            q[64 + i] = t1 * cs - t2 * sn; q[80 + i] = t2 * cs + t1 * sn;
        }
    }
#pragma unroll
    for (int d = 0; d < 64; ++d) o[d] = 0.f;
    const float scale = 0.10206207261596577f;
    float m = -1e30f, l = 0.f;
    const int nk = (c + 1) * CHUNK;
    for (int kp = 0; kp < nk; ++kp) {
        const bf16_t* kr = kvm + (size_t)(b * SEQ + kp) * 1024 + h * 128;
        const bf16_t* rr = krope + (size_t)(b * SEQ + kp) * 32;
        float sc = 0.f;
#pragma unroll
        for (int d = 0; d < 64; ++d) sc += q[d] * bf2f(kr[d]);
#pragma unroll
        for (int d = 0; d < 32; ++d) sc += q[64 + d] * bf2f(rr[d]);
        sc *= scale;
        const float mn = fmaxf(m, sc), f = __expf(m - mn), p = __expf(sc - mn);
        l = l * f + p; m = mn;
#pragma unroll
        for (int d = 0; d < 64; ++d) o[d] = o[d] * f + p * bf2f(kr[64 + d]);
    }
    const float il = 1.f / l;
#pragma unroll
    for (int d = 0; d < 64; ++d) ymix[(size_t)tkn * D + 512 + h * 64 + d] = f2bf(o[d] * il);
}

__global__ void __launch_bounds__(128) k_ret(const bf16_t* __restrict__ proj1, float* __restrict__ yr) {
    const int bh = blockIdx.x, b = bh >> 2, h = bh & 3, dv = threadIdx.x;
    const float g = 1.f - exp2f(-5.f - (float)h);
    const float ks = 0.08838834764831845f;
    float S[128];
#pragma unroll
    for (int d = 0; d < 128; ++d) S[d] = 0.f;
    __shared__ float qs[128], kss[128];
    for (int s = 0; s < SEQ; ++s) {
        const bf16_t* pr = proj1 + (size_t)(b * SEQ + s) * ODD_IN;
        __syncthreads();
        qs[dv] = bf2f(pr[P1_Q + h * 128 + dv]); kss[dv] = bf2f(pr[P1_K + h * 128 + dv]) * ks;
        __syncthreads();
        const float v = bf2f(pr[P1_V + h * 128 + dv]);
        float o = 0.f;
#pragma unroll
        for (int d = 0; d < 128; ++d) { S[d] = g * S[d] + kss[d] * v; o += qs[d] * S[d]; }
        yr[(size_t)(b * SEQ + s) * 512 + h * 128 + dv] = o;
    }
}
__global__ void __launch_bounds__(256) k_ret_gn(const float* __restrict__ yr, const bf16_t* __restrict__ proj1, const float* __restrict__ gn, bf16_t* __restrict__ ymix) {
    const int w = blockIdx.x * 4 + (threadIdx.x >> 6), lane = threadIdx.x & 63;
    const int tkn = w >> 2, h = w & 3;
    const float a = yr[(size_t)tkn * 512 + h * 128 + lane], c = yr[(size_t)tkn * 512 + h * 128 + 64 + lane];
    const float mu = wave_sum(a + c) * (1.f / 128.f);
    const float da = a - mu, dc = c - mu;
    const float var = wave_sum(da * da + dc * dc) * (1.f / 128.f);
    const float rs = rsqrtf(var + EPS);
    const float g0 = bf2f(proj1[(size_t)tkn * ODD_IN + P1_G + h * 128 + lane]), g1 = bf2f(proj1[(size_t)tkn * ODD_IN + P1_G + h * 128 + 64 + lane]);
    ymix[(size_t)tkn * D + h * 128 + lane] = f2bf(silu(g0) * da * rs * gn[h * 128 + lane]);
    ymix[(size_t)tkn * D + h * 128 + 64 + lane] = f2bf(silu(g1) * dc * rs * gn[h * 128 + 64 + lane]);
}
__global__ void __launch_bounds__(256) k_conv(const bf16_t* __restrict__ proj1, const float* __restrict__ w, bf16_t* __restrict__ ymix) {
    const size_t i = (size_t)blockIdx.x * 256 + threadIdx.x;
    const int tkn = (int)(i >> 9), c = (int)(i & 511), s = tkn % SEQ;
    float y = 0.f;
#pragma unroll
    for (int j = 0; j < 3; ++j) {
        const int sp = s - 2 + j;
        if (sp >= 0) { const bf16_t* pr = proj1 + (size_t)(tkn - 2 + j) * ODD_IN; y += w[j * 512 + c] * bf2f(pr[P1_C + c]) * bf2f(pr[P1_H + c]); }
    }
    ymix[(size_t)tkn * D + 512 + c] = f2bf(bf2f(proj1[(size_t)tkn * ODD_IN + P1_B + c]) * y);
}

__global__ void __launch_bounds__(512) k_route(const float* __restrict__ x, const float* __restrict__ g, const float* __restrict__ router, bf16_t* __restrict__ xnm,
                                               unsigned* __restrict__ ctl, unsigned char* __restrict__ tab) {
    __shared__ unsigned lcnt[NE], lbase[NE];
    __shared__ int se[64][2], ss[64][2]; __shared__ float sg[64][2];
    const int wave = threadIdx.x >> 6, lane = threadIdx.x & 63;
    if (threadIdx.x < NE) lcnt[threadIdx.x] = 0u;
    __syncthreads();
    for (int it = 0; it < 8; ++it) {
        const int lt = wave * 8 + it, tkn = blockIdx.x * 64 + lt;
        const float* xr = x + (size_t)tkn * D;
        float v[16]; float s = 0.f;
#pragma unroll
        for (int j = 0; j < 16; ++j) { v[j] = xr[lane + 64 * j]; s += v[j] * v[j]; }
        const float rs = rsqrtf(wave_sum(s) * (1.f / D) + EPS);
        float lg[NE];
#pragma unroll
        for (int e = 0; e < NE; ++e) lg[e] = 0.f;
#pragma unroll
        for (int j = 0; j < 16; ++j) {
            const float hv = v[j] * rs * g[lane + 64 * j];
            xnm[(size_t)tkn * D + lane + 64 * j] = f2bf(hv);
#pragma unroll
            for (int e = 0; e < NE; ++e) lg[e] += hv * router[(size_t)(lane + 64 * j) * NE + e];
        }
#pragma unroll
        for (int e = 0; e < NE; ++e) lg[e] = wave_sum(lg[e]);
        int e0 = 0; float v0 = lg[0];
#pragma unroll
        for (int e = 1; e < NE; ++e) if (lg[e] > v0) { v0 = lg[e]; e0 = e; }
        int e1 = -1; float v1 = -INFINITY;
#pragma unroll
        for (int e = 0; e < NE; ++e) if (e != e0 && lg[e] > v1) { v1 = lg[e]; e1 = e; }
        const float p1 = __expf(v1 - v0), g0 = 1.f / (1.f + p1), g1 = p1 / (1.f + p1);
        if (lane == 0) { se[lt][0] = e0; se[lt][1] = e1; sg[lt][0] = g0; sg[lt][1] = g1; ss[lt][0] = (int)atomicAdd(&lcnt[e0], 1u); ss[lt][1] = (int)atomicAdd(&lcnt[e1], 1u); }
    }
    __syncthreads();
    if (threadIdx.x < NE) lbase[threadIdx.x] = atomicAdd(&ctl[CW_CNT + 64 * threadIdx.x], lcnt[threadIdx.x]);
    __syncthreads();
    if (threadIdx.x < 64) {
        const int lt = threadIdx.x, tkn = blockIdx.x * 64 + lt;
        int* ltok = (int*)(tab + TAB_LTOK); float* lgate = (float*)(tab + TAB_LGATE); int* tsel = (int*)(tab + TAB_TSEL);
#pragma unroll
        for (int k = 0; k < 2; ++k) { const int e = se[lt][k], slot = (int)lbase[e] + ss[lt][k]; ltok[e * T + slot] = tkn; lgate[e * T + slot] = sg[lt][k]; tsel[tkn * 4 + 2 * k] = e; tsel[tkn * 4 + 2 * k + 1] = slot; }
    }
}

__global__ void __launch_bounds__(256) k_final(const float* x3, const bf16_t* __restrict__ yp0, const bf16_t* __restrict__ yp1, const unsigned* __restrict__ ctl,
                                               const unsigned char* __restrict__ tab, const float* __restrict__ g, float* out) {
    const int tkn = blockIdx.x * 4 + (threadIdx.x >> 6), lane = threadIdx.x & 63;
    const int* tsel = (const int*)(tab + TAB_TSEL);
    size_t row[2];
#pragma unroll
    for (int k = 0; k < 2; ++k) {
        const int e = tsel[tkn * 4 + 2 * k], slot = tsel[tkn * 4 + 2 * k + 1];
        int tb = 0;
        for (int i = 0; i < e; ++i) tb += ((int)ctl[CW_CNT + 64 * i] + 255) >> 8;
        row[k] = (size_t)tb * 256 + slot;
    }
    float v[16]; float s = 0.f;
#pragma unroll
    for (int j = 0; j < 16; ++j) {
        const int c = lane + 64 * j;
        v[j] = x3[(size_t)tkn * D + c] + bf2f(yp0[row[0] * D + c]) + bf2f(yp1[row[0] * D + c]) + bf2f(yp0[row[1] * D + c]) + bf2f(yp1[row[1] * D + c]);
        s += v[j] * v[j];
    }
    const float rs = rsqrtf(wave_sum(s) * (1.f / D) + EPS);
#pragma unroll
    for (int j = 0; j < 16; ++j) out[(size_t)tkn * D + lane + 64 * j] = v[j] * rs * g[lane + 64 * j];
}


namespace pg8 {
#define PG8_LAS __attribute__((address_space(3)))
typedef short bf16x8 __attribute__((ext_vector_type(8)));
typedef float f32x4 __attribute__((ext_vector_type(4)));
typedef unsigned u32x4 __attribute__((ext_vector_type(4)));
typedef int i32x4 __attribute__((ext_vector_type(4)));
constexpr int BM = 256, BK = 64, HALF = 128, HTB = HALF * BK * 2  , STAGE_BYTES = 8 * HTB, NXCD = 8, WGM = 8;
__host__ __device__ __forceinline__ int lds_byte(int r, int c) { const int st = (r >> 4) * 2 + (c >> 5), rr = r & 15, cc = c & 31, ob = rr * 64 + cc * 2; return st * 1024 + (ob ^ (((ob >> 9) & 1) << 5)); }
__host__ __device__ __forceinline__ void stage_rc(int b, int& R, int& C) { const int st = b / 1024, sb = b % 1024, swz = sb ^ (((sb >> 9) & 1) << 5); R = (st >> 1) * 16 + swz / 64; C = (st & 1) * 32 + (swz % 64) / 2; }
__host__ __device__ __forceinline__ int perm32(int rho) { const int n = rho >> 4, i = rho & 15; return 8 * (i >> 2) + 4 * n + (i & 3); }

struct Unit { int pm, pn, be, s0, ko; };
struct Gemm { const void* A; const void* Bt; int lda, ldb, K; size_t bgroup; int sclA, sclB, sclB1; };

struct StaticOrder {
    int nM, nN, nwg, G, c;
    __device__ void init(int nM_, int nN_, int G_, int c_) { nM = nM_; nN = nN_; nwg = nM * nN; G = G_; c = c_; }
    __device__ bool next(int i, Unit& u) const {
        const long L = (long)i * G + c; if (L >= nwg) return false;
        int wgid = (int)L; { const int q = nwg / NXCD, r = nwg % NXCD, xcd = wgid % NXCD, off = wgid / NXCD; wgid = (xcd < r ? xcd * (q + 1) : r * (q + 1) + (xcd - r) * q) + off; }
        const int nig = WGM * nN, gid = wgid / nig, fm = gid * WGM, gsz = (nM - fm) < WGM ? (nM - fm) : WGM;
        u.pm = fm + ((wgid % nig) % gsz); u.pn = (wgid % nig) / gsz; u.be = 0; u.s0 = 0; u.ko = 0; return true;
    }
};
struct MoeOrder {
    StaticOrder so; int tlo, nNr, kper; unsigned tbp0, tbp1;
    __device__ void init(const unsigned* cnt, int tlo_, int thi_, int nN, int ksplit, int kper_, int G, int c) {
        int t = 0; tbp0 = 0u; tbp1 = 0u;
#pragma unroll
        for (int e = 0; e < NE; ++e) { if (e < 4) tbp0 |= (unsigned)t << (8 * e); else tbp1 |= (unsigned)t << (8 * (e - 4));
            t += ((int)__hip_atomic_load(cnt + 64 * e, __ATOMIC_RELAXED, __HIP_MEMORY_SCOPE_AGENT) + 255) >> 8; }
        tlo = tlo_; nNr = nN; kper = kper_; const int hi = thi_ < t ? thi_ : t; so.init(hi > tlo_ ? hi - tlo_ : 0, nN * ksplit, G, c);
    }
    __device__ bool next(int i, Unit& u) const {
        if (!so.next(i, u)) return false;
        const int tile = tlo + u.pm; int e = 0, tbe = 0;
#pragma unroll
        for (int k = 1; k < NE; ++k) { const int tk = (int)(((k < 4 ? tbp0 : tbp1) >> (8 * (k & 3))) & 0xffu); if (tile >= tk) { e = k; tbe = tk; } }
        u.be = e; u.s0 = (tile - tbe) * 256; const int kh = u.pn / nNr; u.pn -= kh * nNr; u.ko = kh * kper; return true;
    }
};
struct ARowIdent {
    __device__ __forceinline__ unsigned direct(const Unit& u, int r) const { return (unsigned)(u.pm * BM + r); }
    __device__ __forceinline__ void prefetch(const Unit&, PG8_LAS unsigned*) const {}
    __device__ __forceinline__ unsigned get(const Unit& u, int r, const PG8_LAS unsigned*) const { return (unsigned)(u.pm * BM + r); }
};
struct ARowMoe {
    const int* ltok; const unsigned* cnt;
    __device__ __forceinline__ unsigned direct(const Unit& u, int r) const {
        const int slot = u.s0 + r, n = (int)__hip_atomic_load(cnt + 64 * u.be, __ATOMIC_RELAXED, __HIP_MEMORY_SCOPE_AGENT);
        return slot < n ? (unsigned)ltok[u.be * T + slot] : 0u;
    }
    __device__ __forceinline__ void prefetch(const Unit& u, PG8_LAS unsigned* tab) const { if (threadIdx.x < BM) tab[threadIdx.x] = direct(u, (int)threadIdx.x); }
    __device__ __forceinline__ unsigned get(const Unit&, int r, const PG8_LAS unsigned* tab) const { return tab[r]; }
};

__device__ __forceinline__ unsigned cvt_pk_bf16(float lo, float hi) { unsigned r; asm volatile("v_cvt_pk_bf16_f32 %0, %1, %2" : "=v"(r) : "v"(lo), "v"(hi)); return r; }
struct EpiBf16 {
    static constexpr bool PERM = true;
    bf16_t* O; int ldc;
    __device__ __forceinline__ void operator()(const f32x4 (&acc)[2][2][4][2], const Unit& u, int wr, int wc, int fr, int fq) const {
        const int row0 = u.pm * BM + wr * 64 + fr, col0 = u.pn * BM + wc * 32 + 8 * fq;
#pragma unroll
        for (int ai = 0; ai < 2; ++ai)
#pragma unroll
            for (int m = 0; m < 4; ++m) { bf16_t* rowp = O + (size_t)(row0 + ai * HALF + m * 16) * ldc + col0;
#pragma unroll
                for (int bj = 0; bj < 2; ++bj) { const f32x4 v0 = acc[ai][bj][m][0], v1 = acc[ai][bj][m][1];
                    u32x4 w; w.x = cvt_pk_bf16(v0[0], v0[1]); w.y = cvt_pk_bf16(v0[2], v0[3]); w.z = cvt_pk_bf16(v1[0], v1[1]); w.w = cvt_pk_bf16(v1[2], v1[3]);
                    *(u32x4*)(rowp + bj * HALF) = w; } }
    }
};
struct EpiRes {
    static constexpr bool PERM = false;
    const float* base; float* out; int ldc;
    __device__ __forceinline__ void operator()(const f32x4 (&acc)[2][2][4][2], const Unit& u, int wr, int wc, int fr, int fq) const {
        const int row0 = u.pm * BM + wr * 64 + fr, col0 = u.pn * BM + wc * 32 + 4 * fq;
#pragma unroll
        for (int ai = 0; ai < 2; ++ai) {
            f32x4 b[4][2][2];
#pragma unroll
            for (int m = 0; m < 4; ++m) { const size_t off = (size_t)(row0 + ai * HALF + m * 16) * ldc + col0;
#pragma unroll
                for (int bj = 0; bj < 2; ++bj)
#pragma unroll
                    for (int n = 0; n < 2; ++n) b[m][bj][n] = *(const f32x4*)(base + off + bj * HALF + n * 16); }
            asm volatile("" ::: "memory");
#pragma unroll
            for (int m = 0; m < 4; ++m) { const size_t off = (size_t)(row0 + ai * HALF + m * 16) * ldc + col0;
#pragma unroll
                for (int bj = 0; bj < 2; ++bj)
#pragma unroll
                    for (int n = 0; n < 2; ++n) *(f32x4*)(out + off + bj * HALF + n * 16) = b[m][bj][n] + acc[ai][bj][m][n]; }
            asm volatile("" ::: "memory");
        }
    }
};
__device__ __forceinline__ float silu_f(float v) { return v * __builtin_amdgcn_rcpf(1.f + __expf(-v)); }
typedef float f32x2 __attribute__((ext_vector_type(2)));
__device__ __forceinline__ f32x2 swiglu2(f32x2 g2, f32x2 up) {
    f32x2 e; e.x = __builtin_amdgcn_exp2f(-g2.x); e.y = __builtin_amdgcn_exp2f(-g2.y);
    const f32x2 d = e + 1.0f; f32x2 r; r.x = __builtin_amdgcn_rcpf(d.x); r.y = __builtin_amdgcn_rcpf(d.y);
    return (g2 * up) * r;
}
struct EpiSwiglu {
    static constexpr bool PERM = true;
    bf16_t* O; int ldc;
    __device__ __forceinline__ void operator()(const f32x4 (&acc)[2][2][4][2], const Unit& u, int wr, int wc, int fr, int fq) const {
        const int row0 = u.pm * BM + wr * 64 + fr, col0 = u.pn * HALF + wc * 32 + 8 * fq;
#pragma unroll
        for (int ai = 0; ai < 2; ++ai)
#pragma unroll
            for (int m = 0; m < 4; ++m) { bf16_t* rowp = O + (size_t)(row0 + ai * HALF + m * 16) * ldc + col0;
                const f32x4 g0 = acc[ai][0][m][0], g1 = acc[ai][0][m][1], u0 = acc[ai][1][m][0], u1 = acc[ai][1][m][1];
                const f32x2 a = swiglu2((f32x2){g0[0], g0[1]}, (f32x2){u0[0], u0[1]}), b = swiglu2((f32x2){g0[2], g0[3]}, (f32x2){u0[2], u0[3]});
                const f32x2 c = swiglu2((f32x2){g1[0], g1[1]}, (f32x2){u1[0], u1[1]}), d = swiglu2((f32x2){g1[2], g1[3]}, (f32x2){u1[2], u1[3]});
                u32x4 w; w.x = cvt_pk_bf16(a.x, a.y); w.y = cvt_pk_bf16(b.x, b.y); w.z = cvt_pk_bf16(c.x, c.y); w.w = cvt_pk_bf16(d.x, d.y);
                *(u32x4*)rowp = w; }
    }
};
__device__ __forceinline__ float clamp448(float v) { return __builtin_amdgcn_fmed3f(v, -448.f, 448.f); }
__device__ __forceinline__ unsigned pk4_fp8(float a, float b, float c, float d) { unsigned w = 0u; w = __builtin_amdgcn_cvt_pk_fp8_f32(clamp448(a), clamp448(b), w, false); w = __builtin_amdgcn_cvt_pk_fp8_f32(clamp448(c), clamp448(d), w, true); return w; }
struct EpiSwiglu8 {
    static constexpr bool PERM = true;
    unsigned char* O; int ldc;
    __device__ __forceinline__ void operator()(const f32x4 (&acc)[2][2][4][2], const Unit& u, int wr, int wc, int fr, int fq) const {
        const int row0 = u.pm * BM + wr * 64 + fr, col0 = u.pn * HALF + wc * 32 + 8 * fq;
#pragma unroll
        for (int ai = 0; ai < 2; ++ai)
#pragma unroll
            for (int m = 0; m < 4; ++m) { unsigned char* rowp = O + (size_t)(row0 + ai * HALF + m * 16) * ldc + col0;
                const f32x4 g0 = acc[ai][0][m][0], g1 = acc[ai][0][m][1], u0 = acc[ai][1][m][0], u1 = acc[ai][1][m][1];
                const f32x2 a = swiglu2((f32x2){g0[0], g0[1]}, (f32x2){u0[0], u0[1]}), b = swiglu2((f32x2){g0[2], g0[3]}, (f32x2){u0[2], u0[3]});
                const f32x2 c = swiglu2((f32x2){g1[0], g1[1]}, (f32x2){u1[0], u1[1]}), d = swiglu2((f32x2){g1[2], g1[3]}, (f32x2){u1[2], u1[3]});
                typedef unsigned u32x2 __attribute__((ext_vector_type(2)));
                u32x2 w; w.x = pk4_fp8(a.x, a.y, b.x, b.y); w.y = pk4_fp8(c.x, c.y, d.x, d.y);
                *(u32x2*)rowp = w; }
    }
};
struct EpiMoeDn {
    static constexpr bool PERM = true;
    bf16_t* O0; bf16_t* O1; const float* lgate; const unsigned* cnt; int tlo;
    __device__ __forceinline__ void operator()(const f32x4 (&acc)[2][2][4][2], const Unit& u, int wr, int wc, int fr, int fq) const {
        const int r0 = wr * 64 + fr, col0 = u.pn * BM + wc * 32 + 8 * fq;
        const int n = (int)__hip_atomic_load(cnt + 64 * u.be, __ATOMIC_RELAXED, __HIP_MEMORY_SCOPE_AGENT);
#pragma unroll
        for (int ai = 0; ai < 2; ++ai)
#pragma unroll
            for (int m = 0; m < 4; ++m) { const int r = r0 + ai * HALF + m * 16, slot = u.s0 + r; const float gt = slot < n ? lgate[u.be * T + slot] : 0.f;
                bf16_t* rowp = (u.ko ? O1 : O0) + (size_t)((tlo + u.pm) * BM + r) * D + col0;
#pragma unroll
                for (int bj = 0; bj < 2; ++bj) { const f32x4 v0 = acc[ai][bj][m][0] * gt, v1 = acc[ai][bj][m][1] * gt;
                    u32x4 w; w.x = cvt_pk_bf16(v0[0], v0[1]); w.y = cvt_pk_bf16(v0[2], v0[3]); w.z = cvt_pk_bf16(v1[0], v1[1]); w.w = cvt_pk_bf16(v1[2], v1[3]);
                    *(u32x4*)(rowp + bj * HALF) = w; } }
    }
};

template <class Epi, class Sched, class ARow, bool ALIGN_EPI, bool F8 = false>
__device__ __forceinline__ void gemm_phase(PG8_LAS unsigned char* lds, PG8_LAS unsigned* rowtab, const Gemm g, const Sched& S, const ARow& AR, const Epi& E) {
    const int tid = threadIdx.x, wid = __builtin_amdgcn_readfirstlane(tid >> 6), lane = tid & 63, wr = wid >> 2, wc = wid & 3, fr = lane & 15, fq = lane >> 4;
    constexpr int ESZ = F8 ? 1 : 2;
    const int nt = g.K * ESZ / (BK * 2);
    int Rr[2]; unsigned Cb[2], voffB[2];
#pragma unroll
    for (int i = 0; i < 2; ++i) { int R, C; stage_rc(tid * 16 + i * 8192, R, C); const int Rb = Epi::PERM ? ((R & ~31) + perm32(R & 31)) : R;
        Rr[i] = R; Cb[i] = (unsigned)C * 2u; voffB[i] = (unsigned)(Rb * g.ldb * ESZ + C * 2); }
    const size_t kstep = (size_t)(BK * 2);
    const size_t hstepB = (size_t)HALF * g.ldb * ESZ;
    const unsigned lda2 = (unsigned)g.lda * ESZ;
    const unsigned ldsw = (unsigned)wid * 1024u;
    const int aoff = lds_byte(wr * 64 + fr, fq * 8), boff = lds_byte(wc * 32 + fr, fq * 8);
#define PG8_SA(b, h) (((b) * 2 + (h)) * HTB)
#define PG8_SB(b, h) ((4 + (b) * 2 + (h)) * HTB)
#define PG8_STAGE(bufoff, gbase, voff) do { _Pragma("unroll") for (int _i = 0; _i < 2; ++_i) \
        __builtin_amdgcn_global_load_lds((const unsigned*)((const char*)(gbase) + (voff)[_i]), (PG8_LAS unsigned*)(lds + (bufoff) + ldsw + _i * 8192), 16, 0, 0); } while (0)
#define PG8_LDA(dst, b, h) do { _Pragma("unroll") for (int m = 0; m < 4; ++m) _Pragma("unroll") for (int k = 0; k < 2; ++k) dst[m][k] = *(const PG8_LAS bf16x8*)(lds + PG8_SA(b, h) + aoff + m * 2048 + k * 1024); } while (0)
#define PG8_LDB(dst, b, h) do { _Pragma("unroll") for (int n = 0; n < 2; ++n) _Pragma("unroll") for (int k = 0; k < 2; ++k) dst[n][k] = *(const PG8_LAS bf16x8*)(lds + PG8_SB(b, h) + boff + n * 2048 + k * 1024); } while (0)
#define PG8_CAT(x) __builtin_shufflevector(__builtin_bit_cast(i32x4, x[0]), __builtin_bit_cast(i32x4, x[1]), 0, 1, 2, 3, 4, 5, 6, 7)
#define PG8_MMA(ai, bj, At, Bt) do { __builtin_amdgcn_s_setprio(1); _Pragma("unroll") for (int m = 0; m < 4; ++m) _Pragma("unroll") for (int n = 0; n < 2; ++n) { \
        if constexpr (F8) acc[ai][bj][m][n] = __builtin_amdgcn_mfma_scale_f32_16x16x128_f8f6f4(PG8_CAT(Bt[n]), PG8_CAT(At[m]), acc[ai][bj][m][n], 0, 0, 0, (bj) == 0 ? g.sclB : g.sclB1, 0, g.sclA); \
        else { _Pragma("unroll") for (int k = 0; k < 2; ++k) acc[ai][bj][m][n] = __builtin_amdgcn_mfma_f32_16x16x32_bf16(Bt[n][k], At[m][k], acc[ai][bj][m][n], 0, 0, 0); } } \
        __builtin_amdgcn_s_setprio(0); } while (0)
#define PG8_WAIT_V(n) asm volatile("s_waitcnt vmcnt(" #n ")" ::: "memory")
#define PG8_WAIT_L(n) asm volatile("s_waitcnt lgkmcnt(" #n ")" ::: "memory")
#define PG8_BAR __builtin_amdgcn_s_barrier()
#define PG8_SCHED __builtin_amdgcn_sched_barrier(0)
    Unit cur, nxt; int ui = 0;
    if (!S.next(0, cur)) return;
    f32x4 acc[2][2][4][2];
#pragma unroll
    for (int a = 0; a < 2; ++a)
#pragma unroll
        for (int b = 0; b < 2; ++b)
#pragma unroll
            for (int m = 0; m < 4; ++m)
#pragma unroll
                for (int n = 0; n < 2; ++n) acc[a][b][m][n] = (f32x4){0.f, 0.f, 0.f, 0.f};
    bf16x8 At[4][2], B0[2][2], B1[2][2];
    unsigned offC[2][2];
#pragma unroll
    for (int h = 0; h < 2; ++h)
#pragma unroll
        for (int i = 0; i < 2; ++i) offC[h][i] = AR.direct(cur, h * HALF + Rr[i]) * lda2 + Cb[i];
    const char* cA = (const char*)g.A + (size_t)cur.ko * ESZ;
    const char* cB = (const char*)g.Bt + ((size_t)cur.be * g.bgroup + (size_t)cur.pn * BM * g.ldb + cur.ko) * ESZ;
    PG8_STAGE(PG8_SB(0, 0), cB, voffB); PG8_STAGE(PG8_SB(0, 1), cB + hstepB, voffB); PG8_STAGE(PG8_SA(0, 0), cA, offC[0]); PG8_STAGE(PG8_SA(0, 1), cA, offC[1]);
    if (wr == 1) PG8_BAR;
    PG8_WAIT_V(2); PG8_BAR;
    PG8_STAGE(PG8_SB(1, 0), cB + kstep, voffB); PG8_STAGE(PG8_SA(1, 0), cA + kstep, offC[0]); PG8_STAGE(PG8_SB(1, 1), cB + hstepB + kstep, voffB);
    PG8_WAIT_V(6); PG8_BAR;
    for (;;) {
        const bool has_next = S.next(ui + 1, nxt);
        if (has_next) AR.prefetch(nxt, rowtab);
        const char* nA = has_next ? (const char*)g.A + (size_t)nxt.ko * ESZ : cA;
        const char* nB = has_next ? (const char*)g.Bt + ((size_t)nxt.be * g.bgroup + (size_t)nxt.pn * BM * g.ldb + nxt.ko) * ESZ : cB;
        for (int t = 0; t < nt; t += 2) {
            const bool last = (t == nt - 2);
            const char* a1 = cA + (size_t)(t + 1) * kstep;
            const char* a2 = last ? nA : cA + (size_t)(t + 2) * kstep; const char* b2 = last ? nB : cB + (size_t)(t + 2) * kstep;
            const char* a3 = a2 + kstep; const char* b3 = b2 + kstep;
            PG8_LDB(B0, 0, 0); PG8_LDB(B1, 0, 1); PG8_SCHED; PG8_LDA(At, 0, 0); PG8_STAGE(PG8_SA(1, 1), a1, offC[1]);
            if (last && has_next) {
#pragma unroll
                for (int h = 0; h < 2; ++h)
#pragma unroll
                    for (int i = 0; i < 2; ++i) offC[h][i] = AR.get(nxt, h * HALF + Rr[i], rowtab) * lda2 + Cb[i]; }
            PG8_WAIT_V(8); PG8_WAIT_L(0); PG8_BAR; PG8_MMA(0, 0, At, B0); PG8_MMA(0, 1, At, B1); PG8_BAR; PG8_SCHED;
            PG8_LDA(At, 0, 1); PG8_STAGE(PG8_SB(0, 0), b2, voffB); PG8_STAGE(PG8_SB(0, 1), b2 + hstepB, voffB); PG8_STAGE(PG8_SA(0, 0), a2, offC[0]);
            PG8_WAIT_V(8); PG8_WAIT_L(0); PG8_BAR; PG8_MMA(1, 0, At, B0); PG8_MMA(1, 1, At, B1); PG8_BAR; PG8_SCHED;
            PG8_LDB(B0, 1, 0); PG8_LDB(B1, 1, 1); PG8_SCHED; PG8_LDA(At, 1, 0); PG8_STAGE(PG8_SA(0, 1), a2, offC[1]);
            PG8_WAIT_V(8); PG8_WAIT_L(0); PG8_BAR; PG8_MMA(0, 0, At, B0); PG8_MMA(0, 1, At, B1); PG8_BAR; PG8_SCHED;
            PG8_LDA(At, 1, 1); PG8_STAGE(PG8_SB(1, 0), b3, voffB); PG8_STAGE(PG8_SB(1, 1), b3 + hstepB, voffB); PG8_STAGE(PG8_SA(1, 0), a3, offC[0]);
            PG8_WAIT_V(8); PG8_WAIT_L(0); PG8_BAR; PG8_MMA(1, 0, At, B0); PG8_MMA(1, 1, At, B1); PG8_BAR; PG8_SCHED;
        }
        if constexpr (ALIGN_EPI) { if (wr == 0) PG8_BAR; }
        E(acc, cur, wr, wc, fr, fq);
        if (!has_next) break;
#pragma unroll
        for (int a = 0; a < 2; ++a)
#pragma unroll
            for (int b = 0; b < 2; ++b)
#pragma unroll
                for (int m = 0; m < 4; ++m)
#pragma unroll
                    for (int n = 0; n < 2; ++n) acc[a][b][m][n] = (f32x4){0.f, 0.f, 0.f, 0.f};
        cur = nxt; cA = nA; cB = nB; ++ui;
        if constexpr (ALIGN_EPI) { if (wr == 1) PG8_BAR; }
    }
    PG8_WAIT_V(0);
    if constexpr (!ALIGN_EPI) { if (wr == 0) PG8_BAR; }
    PG8_BAR;
#undef PG8_SA
#undef PG8_SB
#undef PG8_STAGE
#undef PG8_LDA
#undef PG8_LDB
#undef PG8_MMA
#undef PG8_CAT
#undef PG8_WAIT_V
#undef PG8_WAIT_L
#undef PG8_BAR
#undef PG8_SCHED
}
}


namespace att {
typedef float f32x16 __attribute__((ext_vector_type(16)));
typedef float f32x4 __attribute__((ext_vector_type(4)));
typedef short bf16x8 __attribute__((ext_vector_type(8)));
typedef short s16x4 __attribute__((ext_vector_type(4)));
typedef unsigned u32x4 __attribute__((ext_vector_type(4)));
#define ATT_LAS __attribute__((address_space(3)))
constexpr int KBUF = 13312, VBUF = 8192, L_K0 = 0, L_V0 = 2 * KBUF, L_SCR = L_V0 + 2 * VBUF, L_OST = L_SCR + 8 * 256, L_END = L_OST + 8 * 4096,
              SWA_KBUF = 64 * 144, SWA_K0 = L_END, SWA_V0 = SWA_K0 + 3 * SWA_KBUF, SWA_END = SWA_V0 + 3 * VBUF;
constexpr float LOG2E = 1.4426950408889634f;
__device__ __forceinline__ s16x4 trread(const ATT_LAS char* p) { return __builtin_bit_cast(s16x4, __builtin_amdgcn_ds_read_tr16_b64_v4i16((ATT_LAS s16x4*)p)); }
__device__ __forceinline__ unsigned cvtpk(float lo, float hi) { unsigned r; asm volatile("v_cvt_pk_bf16_f32 %0, %1, %2" : "=v"(r) : "v"(lo), "v"(hi)); return r; }
#define ATT_PACK8(P, B) __builtin_bit_cast(bf16x8, (u32x4){cvtpk(P[(B) + 0], P[(B) + 1]), cvtpk(P[(B) + 2], P[(B) + 3]), cvtpk(P[(B) + 4], P[(B) + 5]), cvtpk(P[(B) + 6], P[(B) + 7])})
__device__ __forceinline__ bf16x8 vfrag(const ATT_LAS char* vp) { const s16x4 lo = trread(vp), hi = trread(vp + 8 * 64); return (bf16x8){lo[0], lo[1], lo[2], lo[3], hi[0], hi[1], hi[2], hi[3]}; }

template <int NS, int KSTR, bool ALIBI>
__device__ __forceinline__ void tile(const ATT_LAS char* Kb, const ATT_LAS char* Vb, const bf16x8 (&qf)[NS], f32x16 (&o)[2], float& m, float& l, ATT_LAS float* scr, float c0, float slope2, float dq, int lane) {
    const int r32 = lane & 31, h = lane >> 5;
    f32x16 p0, p1;
#pragma unroll
    for (int i = 0; i < 16; ++i) { p0[i] = 0.f; p1[i] = 0.f; }
    const ATT_LAS char* ka = Kb + r32 * KSTR + h * 16;
#pragma unroll
    for (int s2 = 0; s2 < NS; ++s2) {
        const bf16x8 a0 = *(const ATT_LAS bf16x8*)(ka + s2 * 32), a1 = *(const ATT_LAS bf16x8*)(ka + 32 * KSTR + s2 * 32);
        p0 = __builtin_amdgcn_mfma_f32_32x32x16_bf16(a0, qf[s2], p0, 0, 0, 0);
        p1 = __builtin_amdgcn_mfma_f32_32x32x16_bf16(a1, qf[s2], p1, 0, 0, 0);
    }
    float mx = -INFINITY;
    if (ALIBI) {
#pragma unroll
        for (int i = 0; i < 16; ++i) { const float kr = (float)((i & 3) + 8 * (i >> 2));
            const float v0 = p0[i] * c0 - slope2 * fabsf(dq - kr), v1 = p1[i] * c0 - slope2 * fabsf(dq - 32.f - kr);
            p0[i] = v0; p1[i] = v1; mx = fmaxf(mx, fmaxf(v0, v1)); }
    } else {
#pragma unroll
        for (int i = 0; i < 16; ++i) mx = __builtin_fmaxf(__builtin_fmaxf(mx, p0[i]), p1[i]);
        mx *= c0;
    }
    mx = fmaxf(mx, __shfl_xor(mx, 32));
    if (__any(mx > m + 8.f)) {
        const float mn = fmaxf(m, mx), alpha = __builtin_amdgcn_exp2f(m - mn); m = mn; l *= alpha;
        if (h == 0) scr[r32] = alpha;
#pragma unroll
        for (int g = 0; g < 4; ++g) { const f32x4 a4 = *(const ATT_LAS f32x4*)(scr + 8 * g + 4 * h);
#pragma unroll
            for (int j = 0; j < 4; ++j) { o[0][4 * g + j] *= a4[j]; o[1][4 * g + j] *= a4[j]; } }
    }
    float ps = 0.f;
    if (ALIBI) {
#pragma unroll
        for (int i = 0; i < 16; ++i) { p0[i] = __builtin_amdgcn_exp2f(p0[i] - m); p1[i] = __builtin_amdgcn_exp2f(p1[i] - m); ps += p0[i] + p1[i]; }
    } else {
        const float nm = -m;
#pragma unroll
        for (int i = 0; i < 16; ++i) { p0[i] = __builtin_amdgcn_exp2f(__builtin_fmaf(p0[i], c0, nm)); p1[i] = __builtin_amdgcn_exp2f(__builtin_fmaf(p1[i], c0, nm)); ps += p0[i] + p1[i]; }
    }
    l += ps;
    const int i16 = lane & 15, g1 = (lane >> 4) & 1;
    const ATT_LAS char* vb = Vb + (4 * h + (i16 >> 2)) * 64 + (16 * g1 + 4 * (i16 & 3)) * 2;
    {   const bf16x8 A = ATT_PACK8(p0, 0);
        o[0] = __builtin_amdgcn_mfma_f32_32x32x16_bf16(A, vfrag(vb + 0 * 64), o[0], 0, 0, 0);
        o[1] = __builtin_amdgcn_mfma_f32_32x32x16_bf16(A, vfrag(vb + 4096 + 0 * 64), o[1], 0, 0, 0); }
    {   const bf16x8 A = ATT_PACK8(p0, 8);
        o[0] = __builtin_amdgcn_mfma_f32_32x32x16_bf16(A, vfrag(vb + 16 * 64), o[0], 0, 0, 0);
        o[1] = __builtin_amdgcn_mfma_f32_32x32x16_bf16(A, vfrag(vb + 4096 + 16 * 64), o[1], 0, 0, 0); }
    {   const bf16x8 A = ATT_PACK8(p1, 0);
        o[0] = __builtin_amdgcn_mfma_f32_32x32x16_bf16(A, vfrag(vb + 32 * 64), o[0], 0, 0, 0);
        o[1] = __builtin_amdgcn_mfma_f32_32x32x16_bf16(A, vfrag(vb + 4096 + 32 * 64), o[1], 0, 0, 0); }
    {   const bf16x8 A = ATT_PACK8(p1, 8);
        o[0] = __builtin_amdgcn_mfma_f32_32x32x16_bf16(A, vfrag(vb + 48 * 64), o[0], 0, 0, 0);
        o[1] = __builtin_amdgcn_mfma_f32_32x32x16_bf16(A, vfrag(vb + 4096 + 48 * 64), o[1], 0, 0, 0); }
}
__device__ __forceinline__ void finish(f32x16 (&o)[2], float l, ATT_LAS float* scr, ATT_LAS bf16_t* stg, bf16_t* O, int tok0, int lane) {
    const int r32 = lane & 31, h = lane >> 5;
    const float lt = l + __shfl_xor(l, 32);
    if (h == 0) scr[r32] = 1.f / lt;
#pragma unroll
    for (int g = 0; g < 4; ++g) { const f32x4 a4 = *(const ATT_LAS f32x4*)(scr + 8 * g + 4 * h);
#pragma unroll
        for (int j = 0; j < 4; ++j) { const int q = 8 * g + 4 * h + j;
            stg[q * 64 + r32] = f2bf(o[0][4 * g + j] * a4[j]); stg[q * 64 + 32 + r32] = f2bf(o[1][4 * g + j] * a4[j]); } }
#pragma unroll
    for (int it = 0; it < 4; ++it) { const int row = it * 8 + (lane >> 3), ch = lane & 7;
        const u32x4 v = *(const ATT_LAS u32x4*)(stg + row * 64 + ch * 8);
        *(u32x4*)(O + (size_t)(tok0 + row) * 1024 + ch * 8) = v; }
}

__device__ __forceinline__ void mla_unit(ATT_LAS char* sm, const bf16_t* QM, const bf16_t* KVM, const bf16_t* KROPE, const float* ropecs, bf16_t* YMIX, int b, int hd, int qb) {
    const int tid = threadIdx.x, lane = tid & 63, wave = __builtin_amdgcn_readfirstlane(tid >> 6), r32 = lane & 31, h = lane >> 5;
    const int q0 = 256 * qb, NT = 4 * qb + 4, cw = 4 * qb + (wave >> 1);
    const int tokw = b * SEQ + q0 + 32 * wave;
    ATT_LAS float* scr = (ATT_LAS float*)(sm + L_SCR + wave * 256);
    const size_t kvoff = (size_t)(b * SEQ + (tid >> 3)) * 1024 + hd * 128 + (tid & 7) * 8;
    const size_t kroff = (size_t)(b * SEQ + (tid >> 2)) * 32 + (tid & 3) * 8;
    const int kdst = (tid >> 3) * 208 + (tid & 7) * 16, krdst = (tid >> 2) * 208 + 128 + (tid & 3) * 16, vdst = ((tid & 7) >> 2) * 4096 + (tid >> 3) * 64 + (tid & 3) * 16;
    u32x4 knA, krA = (u32x4){0u, 0u, 0u, 0u}, vvA, knB, krB = (u32x4){0u, 0u, 0u, 0u}, vvB;
#define MLA_GLOAD(t, S) do { kn##S = *(const u32x4*)(KVM + kvoff + (size_t)(t) * 64 * 1024); vv##S = *(const u32x4*)(KVM + kvoff + (size_t)(t) * 64 * 1024 + 64); \
        if (tid < 256) kr##S = *(const u32x4*)(KROPE + kroff + (size_t)(t) * 64 * 32); } while (0)
#define MLA_LWRITE(bufi, S) do { *(ATT_LAS u32x4*)(sm + L_K0 + (bufi) * KBUF + kdst) = kn##S; if (tid < 256) *(ATT_LAS u32x4*)(sm + L_K0 + (bufi) * KBUF + krdst) = kr##S; \
        *(ATT_LAS u32x4*)(sm + L_V0 + (bufi) * VBUF + vdst) = vv##S; } while (0)
    MLA_GLOAD(0, A); MLA_GLOAD(1, B);
    bf16x8 qf[6];
    const bf16_t* qp = QM + (size_t)(tokw + r32) * 768 + hd * 96 + 8 * h;
#pragma unroll
    for (int s2 = 0; s2 < 6; ++s2) qf[s2] = *(const bf16x8*)(qp + 16 * s2);
    {   const float* cs = ropecs + (size_t)(tokw + r32) * 32 + 8 * h;
        const f32x4 c0 = *(const f32x4*)cs, c1 = *(const f32x4*)(cs + 4), s0 = *(const f32x4*)(cs + 16), s1 = *(const f32x4*)(cs + 20);
        float t1[8], t2[8];
#pragma unroll
        for (int j = 0; j < 8; ++j) { t1[j] = bf2f((bf16_t)qf[4][j]); t2[j] = bf2f((bf16_t)qf[5][j]); }
#pragma unroll
        for (int j = 0; j < 8; ++j) { const float c = j < 4 ? c0[j & 3] : c1[j & 3], sn = j < 4 ? s0[j & 3] : s1[j & 3];
            qf[4][j] = (short)f2bf(t1[j] * c - t2[j] * sn); qf[5][j] = (short)f2bf(t2[j] * c + t1[j] * sn); } }
    f32x16 o[2];
#pragma unroll
    for (int i = 0; i < 16; ++i) { o[0][i] = 0.f; o[1][i] = 0.f; }
    float m = -1e30f, l = 0.f;
    MLA_LWRITE(0, A);
    __syncthreads();
    for (int t = 0; t < NT; t += 2) {
        if (t + 2 < NT) MLA_GLOAD(t + 2, A);
        if (t <= cw) tile<6, 208, false>(sm + L_K0, sm + L_V0, qf, o, m, l, scr, 0.10206207261596577f * LOG2E, 0.f, 0.f, lane);
        MLA_LWRITE(1, B);
        __syncthreads();
        if (t + 3 < NT) MLA_GLOAD(t + 3, B);
        if (t + 1 <= cw) tile<6, 208, false>(sm + L_K0 + KBUF, sm + L_V0 + VBUF, qf, o, m, l, scr, 0.10206207261596577f * LOG2E, 0.f, 0.f, lane);
        if (t + 2 < NT) MLA_LWRITE(0, A);
        __syncthreads();
    }
    finish(o, l, scr, (ATT_LAS bf16_t*)(sm + L_OST + wave * 4096), YMIX + 512 + hd * 64, tokw, lane);
#undef MLA_GLOAD
#undef MLA_LWRITE
}
__device__ __forceinline__ void swa_unit(ATT_LAS char* sm, const bf16_t* PROJ0, const float* sinks, bf16_t* YMIX, int b, int n, int hk) {
    const int tid = threadIdx.x, lane = tid & 63, wave = __builtin_amdgcn_readfirstlane(tid >> 6), r32 = lane & 31, h = lane >> 5;
    const int head = hk * 4 + (wave >> 1), qi0 = 32 * (wave & 1), tokw = b * SEQ + 64 * n + qi0;
    ATT_LAS float* scr = (ATT_LAS float*)(sm + L_SCR + wave * 256);
    const int t_lo = n >= 2 ? 0 : 2 - n;
    const size_t koff = (size_t)(b * SEQ + (tid >> 3)) * EVEN_INP + P0_KA + hk * 64 + (tid & 7) * 8;
    const int kdst = (tid >> 3) * 144 + (tid & 7) * 16, vdst = ((tid & 7) >> 2) * 4096 + (tid >> 3) * 64 + (tid & 3) * 16;
    u32x4 kn[3], vv[3];
#pragma unroll
    for (int t = 0; t < 3; ++t) if (t >= t_lo) { const size_t o_ = koff + (size_t)(n - 2 + t) * 64 * EVEN_INP; kn[t] = *(const u32x4*)(PROJ0 + o_); vv[t] = *(const u32x4*)(PROJ0 + o_ + (P0_VA - P0_KA)); }
    bf16x8 qf[4];
    const bf16_t* qp = PROJ0 + (size_t)(tokw + r32) * EVEN_INP + P0_QA + head * 64 + 8 * h;
#pragma unroll
    for (int s2 = 0; s2 < 4; ++s2) qf[s2] = *(const bf16x8*)(qp + 16 * s2);
    f32x16 o[2];
#pragma unroll
    for (int i = 0; i < 16; ++i) { o[0][i] = 0.f; o[1][i] = 0.f; }
    float m = sinks[head] * LOG2E, l = h == 0 ? 1.f : 0.f;
    const float slope2 = exp2f(-(float)(head + 1)) * LOG2E;
    __syncthreads();
#pragma unroll
    for (int t = 0; t < 3; ++t) if (t >= t_lo) { *(ATT_LAS u32x4*)(sm + SWA_K0 + t * SWA_KBUF + kdst) = kn[t]; *(ATT_LAS u32x4*)(sm + SWA_V0 + t * VBUF + vdst) = vv[t]; }
    __syncthreads();
    for (int t = t_lo; t < 3; ++t)
        tile<4, 144, true>(sm + SWA_K0 + t * SWA_KBUF, sm + SWA_V0 + t * VBUF, qf, o, m, l, scr, 0.125f * LOG2E, slope2, (float)(qi0 + r32 + 128 - 64 * t - 4 * h), lane);
    finish(o, l, scr, (ATT_LAS bf16_t*)(sm + L_OST + wave * 4096), YMIX + head * 64, tokw, lane);
}
}


namespace ret {
using att::f32x16; using att::f32x4; using att::bf16x8; using att::s16x4; using att::u32x4; using att::trread; using att::cvtpk; using att::vfrag;
__device__ __forceinline__ bf16x8 nfrag(const ATT_LAS char* p) { const s16x4 lo = trread(p), hi = trread(p + 4 * 64); return (bf16x8){lo[0], lo[1], lo[2], lo[3], hi[0], hi[1], hi[2], hi[3]}; }
__device__ __forceinline__ float log2g(int hh) { return log2f(1.f - exp2f(-5.f - (float)hh)); }

__device__ __forceinline__ void ret1_unit(ATT_LAS char* sm, const bf16_t* PROJ1, bf16_t* RKV, int u) {
    const int tid = threadIdx.x, lane = tid & 63, wave = __builtin_amdgcn_readfirstlane(tid >> 6), r32 = lane & 31, h = lane >> 5, i16 = lane & 15, g1 = (lane >> 4) & 1;
    const int b = u >> 7, hh = (u >> 5) & 3, n = u & 31;
    const float lg = log2g(hh);
    __syncthreads();
#pragma unroll
    for (int k = 0; k < 2; ++k) {
        const int c = tid + 512 * k, t = c >> 4, ch = c & 15;
        const bf16_t* src = PROJ1 + (size_t)(b * SEQ + 64 * n + t) * ODD_IN + hh * 128 + ch * 8;
        const u32x4 kv = *(const u32x4*)(src + P1_K), vv = *(const u32x4*)(src + P1_V);
        const float fac = 0.08838834764831845f * exp2f(lg * (float)(63 - t));
        u32x4 ks;
#pragma unroll
        for (int j = 0; j < 4; ++j) { const unsigned w = kv[j]; ks[j] = cvtpk(__uint_as_float(w << 16) * fac, __uint_as_float(w & 0xffff0000u) * fac); }
        const int dst = (ch >> 2) * 4096 + t * 64 + (ch & 3) * 16;
        *(ATT_LAS u32x4*)(sm + dst) = ks; *(ATT_LAS u32x4*)(sm + 16384 + dst) = vv;
    }
    __syncthreads();
    const int dkb = wave >> 1, dvb = 2 * (wave & 1);
    f32x16 acc[2];
#pragma unroll
    for (int i = 0; i < 16; ++i) { acc[0][i] = 0.f; acc[1][i] = 0.f; }
    const int fo = (8 * h + (i16 >> 2)) * 64 + (16 * g1 + 4 * (i16 & 3)) * 2;
#pragma unroll
    for (int s2 = 0; s2 < 4; ++s2) {
        const bf16x8 A = nfrag(sm + dkb * 4096 + s2 * 16 * 64 + fo);
        acc[0] = __builtin_amdgcn_mfma_f32_32x32x16_bf16(A, nfrag(sm + 16384 + dvb * 4096 + s2 * 16 * 64 + fo), acc[0], 0, 0, 0);
        acc[1] = __builtin_amdgcn_mfma_f32_32x32x16_bf16(A, nfrag(sm + 16384 + (dvb + 1) * 4096 + s2 * 16 * 64 + fo), acc[1], 0, 0, 0);
    }
    bf16_t* dst = RKV + (size_t)u * 16384 + 32 * dvb + r32;
#pragma unroll
    for (int i = 0; i < 16; ++i) { const int dk = 32 * dkb + (i & 3) + 8 * (i >> 2) + 4 * h; dst[dk * 128] = f2bf(acc[0][i]); dst[dk * 128 + 32] = f2bf(acc[1][i]); }
}
__device__ __forceinline__ void ret2_elems(bf16_t* RKV, int gt, int NGT) {
    for (int e = gt; e < BATCH * 4 * 4096; e += NGT) {
        const int bh = e >> 12, el = (e & 4095) * 4;
        const float cd = exp2f(64.f * log2g(bh & 3));
        float st[4] = {0.f, 0.f, 0.f, 0.f};
        unsigned long long* p = (unsigned long long*)(RKV + (size_t)bh * 32 * 16384 + el);
#pragma unroll 8
        for (int n = 0; n < 32; ++n) {
            const unsigned long long x = p[(size_t)n * 4096];
            p[(size_t)n * 4096] = (unsigned long long)cvtpk(st[0], st[1]) | ((unsigned long long)cvtpk(st[2], st[3]) << 32);
            st[0] = cd * st[0] + __uint_as_float((unsigned)x << 16); st[1] = cd * st[1] + __uint_as_float((unsigned)x & 0xffff0000u);
            st[2] = cd * st[2] + __uint_as_float((unsigned)(x >> 32) << 16); st[3] = cd * st[3] + __uint_as_float((unsigned)(x >> 32) & 0xffff0000u);
        }
    }
}
constexpr int R3_Q = 0, R3_K = 17408, R3_V = 34816, R3_R = 51200, R3_O = 83968, R3_END = R3_O + 64 * 132 * 4;
__device__ __forceinline__ void ret3_unit(ATT_LAS char* sm, const bf16_t* PROJ1, const bf16_t* RKV, const float* gn, bf16_t* YMIX, int u) {
    const int tid = threadIdx.x, lane = tid & 63, wave = __builtin_amdgcn_readfirstlane(tid >> 6), r32 = lane & 31, h = lane >> 5, i16 = lane & 15, g1 = (lane >> 4) & 1;
    const int b = u >> 7, hh = (u >> 5) & 3, n = u & 31, tok0 = b * SEQ + 64 * n;
    const float lg = log2g(hh);
    __syncthreads();
#pragma unroll
    for (int k = 0; k < 2; ++k) {
        const int c = tid + 512 * k, t = c >> 4, ch = c & 15;
        const bf16_t* src = PROJ1 + (size_t)(tok0 + t) * ODD_IN + hh * 128 + ch * 8;
        *(ATT_LAS u32x4*)(sm + R3_Q + t * 272 + ch * 16) = *(const u32x4*)(src + P1_Q);
        *(ATT_LAS u32x4*)(sm + R3_K + t * 272 + ch * 16) = *(const u32x4*)(src + P1_K);
        *(ATT_LAS u32x4*)(sm + R3_V + (ch >> 2) * 4096 + t * 64 + (ch & 3) * 16) = *(const u32x4*)(src + P1_V);
    }
#pragma unroll
    for (int k = 0; k < 4; ++k) {
        const int c = tid + 512 * k, d = c >> 4, ch = c & 15;
        *(ATT_LAS u32x4*)(sm + R3_R + (ch >> 2) * 8192 + d * 64 + (ch & 3) * 16) = *(const u32x4*)(RKV + (size_t)u * 16384 + d * 128 + ch * 8);
    }
    __syncthreads();
    const int qb = wave >> 2, dvb = wave & 3;
    bf16x8 qf[8];
#pragma unroll
    for (int s2 = 0; s2 < 8; ++s2) qf[s2] = *(const ATT_LAS bf16x8*)(sm + R3_Q + (32 * qb + r32) * 272 + s2 * 32 + h * 16);
    f32x16 acc, accx;
#pragma unroll
    for (int i = 0; i < 16; ++i) { acc[i] = 0.f; accx[i] = 0.f; }
    const int fv = (4 * h + (i16 >> 2)) * 64 + (16 * g1 + 4 * (i16 & 3)) * 2;
    for (int kb = 0; kb <= qb; ++kb) {
        f32x16 p;
#pragma unroll
        for (int i = 0; i < 16; ++i) p[i] = 0.f;
#pragma unroll
        for (int s2 = 0; s2 < 8; ++s2) { const bf16x8 a = *(const ATT_LAS bf16x8*)(sm + R3_K + (32 * kb + r32) * 272 + s2 * 32 + h * 16); p = __builtin_amdgcn_mfma_f32_32x32x16_bf16(a, qf[s2], p, 0, 0, 0); }
        const int q = 32 * qb + r32;
#pragma unroll
        for (int i = 0; i < 16; ++i) { const int key = 32 * kb + (i & 3) + 8 * (i >> 2) + 4 * h, df = q - key; p[i] = df >= 0 ? p[i] * 0.08838834764831845f * exp2f(lg * (float)df) : 0.f; }
        { const bf16x8 A = ATT_PACK8(p, 0); acc = __builtin_amdgcn_mfma_f32_32x32x16_bf16(A, vfrag(sm + R3_V + dvb * 4096 + (32 * kb) * 64 + fv), acc, 0, 0, 0); }
        { const bf16x8 A = ATT_PACK8(p, 8); acc = __builtin_amdgcn_mfma_f32_32x32x16_bf16(A, vfrag(sm + R3_V + dvb * 4096 + (32 * kb + 16) * 64 + fv), acc, 0, 0, 0); }
    }
    const int fn = (8 * h + (i16 >> 2)) * 64 + (16 * g1 + 4 * (i16 & 3)) * 2;
#pragma unroll
    for (int s2 = 0; s2 < 8; ++s2) accx = __builtin_amdgcn_mfma_f32_32x32x16_bf16(qf[s2], nfrag(sm + R3_R + dvb * 8192 + s2 * 16 * 64 + fn), accx, 0, 0, 0);
    ATT_LAS float* Os = (ATT_LAS float*)(sm + R3_O);
#pragma unroll
    for (int i = 0; i < 16; ++i) { const int q = 32 * qb + (i & 3) + 8 * (i >> 2) + 4 * h; Os[q * 132 + 32 * dvb + r32] = acc[i] + accx[i] * exp2f(lg * (float)(q + 1)); }
    __syncthreads();
#pragma unroll
    for (int k = 0; k < 8; ++k) {
        const int q = 8 * wave + k, tkn = tok0 + q;
        const float a = Os[q * 132 + lane], c = Os[q * 132 + 64 + lane];
        const float mu = wave_sum(a + c) * (1.f / 128.f), da = a - mu, dc = c - mu;
        const float rs = rsqrtf(wave_sum(da * da + dc * dc) * (1.f / 128.f) + EPS);
        const bf16_t* gp = PROJ1 + (size_t)tkn * ODD_IN + P1_G + hh * 128;
        YMIX[(size_t)tkn * D + hh * 128 + lane] = f2bf(silu(bf2f(gp[lane])) * da * rs * gn[hh * 128 + lane]);
        YMIX[(size_t)tkn * D + hh * 128 + 64 + lane] = f2bf(silu(bf2f(gp[64 + lane])) * dc * rs * gn[hh * 128 + 64 + lane]);
    }
}
}

#define LAS __attribute__((address_space(3)))
#define GAS __attribute__((address_space(1)))
typedef unsigned v4u __attribute__((ext_vector_type(4)));
#define LDS_WAIT() asm volatile("s_waitcnt lgkmcnt(0)" ::: "memory")
__device__ __forceinline__ unsigned pk2(float lo, float hi) { return (unsigned)f2bf(lo) | ((unsigned)f2bf(hi) << 16); }
constexpr int NWAVES = 8, LDS_BYTES = 147456, RING_BYTES = 131072, MISC_OFF = RING_BYTES + 320, ROWTAB_OFF = RING_BYTES + 1024;
constexpr int CW_BAR = 4096;

#define XB_TMO      128
#define XB_XCNT(j)  (256  + 64 * (j))
#define XB_XSUB(j)  (1280 + 64 * (j))
#define XB_XGEN(j)  (2304 + 64 * (j))
#define XB_TOP      3328
#define XB_TOPGEN   3392
#define XCD_BAR_WORDS 3456
#define XB_SPIN_CAP (1u << 18)
__device__ __forceinline__ unsigned xb_ld(unsigned* p)              { return __hip_atomic_load(p, __ATOMIC_RELAXED, __HIP_MEMORY_SCOPE_AGENT); }
__device__ __forceinline__ unsigned xb_add(unsigned* p, unsigned v) { return __hip_atomic_fetch_add(p, v, __ATOMIC_RELAXED, __HIP_MEMORY_SCOPE_AGENT); }
__device__ __forceinline__ unsigned xb_xcc_id() { return (unsigned)__builtin_amdgcn_s_getreg((3 << 11) | 20) & 0xFu; }
#define XB_SPIN(cond, bar) do { unsigned _sp = 0; while (cond) { __builtin_amdgcn_s_sleep(1); \
    if ((++_sp & 255u) == 0u) { if (xb_ld(&(bar)[XB_TMO])) break; if (_sp > XB_SPIN_CAP) { atomicAdd(&(bar)[XB_TMO], 1u); break; } } } } while (0)
struct XcdBarrier {
    unsigned* bar; unsigned x;
    volatile LAS unsigned* st;
};
__device__ __forceinline__ XcdBarrier xcd_barrier_post(unsigned* bar, volatile LAS unsigned* st) {
    XcdBarrier b; b.bar = bar; b.x = xb_xcc_id(); b.st = st;
    if (threadIdx.x == 0) (void)xb_add(&bar[XB_XCNT(b.x)], 1u);
    return b;
}
__device__ __forceinline__ void xcd_barrier_complete(unsigned* bar, unsigned x, unsigned& nloc, unsigned& nx) {
    const unsigned G = gridDim.x * gridDim.y * gridDim.z;
    unsigned sum, cnt, mine, sp = 0u;
    for (;;) {
        sum = 0u; cnt = 0u; mine = 0u;
#pragma unroll
        for (unsigned j = 0; j < 16; ++j) { const unsigned c = xb_ld(&bar[XB_XCNT(j)]); sum += c; cnt += (c > 0u) ? 1u : 0u; mine = (j == x) ? c : mine; }
        if (sum == G) break;
        __builtin_amdgcn_s_sleep(1);
        if ((++sp & 255u) == 0u) { if (xb_ld(&bar[XB_TMO])) break; if (sp > XB_SPIN_CAP) { atomicAdd(&bar[XB_TMO], 1u); break; } }
    }
    nloc = mine > 0u ? mine : 1u; nx = cnt > 0u ? cnt : 1u;
}
__device__ __forceinline__ void xcd_barrier(const XcdBarrier& b) {
    asm volatile("s_waitcnt vmcnt(0)" ::: "memory");
    __syncthreads();
    if (threadIdx.x == 0) {
        unsigned* bar = b.bar;
        __builtin_amdgcn_s_waitcnt(0);
        unsigned nloc = b.st[0], nx = b.st[1];
        if (nloc == 0u) { xcd_barrier_complete(bar, b.x, nloc, nx); b.st[0] = nloc; b.st[1] = nx; }
        const unsigned old = xb_add(&bar[XB_XSUB(b.x)], 1u);
        const unsigned gen = old / nloc;
        if (old + 1u == (gen + 1u) * nloc) {
            __builtin_amdgcn_fence(__ATOMIC_RELEASE, "agent");
            asm volatile("s_waitcnt vmcnt(0)" ::: "memory");
            const unsigned og = xb_add(&bar[XB_TOP], 1u);
            const unsigned tg = og / nx;
            if (og + 1u == (tg + 1u) * nx) xb_add(&bar[XB_TOPGEN], 1u);
            else XB_SPIN(xb_ld(&bar[XB_TOPGEN]) == tg, bar);
            __builtin_amdgcn_fence(__ATOMIC_ACQUIRE, "agent");
            xb_add(&bar[XB_XGEN(b.x)], 1u);
            asm volatile("s_waitcnt vmcnt(0)" ::: "memory");
        } else {
            XB_SPIN(xb_ld(&bar[XB_XGEN(b.x)]) == gen, bar);
            __builtin_amdgcn_fence(__ATOMIC_ACQUIRE, "agent");
            asm volatile("s_waitcnt vmcnt(0)" ::: "memory");
        }
    }
    __syncthreads();
}

template <class RM>
__device__ __forceinline__ void p0_item(const float* W, int K, int N, bf16_t* WT, RM rm, LAS float* scr, int item, int lane, float mul = 1.f) {
    const int nblk = N / 32, kb = item / nblk, nb = item % nblk, k0 = 64 * kb, n0 = 32 * nb;
#pragma unroll
    for (int i = 0; i < 32; ++i) { const int kk = 2 * i + (lane >> 5); scr[kk * 33 + (lane & 31)] = W[(size_t)(k0 + kk) * N + n0 + (lane & 31)] * mul; }
    LDS_WAIT(); asm volatile("" ::: "memory");
    const int c = lane & 7;
#pragma unroll
    for (int j = 0; j < 4; ++j) { const int n = (lane >> 3) + 8 * j; const LAS float* sp = scr + (8 * c) * 33 + n;
        v4u o; o.x = pk2(sp[0 * 33], sp[1 * 33]); o.y = pk2(sp[2 * 33], sp[3 * 33]); o.z = pk2(sp[4 * 33], sp[5 * 33]); o.w = pk2(sp[6 * 33], sp[7 * 33]);
        *(v4u*)(WT + (size_t)rm(n0 + n) * K + k0 + 8 * c) = o; }
    LDS_WAIT(); asm volatile("" ::: "memory");
}
template <class RM>
__device__ __forceinline__ void p0_item8(const float* W, int K, int N, unsigned char* WT, RM rm, float scale, LAS float* scr, int item, int lane) {
    const int nblk = N / 32, kb = item / nblk, nb = item % nblk, k0 = 64 * kb, n0 = 32 * nb;
#pragma unroll
    for (int i = 0; i < 32; ++i) { const int kk = 2 * i + (lane >> 5); scr[kk * 33 + (lane & 31)] = W[(size_t)(k0 + kk) * N + n0 + (lane & 31)] * scale; }
    LDS_WAIT(); asm volatile("" ::: "memory");
    const int c = lane & 3;
#pragma unroll
    for (int j = 0; j < 2; ++j) { const int n = (lane >> 2) + 16 * j; const LAS float* sp = scr + (16 * c) * 33 + n;
        v4u o; o.x = pg8::pk4_fp8(sp[0 * 33], sp[1 * 33], sp[2 * 33], sp[3 * 33]); o.y = pg8::pk4_fp8(sp[4 * 33], sp[5 * 33], sp[6 * 33], sp[7 * 33]);
        o.z = pg8::pk4_fp8(sp[8 * 33], sp[9 * 33], sp[10 * 33], sp[11 * 33]); o.w = pg8::pk4_fp8(sp[12 * 33], sp[13 * 33], sp[14 * 33], sp[15 * 33]);
        *(v4u*)(WT + (size_t)rm(n0 + n) * K + k0 + 16 * c) = o; }
    LDS_WAIT(); asm volatile("" ::: "memory");
}
__device__ __forceinline__ void norm_rows(const float* x, const float* g, bf16_t* o, int gw, int NGW, int lane) {
    typedef float f32x4 __attribute__((ext_vector_type(4)));
    f32x4 gv[4];
#pragma unroll
    for (int j = 0; j < 4; ++j) gv[j] = *((const f32x4*)g + lane + 64 * j);
    for (int m = gw; m < T; m += NGW) {
        const f32x4* xr = (const f32x4*)(x + (size_t)m * D) + lane;
        f32x4 v[4]; float s = 0.f;
#pragma unroll
        for (int j = 0; j < 4; ++j) { v[j] = xr[64 * j]; s += (v[j].x * v[j].x + v[j].y * v[j].y) + (v[j].z * v[j].z + v[j].w * v[j].w); }
        const float rs = rsqrtf(wave_sum(s) * (1.f / D) + EPS);
        unsigned long long* o8 = (unsigned long long*)(o + (size_t)m * D) + lane;
#pragma unroll
        for (int j = 0; j < 4; ++j) o8[64 * j] = (unsigned long long)pk2(v[j].x * rs * gv[j].x, v[j].y * rs * gv[j].y) | ((unsigned long long)pk2(v[j].z * rs * gv[j].z, v[j].w * rs * gv[j].w) << 32);
    }
}
__device__ __forceinline__ void mla_prep_rows(const bf16_t* proj0, const float* qg, const float* kvg, const int* pos, bf16_t* cqn, bf16_t* ckvn, bf16_t* krope, float* ropecs, int gw, int NGW, int lane) {
    for (int tkn = gw; tkn < T; tkn += NGW) {
        const bf16_t* pr = proj0 + (size_t)tkn * EVEN_INP;
        float q[6], s = 0.f;
#pragma unroll
        for (int j = 0; j < 6; ++j) { q[j] = bf2f(pr[P0_CQ + lane + 64 * j]); s += q[j] * q[j]; }
        float rs = rsqrtf(wave_sum(s) * (1.f / 384.f) + EPS);
#pragma unroll
        for (int j = 0; j < 6; ++j) cqn[(size_t)tkn * 384 + lane + 64 * j] = f2bf(q[j] * rs * qg[lane + 64 * j]);
        float c[4]; s = 0.f;
#pragma unroll
        for (int j = 0; j < 4; ++j) { c[j] = bf2f(pr[P0_CKV + lane + 64 * j]); s += c[j] * c[j]; }
        rs = rsqrtf(wave_sum(s) * (1.f / 256.f) + EPS);
#pragma unroll
        for (int j = 0; j < 4; ++j) ckvn[(size_t)tkn * 256 + lane + 64 * j] = f2bf(c[j] * rs * kvg[lane + 64 * j]);
        if (lane < 16) {
            const float p = (float)pos[tkn];
            const float inv = powf(10000.f, -(float)(2 * lane) / 32.f);
            const float ang = p * inv, cs = cosf(ang), sn = sinf(ang);
            const float t1 = bf2f(pr[P0_KR + lane]), t2 = bf2f(pr[P0_KR + 16 + lane]);
            krope[(size_t)tkn * 32 + lane] = f2bf(t1 * cs - t2 * sn);
            krope[(size_t)tkn * 32 + 16 + lane] = f2bf(t2 * cs + t1 * sn);
            ropecs[(size_t)tkn * 32 + lane] = cs; ropecs[(size_t)tkn * 32 + 16 + lane] = sn;
        }
    }
}
__device__ __forceinline__ void swa_naive(const bf16_t* proj0, const float* sinks, bf16_t* ymix, int gt, int NGT) {
    for (int idx = gt; idx < T * 8; idx += NGT) {
        const int tkn = idx >> 3, h = idx & 7, hk = h >> 2;
        const int b = tkn / SEQ, sq = tkn % SEQ, n = sq / CHUNK, qi = sq % CHUNK;
        const float slope = exp2f(-(float)(h + 1));
        float q[64], o[64];
#pragma unroll
        for (int d = 0; d < 64; ++d) { q[d] = bf2f(proj0[(size_t)tkn * EVEN_INP + P0_QA + h * 64 + d]); o[d] = 0.f; }
        float m = sinks[h], l = 1.f;
        const int k_lo = (n - 2) * CHUNK, k_hi = (n + 1) * CHUNK;
        for (int kp = (k_lo < 0 ? 0 : k_lo); kp < k_hi; ++kp) {
            const bf16_t* kr = proj0 + (size_t)(b * SEQ + kp) * EVEN_INP + P0_KA + hk * 64;
            float sc = 0.f;
#pragma unroll
            for (int d = 0; d < 64; ++d) sc += q[d] * bf2f(kr[d]);
            const float dist = fabsf((float)(qi + 2 * CHUNK - (kp - k_lo)));
            sc = sc * 0.125f - slope * dist;
            const float mn = fmaxf(m, sc), f = __expf(m - mn), pz = __expf(sc - mn);
            l = l * f + pz; m = mn;
            const bf16_t* vr = kr + (P0_VA - P0_KA);
#pragma unroll
            for (int d = 0; d < 64; ++d) o[d] = o[d] * f + pz * bf2f(vr[d]);
        }
        const float il = 1.f / l;
#pragma unroll
        for (int d = 0; d < 64; ++d) ymix[(size_t)tkn * D + h * 64 + d] = f2bf(o[d] * il);
    }
}
__device__ __forceinline__ void mla_naive(const bf16_t* qm, const bf16_t* kvm, const bf16_t* krope, const int* pos, bf16_t* ymix, int gt, int NGT) {
    for (int idx = gt; idx < T * 8; idx += NGT) {
        const int tkn = idx >> 3, h = idx & 7;
        const int b = tkn / SEQ, sq = tkn % SEQ, c = sq / CHUNK;
        float q[96], o[64];
#pragma unroll
        for (int d = 0; d < 96; ++d) q[d] = bf2f(qm[(size_t)tkn * 768 + h * 96 + d]);
        { const float p = (float)pos[tkn];
#pragma unroll
          for (int i = 0; i < 16; ++i) { const float inv = powf(10000.f, -(float)(2 * i) / 32.f), ang = p * inv, cs = cosf(ang), sn = sinf(ang);
              const float t1 = q[64 + i], t2 = q[80 + i]; q[64 + i] = t1 * cs - t2 * sn; q[80 + i] = t2 * cs + t1 * sn; } }
#pragma unroll
        for (int d = 0; d < 64; ++d) o[d] = 0.f;
        float m = -1e30f, l = 0.f;
        const int nk = (c + 1) * CHUNK;
        for (int kp = 0; kp < nk; ++kp) {
            const bf16_t* kr = kvm + (size_t)(b * SEQ + kp) * 1024 + h * 128;
            const bf16_t* rr = krope + (size_t)(b * SEQ + kp) * 32;
            float sc = 0.f;
#pragma unroll
            for (int d = 0; d < 64; ++d) sc += q[d] * bf2f(kr[d]);
#pragma unroll
            for (int d = 0; d < 32; ++d) sc += q[64 + d] * bf2f(rr[d]);
            sc *= 0.10206207261596577f;
            const float mn = fmaxf(m, sc), f = __expf(m - mn), pz = __expf(sc - mn);
            l = l * f + pz; m = mn;
#pragma unroll
            for (int d = 0; d < 64; ++d) o[d] = o[d] * f + pz * bf2f(kr[64 + d]);
        }
        const float il = 1.f / l;
#pragma unroll
        for (int d = 0; d < 64; ++d) ymix[(size_t)tkn * D + 512 + h * 64 + d] = f2bf(o[d] * il);
    }
}
__device__ __forceinline__ void ret_naive(const bf16_t* proj1, float* yr, LAS float* sm, int bx, int G, int tid) {
    for (int bh = bx; bh < BATCH * 4; bh += G) {
        const int b = bh >> 2, h = bh & 3, dv = tid & 127;
        const float g = 1.f - exp2f(-5.f - (float)h);
        float S[128];
#pragma unroll
        for (int d = 0; d < 128; ++d) S[d] = 0.f;
        for (int sq = 0; sq < SEQ; ++sq) {
            const bf16_t* pr = proj1 + (size_t)(b * SEQ + sq) * ODD_IN;
            __syncthreads();
            if (tid < 128) { sm[dv] = bf2f(pr[P1_Q + h * 128 + dv]); sm[128 + dv] = bf2f(pr[P1_K + h * 128 + dv]) * 0.08838834764831845f; }
            __syncthreads();
            if (tid < 128) {
                const float v = bf2f(pr[P1_V + h * 128 + dv]); float o = 0.f;
#pragma unroll
                for (int d = 0; d < 128; ++d) { S[d] = g * S[d] + sm[128 + d] * v; o += sm[d] * S[d]; }
                yr[(size_t)(b * SEQ + sq) * 512 + h * 128 + dv] = o;
            }
        }
    }
}
__device__ __forceinline__ void ret_gn_rows(const float* yr, const bf16_t* proj1, const float* gn, bf16_t* ymix, int gw, int NGW, int lane) {
    for (int w = gw; w < T * 4; w += NGW) {
        const int tkn = w >> 2, h = w & 3;
        const float a = yr[(size_t)tkn * 512 + h * 128 + lane], c = yr[(size_t)tkn * 512 + h * 128 + 64 + lane];
        const float mu = wave_sum(a + c) * (1.f / 128.f);
        const float da = a - mu, dc = c - mu;
        const float rs = rsqrtf(wave_sum(da * da + dc * dc) * (1.f / 128.f) + EPS);
        const float g0 = bf2f(proj1[(size_t)tkn * ODD_IN + P1_G + h * 128 + lane]), g1 = bf2f(proj1[(size_t)tkn * ODD_IN + P1_G + h * 128 + 64 + lane]);
        ymix[(size_t)tkn * D + h * 128 + lane] = f2bf(silu(g0) * da * rs * gn[h * 128 + lane]);
        ymix[(size_t)tkn * D + h * 128 + 64 + lane] = f2bf(silu(g1) * dc * rs * gn[h * 128 + 64 + lane]);
    }
}
__device__ __forceinline__ void conv_elems(const bf16_t* proj1, const float* w, bf16_t* ymix, int gt, int NGT) {
    typedef float f32x4 __attribute__((ext_vector_type(4)));
    for (int i = gt; i < T * 64; i += NGT) {
        const int tkn = i >> 6, c8 = (i & 63) * 8, sq = tkn % SEQ;
        float y[8];
#pragma unroll
        for (int k = 0; k < 8; ++k) y[k] = 0.f;
#pragma unroll
        for (int j = 0; j < 3; ++j) {
            if (sq - 2 + j >= 0) {
                const bf16_t* pr = proj1 + (size_t)(tkn - 2 + j) * ODD_IN + c8;
                const v4u cv = *(const v4u*)(pr + P1_C), hv = *(const v4u*)(pr + P1_H);
                const f32x4 w0 = *(const f32x4*)(w + j * 512 + c8), w1 = *(const f32x4*)(w + j * 512 + c8 + 4);
#pragma unroll
                for (int k = 0; k < 4; ++k) { const float wl = k < 2 ? w0[2 * k] : w1[2 * k - 4], wh = k < 2 ? w0[2 * k + 1] : w1[2 * k - 3];
                    y[2 * k] += wl * __uint_as_float(cv[k] << 16) * __uint_as_float(hv[k] << 16);
                    y[2 * k + 1] += wh * __uint_as_float(cv[k] & 0xffff0000u) * __uint_as_float(hv[k] & 0xffff0000u); }
            }
        }
        const v4u bv = *(const v4u*)(proj1 + (size_t)tkn * ODD_IN + P1_B + c8);
        v4u o;
#pragma unroll
        for (int k = 0; k < 4; ++k) o[k] = pk2(__uint_as_float(bv[k] << 16) * y[2 * k], __uint_as_float(bv[k] & 0xffff0000u) * y[2 * k + 1]);
        *(v4u*)(ymix + (size_t)tkn * D + 512 + c8) = o;
    }
}
__device__ __forceinline__ void route_tokens(const float* x, const float* g, const float* router, unsigned char* xnm8, unsigned* ctl, unsigned char* tab, LAS unsigned* sm, int bx, int G, int tid) {
    typedef float f32x4 __attribute__((ext_vector_type(4)));
    const int wave = tid >> 6, lane = tid & 63;
    LAS unsigned* lcnt = sm; LAS unsigned* lbase = sm + 8; LAS int* se = (LAS int*)(sm + 16); LAS int* ss = (LAS int*)(sm + 16 + 128); LAS float* sg = (LAS float*)(sm + 16 + 256);
    for (int blk = bx; blk < T / 64; blk += G) {
        __syncthreads();
        if (tid < NE) lcnt[tid] = 0u;
        __syncthreads();
        for (int it = 0; it < 8; ++it) {
            const int lt = wave * 8 + it, tkn = blk * 64 + lt;
            const f32x4* xr = (const f32x4*)(x + (size_t)tkn * D) + lane;
            f32x4 v[4]; float s = 0.f;
#pragma unroll
            for (int j = 0; j < 4; ++j) { v[j] = xr[64 * j]; s += (v[j].x * v[j].x + v[j].y * v[j].y) + (v[j].z * v[j].z + v[j].w * v[j].w); }
            const float rs = rsqrtf(wave_sum(s) * (1.f / D) + EPS);
            float lg[NE];
#pragma unroll
            for (int e = 0; e < NE; ++e) lg[e] = 0.f;
#pragma unroll
            for (int j = 0; j < 4; ++j) {
                const f32x4 gv = *((const f32x4*)g + lane + 64 * j);
                const f32x4 hv = v[j] * rs * gv;
                *(unsigned*)(xnm8 + (size_t)tkn * D + 4 * lane + 256 * j) = pg8::pk4_fp8(hv.x * 4.f, hv.y * 4.f, hv.z * 4.f, hv.w * 4.f);
                const f32x4* rr = (const f32x4*)(router + (size_t)(4 * lane + 256 * j) * NE);
#pragma unroll
                for (int q = 0; q < 4; ++q) { const f32x4 r0 = rr[2 * q], r1 = rr[2 * q + 1]; const float hq = hv[q];
                    lg[0] += hq * r0.x; lg[1] += hq * r0.y; lg[2] += hq * r0.z; lg[3] += hq * r0.w; lg[4] += hq * r1.x; lg[5] += hq * r1.y; lg[6] += hq * r1.z; lg[7] += hq * r1.w; }
            }
#pragma unroll
            for (int e = 0; e < NE; ++e) lg[e] = wave_sum(lg[e]);
            int e0 = 0; float v0 = lg[0];
#pragma unroll
            for (int e = 1; e < NE; ++e) if (lg[e] > v0) { v0 = lg[e]; e0 = e; }
            int e1 = -1; float v1 = -INFINITY;
#pragma unroll
            for (int e = 0; e < NE; ++e) if (e != e0 && lg[e] > v1) { v1 = lg[e]; e1 = e; }
            const float p1 = __expf(v1 - v0), g0 = 1.f / (1.f + p1), g1 = p1 / (1.f + p1);
            if (lane == 0) { se[lt * 2] = e0; se[lt * 2 + 1] = e1; sg[lt * 2] = g0; sg[lt * 2 + 1] = g1; ss[lt * 2] = (int)__hip_atomic_fetch_add(&lcnt[e0], 1u, __ATOMIC_RELAXED, __HIP_MEMORY_SCOPE_WORKGROUP); ss[lt * 2 + 1] = (int)__hip_atomic_fetch_add(&lcnt[e1], 1u, __ATOMIC_RELAXED, __HIP_MEMORY_SCOPE_WORKGROUP); }
        }
        __syncthreads();
        if (tid < NE) lbase[tid] = __hip_atomic_fetch_add(&ctl[CW_CNT + 64 * tid], lcnt[tid], __ATOMIC_RELAXED, __HIP_MEMORY_SCOPE_AGENT);
        __syncthreads();
        if (tid < 64) {
            const int lt = tid, tkn = blk * 64 + lt;
            int* ltok = (int*)(tab + TAB_LTOK); float* lgate = (float*)(tab + TAB_LGATE); int* tsel = (int*)(tab + TAB_TSEL);
#pragma unroll
            for (int k = 0; k < 2; ++k) { const int e = se[lt * 2 + k], slot = (int)lbase[e] + ss[lt * 2 + k]; ltok[e * T + slot] = tkn; lgate[e * T + slot] = sg[lt * 2 + k]; tsel[tkn * 4 + 2 * k] = e; tsel[tkn * 4 + 2 * k + 1] = slot; }
        }
    }
}
__device__ __forceinline__ void final_rows(const float* x3, const bf16_t* yp0, const bf16_t* yp1, const unsigned* cnt, const unsigned char* tab, const float* g, float* out, int gw, int NGW, int lane) {
    const int* tsel = (const int*)(tab + TAB_TSEL);
    int tb[NE]; { int t = 0;
#pragma unroll
      for (int e = 0; e < NE; ++e) { tb[e] = t; t += ((int)__hip_atomic_load(cnt + 64 * e, __ATOMIC_RELAXED, __HIP_MEMORY_SCOPE_AGENT) + 255) >> 8; } }
    for (int tkn = gw; tkn < T; tkn += NGW) {
        size_t row[2];
#pragma unroll
        for (int k = 0; k < 2; ++k) { const int e = tsel[tkn * 4 + 2 * k], slot = tsel[tkn * 4 + 2 * k + 1]; int tbe = 0;
#pragma unroll
            for (int i = 0; i < NE; ++i) tbe = (i == e) ? tb[i] : tbe;
            row[k] = (size_t)tbe * 256 + slot; }
        float v[16]; float s = 0.f;
#pragma unroll
        for (int j = 0; j < 16; ++j) { const int c = lane + 64 * j;
            v[j] = x3[(size_t)tkn * D + c] + bf2f(yp0[row[0] * D + c]) + bf2f(yp1[row[0] * D + c]) + bf2f(yp0[row[1] * D + c]) + bf2f(yp1[row[1] * D + c]);
            s += v[j] * v[j]; }
        const float rs = rsqrtf(wave_sum(s) * (1.f / D) + EPS);
#pragma unroll
        for (int j = 0; j < 16; ++j) out[(size_t)tkn * D + lane + 64 * j] = v[j] * rs * g[lane + 64 * j];
    }
}

#ifndef MK_ONE_LAUNCH
#define MK_ONE_LAUNCH 1
#endif
#ifndef PROBE_DUP
#define PROBE_DUP -1
#endif
constexpr int NPHASE = 19;
#ifndef OFF_IPW1
#define OFF_IPW1 10
#endif
#ifndef OFF_IPW2
#define OFF_IPW2 10
#endif
constexpr int OFF_ITEMS = 128 * NWAVES * (OFF_IPW1 + OFF_IPW2);
enum Phase { PH_P0 = 0, PH_G1, PH_MP, PH_G2, PH_ATT, PH_G3, PH_N2, PH_G4, PH_G5, PH_N3, PH_G6, PH_RET1, PH_RET2, PH_RET3, PH_G7, PH_ROUTE, PH_G8, PH_G9, PH_FINAL };
struct Args { const float* in[25]; float* out; unsigned char* ws; int ph_lo, ph_hi; };
static_assert(sizeof(Args) == 25 * 8 + 8 + 8 + 8, "Args has no padding");
enum In { I_X = 0, I_POS, I_ENORM_MIX, I_EW_IN, I_ESINKS, I_EQ_NORM, I_EW_UQ, I_EKV_NORM, I_EW_UKV, I_EW_OUT, I_ENORM_FFN, I_EW_GATE, I_EW_UP, I_EW_DOWN,
          I_ONORM_MIX, I_OW_IN, I_ORET_GN, I_OCONV_W, I_OW_OUT, I_ONORM_FFN, I_OROUTER, I_OWE_GATE, I_OWE_UP, I_OWE_DOWN, I_FINAL_NORM };

__global__ void __launch_bounds__(NWAVES * 64, 2) skel_fwd(Args args) {
    extern __shared__ __attribute__((aligned(16))) unsigned char lds_raw[];
    LAS unsigned char* lds = (LAS unsigned char*)lds_raw;
    LAS unsigned* rowtab = (LAS unsigned*)(lds + ROWTAB_OFF);
    volatile LAS unsigned* MISC = (volatile LAS unsigned*)(lds + MISC_OFF);
    const int G = gridDim.x, bx = blockIdx.x, tid = threadIdx.x, lane = tid & 63, wave = __builtin_amdgcn_readfirstlane(tid >> 6);
    const int gw = bx * NWAVES + wave, NGW = G * NWAVES, gt = bx * NWAVES * 64 + tid, NGT = G * NWAVES * 64;
    unsigned char* ws = args.ws; float* out = args.out;
    unsigned* ctl = (unsigned*)(ws + WS_CTL);
    const unsigned* cnt = ctl + CW_CNT;
    bf16_t* XN = (bf16_t*)(ws + WS_XN); bf16_t* YMIX = (bf16_t*)(ws + WS_YMIX); bf16_t* PROJ0 = (bf16_t*)(ws + WS_PROJ0); bf16_t* CQN = (bf16_t*)(ws + WS_CQN);
    bf16_t* CKVN = (bf16_t*)(ws + WS_CKVN); bf16_t* KROPE = (bf16_t*)(ws + WS_KROPE); bf16_t* QM = (bf16_t*)(ws + WS_QM); bf16_t* KVM = (bf16_t*)(ws + WS_KVM);
    bf16_t* ACT = (bf16_t*)(ws + WS_ACT); bf16_t* PROJ1 = (bf16_t*)(ws + WS_PROJ1); float* YR = (float*)(ws + WS_YR);
    unsigned char* ACTM = ws + WS_ACTM; bf16_t* YP0 = (bf16_t*)(ws + WS_YP0); bf16_t* YP1 = (bf16_t*)(ws + WS_YP1); unsigned char* XNM = ws + WS_XNM;
    unsigned char* TAB = ws + WS_TAB;
    const int* ltok = (const int*)(TAB + TAB_LTOK); const float* lgate = (const float*)(TAB + TAB_LGATE);
    const int lo = args.ph_lo, hi = args.ph_hi;
    for (int u = tid; u < (LDS_BYTES - RING_BYTES) / 4; u += NWAVES * 64) ((LAS unsigned*)(lds + RING_BYTES))[u] = 0u;
    __syncthreads();
    XcdBarrier bar; bar.bar = (unsigned*)(ctl + CW_BAR); bar.x = 0; bar.st = nullptr;
    if (hi - lo > 1) bar = xcd_barrier_post((unsigned*)(ctl + CW_BAR), MISC + 8);
#define IN(k) (lo <= (k) && (k) < hi)
#define SEAM(k) do { if (IN(k) && IN((k) + 1)) xcd_barrier(bar); } while (0)
    using namespace pg8;

#define EXPERT_ITEM(rr) do { const int r_ = (rr), e_ = r_ / (3 * 1792), q_ = r_ % (3 * 1792), which_ = q_ / 1792, item_ = q_ % 1792; LAS float* scr_ = (LAS float*)(lds + wave * 16384); \
        if (which_ == 0) p0_item8(args.in[I_OWE_GATE] + (size_t)e_ * D * FF, D, FF, ws + WS_WE_GU + (size_t)e_ * 2 * FF * D, RowGU{0}, 128.f * LOG2E_F, scr_, item_, lane); \
        else if (which_ == 1) p0_item8(args.in[I_OWE_UP] + (size_t)e_ * D * FF, D, FF, ws + WS_WE_GU + (size_t)e_ * 2 * FF * D, RowGU{1}, 128.f * RLOG2E_F, scr_, item_, lane); \
        else p0_item8(args.in[I_OWE_DOWN] + (size_t)e_ * FF * D, FF, D, ws + WS_WE_DN + (size_t)e_ * D * FF, RowIdent{0}, 256.f, scr_, item_, lane); } while (0)
#define OFFLOAD_TAIL(nwg, base, IPW) do { const int rem_ = (nwg) % G; if (rem_ != 0 && bx >= rem_) { const int first_ = (base) + ((bx - rem_) * NWAVES + wave) * (IPW); \
        for (int k_ = 0; k_ < (IPW); ++k_) EXPERT_ITEM(first_ + k_); } } while (0)
    if (IN(PH_P0)) {
        LAS float* scr = (LAS float*)(lds + wave * 16384);
        constexpr int I_IN0 = 16 * 45, I_UQ = 6 * 24, I_UKV = 4 * 32, I_SQ = 16 * 32, I_FF = 16 * 112, I_DN = 56 * 32;
        constexpr int NDENSE = I_IN0 + I_UQ + I_UKV + I_SQ + 2 * I_FF + I_DN + I_FF + I_SQ, NITEMS = NDENSE + NE * 3 * I_FF - OFF_ITEMS;
        static_assert(I_DN == I_FF, "expert item arithmetic assumes equal item counts");
        for (int it = gw; it < NITEMS; it += NGW) {
            int r = it;
            if (r < I_IN0) { p0_item(args.in[I_EW_IN], D, EVEN_IN, (bf16_t*)(ws + WS_W_IN0), RowIdent{0}, scr, r, lane); continue; } r -= I_IN0;
            if (r < I_UQ) { p0_item(args.in[I_EW_UQ], 384, 768, (bf16_t*)(ws + WS_W_UQ), RowIdent{0}, scr, r, lane); continue; } r -= I_UQ;
            if (r < I_UKV) { p0_item(args.in[I_EW_UKV], 256, 1024, (bf16_t*)(ws + WS_W_UKV), RowIdent{0}, scr, r, lane); continue; } r -= I_UKV;
            if (r < I_SQ) { p0_item(args.in[I_EW_OUT], D, D, (bf16_t*)(ws + WS_W_OUT0), RowIdent{0}, scr, r, lane); continue; } r -= I_SQ;
            if (r < I_FF) { p0_item(args.in[I_EW_GATE], D, FF, (bf16_t*)(ws + WS_W_GU0), RowGU{0}, scr, r, lane, LOG2E_F); continue; } r -= I_FF;
            if (r < I_FF) { p0_item(args.in[I_EW_UP], D, FF, (bf16_t*)(ws + WS_W_GU0), RowGU{1}, scr, r, lane, RLOG2E_F); continue; } r -= I_FF;
            if (r < I_DN) { p0_item(args.in[I_EW_DOWN], FF, D, (bf16_t*)(ws + WS_W_DN0), RowIdent{0}, scr, r, lane); continue; } r -= I_DN;
            if (r < I_FF) { p0_item(args.in[I_OW_IN], D, ODD_IN, (bf16_t*)(ws + WS_W_IN1), RowIdent{0}, scr, r, lane); continue; } r -= I_FF;
            if (r < I_SQ) { p0_item(args.in[I_OW_OUT], D, D, (bf16_t*)(ws + WS_W_OUT1), RowIdent{0}, scr, r, lane); continue; } r -= I_SQ;
            EXPERT_ITEM(r + OFF_ITEMS);
        }
        if (G != 256) for (int it = gw; it < OFF_ITEMS; it += NGW) EXPERT_ITEM(it);
        { v4u* z = (v4u*)((bf16_t*)(ws + WS_W_IN0) + (size_t)EVEN_IN * D); for (int i = gt; i < (EVEN_INP - EVEN_IN) * D / 8; i += NGT) z[i] = (v4u){0u, 0u, 0u, 0u}; }
        norm_rows(args.in[I_X], args.in[I_ENORM_MIX], XN, gw, NGW, lane);
    }
    SEAM(PH_P0);
    if (IN(PH_G1)) {
        Gemm g{XN, (const bf16_t*)(ws + WS_W_IN0), D, D, D, 0}; StaticOrder S; S.init(T / 256, EVEN_INP / 256, G, bx);
        gemm_phase<EpiBf16, StaticOrder, ARowIdent, true>(lds, rowtab, g, S, ARowIdent{}, EpiBf16{PROJ0, EVEN_INP});
        if (G == 256) OFFLOAD_TAIL((T / 256) * (EVEN_INP / 256), 0, OFF_IPW1);
    }
    SEAM(PH_G1);
    if (IN(PH_MP)) mla_prep_rows(PROJ0, args.in[I_EQ_NORM], args.in[I_EKV_NORM], (const int*)args.in[I_POS], CQN, CKVN, KROPE, (float*)(ws + WS_ROPE), gw, NGW, lane);
    SEAM(PH_MP);
    if (IN(PH_G2)) {
        { Gemm g{CQN, (const bf16_t*)(ws + WS_W_UQ), 384, 384, 384, 0}; StaticOrder S; S.init(T / 256, 768 / 256, G, bx);
          gemm_phase<EpiBf16, StaticOrder, ARowIdent, true>(lds, rowtab, g, S, ARowIdent{}, EpiBf16{QM, 768}); }
        { Gemm g{CKVN, (const bf16_t*)(ws + WS_W_UKV), 256, 256, 256, 0}; StaticOrder S; S.init(T / 256, 1024 / 256, G, bx);
          gemm_phase<EpiBf16, StaticOrder, ARowIdent, true>(lds, rowtab, g, S, ARowIdent{}, EpiBf16{KVM, 1024}); }
    }
    SEAM(PH_G2);
    if (IN(PH_ATT)) {
        static_assert(att::SWA_END <= RING_BYTES, "attention LDS map");
        const int vcu = (G % 8 == 0) ? (bx % 8) * (G / 8) + bx / 8 : bx;
        for (int pr = vcu; pr < BATCH * 8 * 4; pr += G) {
            const int bh = pr >> 2, sI = pr & 3;
            att::mla_unit((LAS char*)lds, QM, KVM, KROPE, (const float*)(ws + WS_ROPE), YMIX, bh >> 3, bh & 7, sI);
            att::mla_unit((LAS char*)lds, QM, KVM, KROPE, (const float*)(ws + WS_ROPE), YMIX, bh >> 3, bh & 7, 7 - sI);
        }
        for (int u = vcu; u < BATCH * 32 * 2; u += G) att::swa_unit((LAS char*)lds, PROJ0, args.in[I_ESINKS], YMIX, u >> 6, (u & 63) >> 1, u & 1);
    }
    SEAM(PH_ATT);
    if (IN(PH_G3)) {
        Gemm g{YMIX, (const bf16_t*)(ws + WS_W_OUT0), D, D, D, 0}; StaticOrder S; S.init(T / 256, D / 256, G, bx);
        gemm_phase<EpiRes, StaticOrder, ARowIdent, true>(lds, rowtab, g, S, ARowIdent{}, EpiRes{args.in[I_X], out, D});
    }
    SEAM(PH_G3);
    if (IN(PH_N2)) norm_rows(out, args.in[I_ENORM_FFN], XN, gw, NGW, lane);
    SEAM(PH_N2);
    if (IN(PH_G4)) {
        Gemm g{XN, (const bf16_t*)(ws + WS_W_GU0), D, D, D, 0}; StaticOrder S; S.init(T / 256, 2 * FF / 256, G, bx);
        gemm_phase<EpiSwiglu, StaticOrder, ARowIdent, true>(lds, rowtab, g, S, ARowIdent{}, EpiSwiglu{ACT, FF});
    }
    SEAM(PH_G4);
    if (IN(PH_G5)) {
        Gemm g{ACT, (const bf16_t*)(ws + WS_W_DN0), FF, FF, FF, 0}; StaticOrder S; S.init(T / 256, D / 256, G, bx);
        gemm_phase<EpiRes, StaticOrder, ARowIdent, true>(lds, rowtab, g, S, ARowIdent{}, EpiRes{out, out, D});
    }
    SEAM(PH_G5);
    if (IN(PH_N3)) norm_rows(out, args.in[I_ONORM_MIX], XN, gw, NGW, lane);
    SEAM(PH_N3);
    if (IN(PH_G6)) {
        Gemm g{XN, (const bf16_t*)(ws + WS_W_IN1), D, D, D, 0}; StaticOrder S; S.init(T / 256, ODD_IN / 256, G, bx);
        gemm_phase<EpiBf16, StaticOrder, ARowIdent, true>(lds, rowtab, g, S, ARowIdent{}, EpiBf16{PROJ1, ODD_IN});
        if (G == 256) OFFLOAD_TAIL((T / 256) * (ODD_IN / 256), 128 * NWAVES * OFF_IPW1, OFF_IPW2);
    }
    SEAM(PH_G6);
    if (IN(PH_RET1)) {
        for (int u = bx; u < BATCH * 4 * 32; u += G) ret::ret1_unit((LAS char*)lds, PROJ1, (bf16_t*)(ws + WS_RKV), u);
        conv_elems(PROJ1, args.in[I_OCONV_W], YMIX, gt, NGT);
    }
    SEAM(PH_RET1);
    if (IN(PH_RET2)) ret::ret2_elems((bf16_t*)(ws + WS_RKV), gt, NGT);
    SEAM(PH_RET2);
    if (IN(PH_RET3)) { static_assert(ret::R3_END <= RING_BYTES, "retention LDS map");
        for (int u = bx; u < BATCH * 4 * 32; u += G) ret::ret3_unit((LAS char*)lds, PROJ1, (const bf16_t*)(ws + WS_RKV), args.in[I_ORET_GN], YMIX, u); }
    SEAM(PH_RET3);
    if (IN(PH_G7)) {
        Gemm g{YMIX, (const bf16_t*)(ws + WS_W_OUT1), D, D, D, 0}; StaticOrder S; S.init(T / 256, D / 256, G, bx);
        gemm_phase<EpiRes, StaticOrder, ARowIdent, true>(lds, rowtab, g, S, ARowIdent{}, EpiRes{out, out, D});
    }
    SEAM(PH_G7);
    if (IN(PH_ROUTE)) route_tokens(out, args.in[I_ONORM_FFN], args.in[I_OROUTER], XNM, ctl, TAB, (LAS unsigned*)lds, bx, G, tid);
    SEAM(PH_ROUTE);
    if (IN(PH_G8)) {
        Gemm g{XNM, ws + WS_WE_GU, D, D, D, (size_t)2 * FF * D, 0x7D7D7D7D, 0x78787878, 0x7B7B7B7B}; MoeOrder S; S.init(cnt, 0, MOE_MAXT, 2 * FF / 256, 1, 0, G, bx);
        gemm_phase<EpiSwiglu8, MoeOrder, ARowMoe, true, true>(lds, rowtab, g, S, ARowMoe{ltok, cnt}, EpiSwiglu8{ACTM, FF});
    }
    SEAM(PH_G8);
    if (IN(PH_G9)) {
        Gemm g{ACTM, ws + WS_WE_DN, FF, FF, FF / 2, (size_t)D * FF, 0x7C7C7C7C, 0x77777777, 0x77777777}; MoeOrder S; S.init(cnt, 0, MOE_MAXT, D / 256, 2, FF / 2, G, bx);
        gemm_phase<EpiMoeDn, MoeOrder, ARowIdent, true, true>(lds, rowtab, g, S, ARowIdent{}, EpiMoeDn{YP0, YP1, lgate, cnt, 0});
    }
    SEAM(PH_G9);
    if (IN(PH_FINAL)) final_rows(out, YP0, YP1, cnt, TAB, args.in[I_FINAL_NORM], out, gw, NGW, lane);
#undef IN
#undef SEAM
}

template <class RM> static void wconv(const float* W, int K, int N, bf16_t* WT, RM rm, hipStream_t st) {
    hipLaunchKernelGGL((k_wconv<RM>), dim3((K / 32) * (N / 32)), dim3(256), 0, st, W, K, N, WT, rm);
}
template <bool DUAL, class Ctx> static void gemm(const bf16_t* A, int lda, const bf16_t* Bt, int ldb, int M, int N, int K, Ctx ctx, hipStream_t st) {
    GemmArgs g{A, Bt, lda, ldb, M, N, K, 0};
    hipLaunchKernelGGL((k_gemm<DUAL, Ctx>), dim3(N / 64, M / 64), dim3(256), 0, st, g, ctx);
}

extern "C" void kernel_launch(void* const* d_in, const int* in_sizes, int n_in, void* d_out, int out_size, void* d_ws, size_t ws_size, hipStream_t stream) {
    if (n_in != 25 || out_size != T * D || ws_size < WS_END) { fprintf(stderr, "kernel_launch: unexpected problem (n_in %d out %d ws %zu need %zu)\n", n_in, out_size, ws_size, (size_t)WS_END); return; }
    const float* x = (const float*)d_in[0]; const int* pos = (const int*)d_in[1];
    const float* e_norm_mix = (const float*)d_in[2]; const float* e_w_in = (const float*)d_in[3]; const float* e_sinks = (const float*)d_in[4];
    const float* e_q_norm = (const float*)d_in[5]; const float* e_w_uq = (const float*)d_in[6]; const float* e_kv_norm = (const float*)d_in[7]; const float* e_w_ukv = (const float*)d_in[8];
    const float* e_w_out = (const float*)d_in[9]; const float* e_norm_ffn = (const float*)d_in[10]; const float* e_w_gate = (const float*)d_in[11]; const float* e_w_up = (const float*)d_in[12];
    const float* e_w_down = (const float*)d_in[13]; const float* o_norm_mix = (const float*)d_in[14]; const float* o_w_in = (const float*)d_in[15]; const float* o_ret_gn = (const float*)d_in[16];
    const float* o_conv_w = (const float*)d_in[17]; const float* o_w_out = (const float*)d_in[18]; const float* o_norm_ffn = (const float*)d_in[19]; const float* o_router = (const float*)d_in[20];
    const float* o_we_gate = (const float*)d_in[21]; const float* o_we_up = (const float*)d_in[22]; const float* o_we_down = (const float*)d_in[23]; const float* final_norm = (const float*)d_in[24];
    unsigned char* ws = (unsigned char*)d_ws; float* out = (float*)d_out;
    unsigned* ctl = (unsigned*)(ws + WS_CTL);
    bf16_t* W_IN0 = (bf16_t*)(ws + WS_W_IN0); bf16_t* W_UQ = (bf16_t*)(ws + WS_W_UQ); bf16_t* W_UKV = (bf16_t*)(ws + WS_W_UKV); bf16_t* W_OUT0 = (bf16_t*)(ws + WS_W_OUT0);
    bf16_t* W_GU0 = (bf16_t*)(ws + WS_W_GU0); bf16_t* W_DN0 = (bf16_t*)(ws + WS_W_DN0); bf16_t* W_IN1 = (bf16_t*)(ws + WS_W_IN1); bf16_t* W_OUT1 = (bf16_t*)(ws + WS_W_OUT1);
    bf16_t* WE_GU = (bf16_t*)(ws + WS_WE_GU); bf16_t* WE_DN = (bf16_t*)(ws + WS_WE_DN);
    bf16_t* XN = (bf16_t*)(ws + WS_XN); bf16_t* YMIX = (bf16_t*)(ws + WS_YMIX); bf16_t* PROJ0 = (bf16_t*)(ws + WS_PROJ0); bf16_t* CQN = (bf16_t*)(ws + WS_CQN);
    bf16_t* CKVN = (bf16_t*)(ws + WS_CKVN); bf16_t* KROPE = (bf16_t*)(ws + WS_KROPE); bf16_t* QM = (bf16_t*)(ws + WS_QM); bf16_t* KVM = (bf16_t*)(ws + WS_KVM);
    bf16_t* ACT = (bf16_t*)(ws + WS_ACT); bf16_t* PROJ1 = (bf16_t*)(ws + WS_PROJ1); float* YR = (float*)(ws + WS_YR);
    bf16_t* ACTM = (bf16_t*)(ws + WS_ACTM); bf16_t* YP0 = (bf16_t*)(ws + WS_YP0); bf16_t* YP1 = (bf16_t*)(ws + WS_YP1); unsigned char* TAB = ws + WS_TAB; bf16_t* XNM = (bf16_t*)(ws + WS_XNM);

    static int grid = 0;
    if (grid == 0) {
        int dev = 0, cus = 0;
        if (hipGetDevice(&dev) != hipSuccess || hipDeviceGetAttribute(&cus, hipDeviceAttributeMultiprocessorCount, dev) != hipSuccess) { fprintf(stderr, "kernel_launch: device query failed\n"); grid = -1; return; }
        if (hipFuncSetAttribute((const void*)skel_fwd, hipFuncAttributeMaxDynamicSharedMemorySize, LDS_BYTES) != hipSuccess) { fprintf(stderr, "kernel_launch: hipFuncSetAttribute failed\n"); grid = -1; return; }
        grid = cus;
    }
    if (grid < 0) return;
    Args a{};
    for (int i = 0; i < 25; ++i) a.in[i] = (const float*)d_in[i];
    a.out = out; a.ws = ws;
    auto phase = [&](int lo, int hi) { a.ph_lo = lo; a.ph_hi = hi; hipLaunchKernelGGL(skel_fwd, dim3(grid), dim3(NWAVES * 64), LDS_BYTES, stream, a); };
    (void)hipMemsetAsync(ws + WS_CTL, 0, 1 * MiB, stream);
#if MK_ONE_LAUNCH
    phase(0, NPHASE);
#else
    for (int k = 0; k < NPHASE; ++k) { phase(k, k + 1); if (k == PROBE_DUP) phase(k, k + 1); }
#endif
}
```

```cpp
#include <hip/hip_runtime.h>
#include <cstdint>
#include <cstdio>
#include <cmath>

typedef unsigned short bf16_t;
constexpr int D = 1024, BATCH = 8, SEQ = 2048, T = BATCH * SEQ, CHUNK = 64;
constexpr int EVEN_IN = 1440, EVEN_INP = 1536, FF = 3584, ODD_IN = 3584, NE = 8;
constexpr float EPS = 1e-6f;
constexpr int P0_QA = 0, P0_KA = 512, P0_VA = 640, P0_CQ = 768, P0_CKV = 1152, P0_KR = 1408;
constexpr int P1_Q = 0, P1_K = 512, P1_V = 1024, P1_G = 1536, P1_B = 2048, P1_C = 2560, P1_H = 3072;

constexpr size_t MiB = 1u << 20;
constexpr size_t WS_CTL = 0;
constexpr size_t WS_W_IN0 = 1 * MiB;
constexpr size_t WS_W_UQ = WS_W_IN0 + (size_t)EVEN_INP * D * 2;
constexpr size_t WS_W_UKV = WS_W_UQ + (size_t)768 * 384 * 2;
constexpr size_t WS_W_OUT0 = WS_W_UKV + (size_t)1024 * 256 * 2;
constexpr size_t WS_W_GU0 = WS_W_OUT0 + (size_t)D * D * 2;
constexpr size_t WS_W_DN0 = WS_W_GU0 + (size_t)2 * FF * D * 2;
constexpr size_t WS_W_IN1 = WS_W_DN0 + (size_t)D * FF * 2;
constexpr size_t WS_W_OUT1 = WS_W_IN1 + (size_t)ODD_IN * D * 2;
constexpr size_t WS_WE_GU = 38 * MiB;
constexpr size_t WS_WE_DN = WS_WE_GU + (size_t)NE * 2 * FF * D;
constexpr size_t WS_ACT0 = WS_WE_DN + (size_t)NE * D * FF;
static_assert(WS_W_OUT1 + (size_t)D * D * 2 <= WS_WE_GU, "dense weights fit below 38 MiB");
static_assert(WS_ACT0 == 122 * MiB, "activation base");
constexpr size_t WS_XN = WS_ACT0;
constexpr size_t WS_YMIX = WS_ACT0 + 32 * MiB;
constexpr size_t WS_BIG = WS_ACT0 + 64 * MiB;
constexpr size_t WS_PROJ0 = WS_BIG;
constexpr size_t WS_CQN = WS_BIG + 48 * MiB;
constexpr size_t WS_CKVN = WS_BIG + 60 * MiB;
constexpr size_t WS_KROPE = WS_BIG + 68 * MiB;
constexpr size_t WS_QM = WS_BIG + 70 * MiB;
constexpr size_t WS_KVM = WS_BIG + 94 * MiB;
constexpr size_t WS_ROPE = WS_BIG + 126 * MiB;
constexpr size_t WS_ACT = WS_BIG;
constexpr size_t WS_PROJ1 = WS_BIG;
constexpr size_t WS_RKV = WS_BIG + 112 * MiB;
constexpr size_t WS_YR = WS_BIG + 144 * MiB;
constexpr int MOE_MAXT = 136;
constexpr size_t WS_ACTM = WS_ACT0;
constexpr size_t WS_YP0 = WS_ACT0 + 119 * MiB;
constexpr size_t WS_YP1 = WS_YP0 + 68 * MiB;
constexpr size_t WS_TAB = WS_YP1 + 68 * MiB;
constexpr size_t WS_XNM = 1 * MiB;
constexpr size_t WS_END = WS_TAB + 2 * MiB;
static_assert(WS_END <= 471 * MiB, "workspace budget");
constexpr size_t TAB_LTOK = 0;
constexpr size_t TAB_LGATE = 512 * 1024;
constexpr size_t TAB_TSEL = 1024 * 1024;
constexpr size_t TAB_TGATE = 1280 * 1024;
constexpr int CW_CNT = 64;

__device__ __forceinline__ float bf2f(bf16_t v) { return __uint_as_float((unsigned)v << 16); }
__device__ __forceinline__ bf16_t f2bf(float f) { unsigned u = __float_as_uint(f); return (bf16_t)((u + 0x7fffu + ((u >> 16) & 1u)) >> 16); }
__device__ __forceinline__ float wave_sum(float v) {
#pragma unroll
    for (int o = 1; o < 64; o <<= 1) v += __shfl_xor(v, o);
    return v;
}
__device__ __forceinline__ float silu(float v) { return v / (1.f + __expf(-v)); }

struct RowIdent { int off; __device__ int operator()(int n) const { return off + n; } };
struct RowGU { int half; __device__ int operator()(int n) const { return 256 * (n >> 7) + 128 * half + (n & 127); } };
constexpr float LOG2E_F = 1.4426950408889634f, RLOG2E_F = 0.6931471805599453f;
template <class RM>
__global__ void __launch_bounds__(256) k_wconv(const float* __restrict__ W, int K, int N, bf16_t* __restrict__ WT, RM rm) {
    __shared__ float tile[32][33];
    const int nb = N / 32, kb = blockIdx.x / nb, n0 = (blockIdx.x % nb) * 32, k0 = kb * 32;
    const int tx = threadIdx.x & 31, ty = threadIdx.x >> 5;
    for (int i = ty; i < 32; i += 8) tile[i][tx] = W[(size_t)(k0 + i) * N + n0 + tx];
    __syncthreads();
    for (int i = ty; i < 32; i += 8) WT[(size_t)rm(n0 + i) * K + k0 + tx] = f2bf(tile[tx][i]);
}
__global__ void k_fill_bf16(bf16_t* p, size_t n, bf16_t v) { size_t i = (size_t)blockIdx.x * blockDim.x + threadIdx.x; if (i < n) p[i] = v; }

__global__ void __launch_bounds__(256) k_rmsnorm(const float* __restrict__ x, const float* __restrict__ g, bf16_t* __restrict__ o) {
    const int row = blockIdx.x * 4 + (threadIdx.x >> 6), lane = threadIdx.x & 63;
    const float* xr = x + (size_t)row * D;
    float v[16]; float s = 0.f;
#pragma unroll
    for (int j = 0; j < 16; ++j) { v[j] = xr[lane + 64 * j]; s += v[j] * v[j]; }
    const float rs = rsqrtf(wave_sum(s) * (1.f / D) + EPS);
#pragma unroll
    for (int j = 0; j < 16; ++j) o[(size_t)row * D + lane + 64 * j] = f2bf(v[j] * rs * g[lane + 64 * j]);
}

struct GemmArgs { const bf16_t* A; const bf16_t* Bt; int lda, ldb, M, N, K, pad; };
template <bool DUAL, class Ctx>
__global__ void __launch_bounds__(256) k_gemm(GemmArgs g, Ctx ctx) {
    __shared__ float As[16][68], Bs[16][68], B2[16][68];
    const int m0 = blockIdx.y * 64, n0 = blockIdx.x * 64;
    if (!ctx.block_valid(m0)) return;
    const bf16_t* Bt = g.Bt + ctx.b_offset(m0);
    const int tx = threadIdx.x & 15, ty = threadIdx.x >> 4;
    float acc[4][4], acc2[4][4];
#pragma unroll
    for (int i = 0; i < 4; ++i)
#pragma unroll
        for (int j = 0; j < 4; ++j) { acc[i][j] = 0.f; acc2[i][j] = 0.f; }
    const int lr = threadIdx.x >> 2, lk = (threadIdx.x & 3) * 4;
    const size_t arow = (size_t)ctx.a_row(m0 + lr) * g.lda;
    const size_t brow = (size_t)ctx.b_row(n0 + lr) * g.ldb;
    for (int k0 = 0; k0 < g.K; k0 += 16) {
#pragma unroll
        for (int j = 0; j < 4; ++j) {
            As[lk + j][lr] = bf2f(g.A[arow + k0 + lk + j]);
            Bs[lk + j][lr] = bf2f(Bt[brow + k0 + lk + j]);
            if (DUAL) B2[lk + j][lr] = bf2f(Bt[brow + (size_t)128 * g.ldb + k0 + lk + j]);
        }
        __syncthreads();
#pragma unroll
        for (int kk = 0; kk < 16; ++kk) {
            float a[4], b[4], b2[4];
#pragma unroll
            for (int i = 0; i < 4; ++i) { a[i] = As[kk][ty * 4 + i]; b[i] = Bs[kk][tx * 4 + i]; b2[i] = DUAL ? B2[kk][tx * 4 + i] : 0.f; }
#pragma unroll
            for (int i = 0; i < 4; ++i)
#pragma unroll
                for (int j = 0; j < 4; ++j) { acc[i][j] += a[i] * b[j]; if (DUAL) acc2[i][j] += a[i] * b2[j]; }
        }
        __syncthreads();
    }
#pragma unroll
    for (int i = 0; i < 4; ++i)
#pragma unroll
        for (int j = 0; j < 4; ++j) ctx.store(m0 + ty * 4 + i, n0 + tx * 4 + j, acc[i][j], acc2[i][j]);
}
struct CtxBf16 {
    bf16_t* O; int ldc; int pad;
    __device__ bool block_valid(int) const { return true; }
    __device__ size_t b_offset(int) const { return 0; }
    __device__ int a_row(int m) const { return m; }
    __device__ int b_row(int n) const { return n; }
    __device__ void store(int m, int n, float a, float) const { O[(size_t)m * ldc + n] = f2bf(a); }
};
struct CtxRes {
    const float* base; float* out; int ldc; int pad;
    __device__ bool block_valid(int) const { return true; }
    __device__ size_t b_offset(int) const { return 0; }
    __device__ int a_row(int m) const { return m; }
    __device__ int b_row(int n) const { return n; }
    __device__ void store(int m, int n, float a, float) const { out[(size_t)m * ldc + n] = base[(size_t)m * ldc + n] + a; }
};
struct CtxSwiglu {
    bf16_t* O; int ldc; int pad;
    __device__ bool block_valid(int) const { return true; }
    __device__ size_t b_offset(int) const { return 0; }
    __device__ int a_row(int m) const { return m; }
    __device__ int b_row(int n) const { return 256 * (n >> 7) + (n & 127); }
    __device__ void store(int m, int n, float a, float b) const { O[(size_t)m * ldc + n] = f2bf(silu(a) * b); }
};
__device__ __forceinline__ void moe_tile(const unsigned* cnt, int tile, int& e, int& slot0, int& ntiles) {
    int tb = 0; e = -1; slot0 = 0;
#pragma unroll
    for (int i = 0; i < NE; ++i) { const int c = (int)cnt[64 * i], nt = (c + 255) >> 8; if (e < 0 && tile < tb + nt) { e = i; slot0 = (tile - tb) * 256; } tb += nt; }
    ntiles = tb;
}
struct CtxMoeGU {
    bf16_t* O; const unsigned* cnt; const int* ltok; int ldc, tile_lo, tile_hi, pad;
    __device__ bool block_valid(int m0) const { int e, s0, nt; const int t = tile_lo + (m0 >> 8); moe_tile(cnt, t, e, s0, nt); return t < tile_hi && t < nt && e >= 0; }
    __device__ size_t b_offset(int m0) const { int e, s0, nt; moe_tile(cnt, tile_lo + (m0 >> 8), e, s0, nt); return (size_t)e * 2 * FF * D; }
    __device__ int a_row(int m) const { int e, s0, nt; moe_tile(cnt, tile_lo + (m >> 8), e, s0, nt); const int slot = s0 + (m & 255); return slot < (int)cnt[64 * e] ? ltok[e * T + slot] : 0; }
    __device__ int b_row(int n) const { return 256 * (n >> 7) + (n & 127); }
    __device__ void store(int m, int n, float a, float b) const { O[(size_t)m * ldc + n] = f2bf(silu(a) * b); }
};
struct CtxMoeDn {
    bf16_t* O; const unsigned* cnt; const float* lgate; int tile_lo, tile_hi;
    __device__ bool block_valid(int m0) const { int e, s0, nt; const int t = tile_lo + (m0 >> 8); moe_tile(cnt, t, e, s0, nt); return t < tile_hi && t < nt && e >= 0; }
    __device__ size_t b_offset(int m0) const { int e, s0, nt; moe_tile(cnt, tile_lo + (m0 >> 8), e, s0, nt); return (size_t)e * D * FF; }
    __device__ int a_row(int m) const { return m; }
    __device__ int b_row(int n) const { return n; }
    __device__ void store(int m, int n, float a, float) const {
        int e, s0, nt; moe_tile(cnt, tile_lo + (m >> 8), e, s0, nt); const int slot = s0 + (m & 255);
        const float gt = slot < (int)cnt[64 * e] ? lgate[e * T + slot] : 0.f;
        O[(size_t)(tile_lo * 256 + m) * D + n] = f2bf(gt * a);
    }
};

__global__ void __launch_bounds__(256) k_mla_prep(const bf16_t* __restrict__ proj0, const float* __restrict__ qg, const float* __restrict__ kvg, const int* __restrict__ pos,
                                                  bf16_t* __restrict__ cqn, bf16_t* __restrict__ ckvn, bf16_t* __restrict__ krope) {
    const int tkn = blockIdx.x * 4 + (threadIdx.x >> 6), lane = threadIdx.x & 63;
    const bf16_t* pr = proj0 + (size_t)tkn * EVEN_INP;
    float q[6], s = 0.f;
#pragma unroll
    for (int j = 0; j < 6; ++j) { q[j] = bf2f(pr[P0_CQ + lane + 64 * j]); s += q[j] * q[j]; }
    float rs = rsqrtf(wave_sum(s) * (1.f / 384.f) + EPS);
#pragma unroll
    for (int j = 0; j < 6; ++j) cqn[(size_t)tkn * 384 + lane + 64 * j] = f2bf(q[j] * rs * qg[lane + 64 * j]);
    float c[4]; s = 0.f;
#pragma unroll
    for (int j = 0; j < 4; ++j) { c[j] = bf2f(pr[P0_CKV + lane + 64 * j]); s += c[j] * c[j]; }
    rs = rsqrtf(wave_sum(s) * (1.f / 256.f) + EPS);
#pragma unroll
    for (int j = 0; j < 4; ++j) ckvn[(size_t)tkn * 256 + lane + 64 * j] = f2bf(c[j] * rs * kvg[lane + 64 * j]);
    if (lane < 16) {
        const float p = (float)pos[tkn];
        const float inv = powf(10000.f, -(float)(2 * lane) / 32.f);
        const float ang = p * inv, cs = cosf(ang), sn = sinf(ang);
        const float t1 = bf2f(pr[P0_KR + lane]), t2 = bf2f(pr[P0_KR + 16 + lane]);
        krope[(size_t)tkn * 32 + lane] = f2bf(t1 * cs - t2 * sn);
        krope[(size_t)tkn * 32 + 16 + lane] = f2bf(t2 * cs + t1 * sn);
    }
}

__global__ void __launch_bounds__(64) k_swa(const bf16_t* __restrict__ proj0, const float* __restrict__ sinks, bf16_t* __restrict__ ymix) {
    const int idx = blockIdx.x * 64 + threadIdx.x;
    const int tkn = idx >> 3, h = idx & 7, hk = h >> 2;
    const int b = tkn / SEQ, s = tkn % SEQ, n = s / CHUNK, qi = s % CHUNK;
    const float slope = exp2f(-8.f * (float)(h + 1) / 8.f);
    float q[64], o[64];
#pragma unroll
    for (int d = 0; d < 64; ++d) { q[d] = bf2f(proj0[(size_t)tkn * EVEN_INP + P0_QA + h * 64 + d]); o[d] = 0.f; }
    const float sink = sinks[h];
    float m = sink, l = 1.f;
    const int k_lo = (n - 2) * CHUNK, k_hi = (n + 1) * CHUNK;
    for (int kp = (k_lo < 0 ? 0 : k_lo); kp < k_hi; ++kp) {
        const bf16_t* kr = proj0 + (size_t)(b * SEQ + kp) * EVEN_INP + P0_KA + hk * 64;
        float sc = 0.f;
#pragma unroll
        for (int d = 0; d < 64; ++d) sc += q[d] * bf2f(kr[d]);
        const int kk = kp - k_lo;
        const float dist = fabsf((float)(qi + 2 * CHUNK - kk));
        sc = sc * 0.125f - slope * dist;
        const float mn = fmaxf(m, sc), f = __expf(m - mn), p = __expf(sc - mn);
        l = l * f + p; m = mn;
        const bf16_t* vr = proj0 + (size_t)(b * SEQ + kp) * EVEN_INP + P0_VA + hk * 64;
#pragma unroll
        for (int d = 0; d < 64; ++d) o[d] = o[d] * f + p * bf2f(vr[d]);
    }
    const float il = 1.f / l;
#pragma unroll
    for (int d = 0; d < 64; ++d) ymix[(size_t)tkn * D + h * 64 + d] = f2bf(o[d] * il);
}

__global__ void __launch_bounds__(64) k_mla(const bf16_t* __restrict__ qm, const bf16_t* __restrict__ kvm, const bf16_t* __restrict__ krope, const int* __restrict__ pos, bf16_t* __restrict__ ymix) {
    const int idx = blockIdx.x * 64 + threadIdx.x;
    const int tkn = idx >> 3, h = idx & 7;
    const int b = tkn / SEQ, s = tkn % SEQ, c = s / CHUNK;
    float q[96], o[64];
#pragma unroll
    for (int d = 0; d < 96; ++d) q[d] = bf2f(qm[(size_t)tkn * 768 + h * 96 + d]);
    {
        const float p = (float)pos[tkn];
#pragma unroll
        for (int i = 0; i < 16; ++i) {
            const float inv = powf(10000.f, -(float)(2 * i) / 32.f), ang = p * inv, cs = cosf(ang), sn = sinf(ang);
            const float t1 = q[64 + i], t2 = q[80 + i];
            q[64 + i] = t1 * cs - t2 * sn; q[80 + i] = t2 * cs + t1 * sn;
        }
    }
#pragma unroll
    for (int d = 0; d < 64; ++d) o[d] = 0.f;
    const float scale = 0.10206207261596577f;
    float m = -1e30f, l = 0.f;
    const int nk = (c + 1) * CHUNK;
    for (int kp = 0; kp < nk; ++kp) {
        const bf16_t* kr = kvm + (size_t)(b * SEQ + kp) * 1024 + h * 128;
        const bf16_t* rr = krope + (size_t)(b * SEQ + kp) * 32;
        float sc = 0.f;
#pragma unroll
        for (int d = 0; d < 64; ++d) sc += q[d] * bf2f(kr[d]);
#pragma unroll
        for (int d = 0; d < 32; ++d) sc += q[64 + d] * bf2f(rr[d]);
        sc *= scale;
        const float mn = fmaxf(m, sc), f = __expf(m - mn), p = __expf(sc - mn);
        l = l * f + p; m = mn;
#pragma unroll
        for (int d = 0; d < 64; ++d) o[d] = o[d] * f + p * bf2f(kr[64 + d]);
    }
    const float il = 1.f / l;
#pragma unroll
    for (int d = 0; d < 64; ++d) ymix[(size_t)tkn * D + 512 + h * 64 + d] = f2bf(o[d] * il);
}

__global__ void __launch_bounds__(128) k_ret(const bf16_t* __restrict__ proj1, float* __restrict__ yr) {
    const int bh = blockIdx.x, b = bh >> 2, h = bh & 3, dv = threadIdx.x;
    const float g = 1.f - exp2f(-5.f - (float)h);
    const float ks = 0.08838834764831845f;
    float S[128];
#pragma unroll
    for (int d = 0; d < 128; ++d) S[d] = 0.f;
    __shared__ float qs[128], kss[128];
    for (int s = 0; s < SEQ; ++s) {
        const bf16_t* pr = proj1 + (size_t)(b * SEQ + s) * ODD_IN;
        __syncthreads();
        qs[dv] = bf2f(pr[P1_Q + h * 128 + dv]); kss[dv] = bf2f(pr[P1_K + h * 128 + dv]) * ks;
        __syncthreads();
        const float v = bf2f(pr[P1_V + h * 128 + dv]);
        float o = 0.f;
#pragma unroll
        for (int d = 0; d < 128; ++d) { S[d] = g * S[d] + kss[d] * v; o += qs[d] * S[d]; }
        yr[(size_t)(b * SEQ + s) * 512 + h * 128 + dv] = o;
    }
}
__global__ void __launch_bounds__(256) k_ret_gn(const float* __restrict__ yr, const bf16_t* __restrict__ proj1, const float* __restrict__ gn, bf16_t* __restrict__ ymix) {
    const int w = blockIdx.x * 4 + (threadIdx.x >> 6), lane = threadIdx.x & 63;
    const int tkn = w >> 2, h = w & 3;
    const float a = yr[(size_t)tkn * 512 + h * 128 + lane], c = yr[(size_t)tkn * 512 + h * 128 + 64 + lane];
    const float mu = wave_sum(a + c) * (1.f / 128.f);
    const float da = a - mu, dc = c - mu;
    const float var = wave_sum(da * da + dc * dc) * (1.f / 128.f);
    const float rs = rsqrtf(var + EPS);
    const float g0 = bf2f(proj1[(size_t)tkn * ODD_IN + P1_G + h * 128 + lane]), g1 = bf2f(proj1[(size_t)tkn * ODD_IN + P1_G + h * 128 + 64 + lane]);
    ymix[(size_t)tkn * D + h * 128 + lane] = f2bf(silu(g0) * da * rs * gn[h * 128 + lane]);
    ymix[(size_t)tkn * D + h * 128 + 64 + lane] = f2bf(silu(g1) * dc * rs * gn[h * 128 + 64 + lane]);
}
__global__ void __launch_bounds__(256) k_conv(const bf16_t* __restrict__ proj1, const float* __restrict__ w, bf16_t* __restrict__ ymix) {
    const size_t i = (size_t)blockIdx.x * 256 + threadIdx.x;
    const int tkn = (int)(i >> 9), c = (int)(i & 511), s = tkn % SEQ;
    float y = 0.f;
#pragma unroll
    for (int j = 0; j < 3; ++j) {
        const int sp = s - 2 + j;
        if (sp >= 0) { const bf16_t* pr = proj1 + (size_t)(tkn - 2 + j) * ODD_IN; y += w[j * 512 + c] * bf2f(pr[P1_C + c]) * bf2f(pr[P1_H + c]); }
    }
    ymix[(size_t)tkn * D + 512 + c] = f2bf(bf2f(proj1[(size_t)tkn * ODD_IN + P1_B + c]) * y);
}

__global__ void __launch_bounds__(512) k_route(const float* __restrict__ x, const float* __restrict__ g, const float* __restrict__ router, bf16_t* __restrict__ xnm,
                                               unsigned* __restrict__ ctl, unsigned char* __restrict__ tab) {
    __shared__ unsigned lcnt[NE], lbase[NE];
    __shared__ int se[64][2], ss[64][2]; __shared__ float sg[64][2];
    const int wave = threadIdx.x >> 6, lane = threadIdx.x & 63;
    if (threadIdx.x < NE) lcnt[threadIdx.x] = 0u;
    __syncthreads();
    for (int it = 0; it < 8; ++it) {
        const int lt = wave * 8 + it, tkn = blockIdx.x * 64 + lt;
        const float* xr = x + (size_t)tkn * D;
        float v[16]; float s = 0.f;
#pragma unroll
        for (int j = 0; j < 16; ++j) { v[j] = xr[lane + 64 * j]; s += v[j] * v[j]; }
        const float rs = rsqrtf(wave_sum(s) * (1.f / D) + EPS);
        float lg[NE];
#pragma unroll
        for (int e = 0; e < NE; ++e) lg[e] = 0.f;
#pragma unroll
        for (int j = 0; j < 16; ++j) {
            const float hv = v[j] * rs * g[lane + 64 * j];
            xnm[(size_t)tkn * D + lane + 64 * j] = f2bf(hv);
#pragma unroll
            for (int e = 0; e < NE; ++e) lg[e] += hv * router[(size_t)(lane + 64 * j) * NE + e];
        }
#pragma unroll
        for (int e = 0; e < NE; ++e) lg[e] = wave_sum(lg[e]);
        int e0 = 0; float v0 = lg[0];
#pragma unroll
        for (int e = 1; e < NE; ++e) if (lg[e] > v0) { v0 = lg[e]; e0 = e; }
        int e1 = -1; float v1 = -INFINITY;
#pragma unroll
        for (int e = 0; e < NE; ++e) if (e != e0 && lg[e] > v1) { v1 = lg[e]; e1 = e; }
        const float p1 = __expf(v1 - v0), g0 = 1.f / (1.f + p1), g1 = p1 / (1.f + p1);
        if (lane == 0) { se[lt][0] = e0; se[lt][1] = e1; sg[lt][0] = g0; sg[lt][1] = g1; ss[lt][0] = (int)atomicAdd(&lcnt[e0], 1u); ss[lt][1] = (int)atomicAdd(&lcnt[e1], 1u); }
    }
    __syncthreads();
    if (threadIdx.x < NE) lbase[threadIdx.x] = atomicAdd(&ctl[CW_CNT + 64 * threadIdx.x], lcnt[threadIdx.x]);
    __syncthreads();
    if (threadIdx.x < 64) {
        const int lt = threadIdx.x, tkn = blockIdx.x * 64 + lt;
        int* ltok = (int*)(tab + TAB_LTOK); float* lgate = (float*)(tab + TAB_LGATE); int* tsel = (int*)(tab + TAB_TSEL);
#pragma unroll
        for (int k = 0; k < 2; ++k) { const int e = se[lt][k], slot = (int)lbase[e] + ss[lt][k]; ltok[e * T + slot] = tkn; lgate[e * T + slot] = sg[lt][k]; tsel[tkn * 4 + 2 * k] = e; tsel[tkn * 4 + 2 * k + 1] = slot; }
    }
}

__global__ void __launch_bounds__(256) k_final(const float* x3, const bf16_t* __restrict__ yp0, const bf16_t* __restrict__ yp1, const unsigned* __restrict__ ctl,
                                               const unsigned char* __restrict__ tab, const float* __restrict__ g, float* out) {
    const int tkn = blockIdx.x * 4 + (threadIdx.x >> 6), lane = threadIdx.x & 63;
    const int* tsel = (const int*)(tab + TAB_TSEL);
    size_t row[2];
#pragma unroll
    for (int k = 0; k < 2; ++k) {
        const int e = tsel[tkn * 4 + 2 * k], slot = tsel[tkn * 4 + 2 * k + 1];
        int tb = 0;
        for (int i = 0; i < e; ++i) tb += ((int)ctl[CW_CNT + 64 * i] + 255) >> 8;
        row[k] = (size_t)tb * 256 + slot;
    }
    float v[16]; float s = 0.f;
#pragma unroll
    for (int j = 0; j < 16; ++j) {
        const int c = lane + 64 * j;
        v[j] = x3[(size_t)tkn * D + c] + bf2f(yp0[row[0] * D + c]) + bf2f(yp1[row[0] * D + c]) + bf2f(yp0[row[1] * D + c]) + bf2f(yp1[row[1] * D + c]);
        s += v[j] * v[j];
    }
    const float rs = rsqrtf(wave_sum(s) * (1.f / D) + EPS);
#pragma unroll
    for (int j = 0; j < 16; ++j) out[(size_t)tkn * D + lane + 64 * j] = v[j] * rs * g[lane + 64 * j];
}


namespace pg8 {
#define PG8_LAS __attribute__((address_space(3)))
typedef short bf16x8 __attribute__((ext_vector_type(8)));
typedef float f32x4 __attribute__((ext_vector_type(4)));
typedef unsigned u32x4 __attribute__((ext_vector_type(4)));
typedef int i32x4 __attribute__((ext_vector_type(4)));
constexpr int MAXU = 32;
constexpr int MAXRSU = 8;
constexpr int BM = 256, BK = 64, HALF = 128, HTB = HALF * BK * 2  , STAGE_BYTES = 8 * HTB, NXCD = 8, WGM = 8;
__host__ __device__ __forceinline__ int lds_byte(int r, int c) { const int st = (r >> 4) * 2 + (c >> 5), rr = r & 15, cc = c & 31, ob = rr * 64 + cc * 2; return st * 1024 + (ob ^ (((ob >> 9) & 1) << 5)); }
__host__ __device__ __forceinline__ void stage_rc(int b, int& R, int& C) { const int st = b / 1024, sb = b % 1024, swz = sb ^ (((sb >> 9) & 1) << 5); R = (st >> 1) * 16 + swz / 64; C = (st & 1) * 32 + (swz % 64) / 2; }
__host__ __device__ __forceinline__ int perm32(int rho) { const int n = rho >> 4, i = rho & 15; return 8 * (i >> 2) + 4 * n + (i & 3); }

struct Unit { int pm, pn, be, s0, ko; };
struct Gemm { const void* A; const void* Bt; int lda, ldb, K; size_t bgroup; int sclA, sclB, sclB1; };

struct StaticOrder {
    int nM, nN, nwg, G, c;
    __device__ void init(int nM_, int nN_, int G_, int c_) { nM = nM_; nN = nN_; nwg = nM * nN; G = G_; c = c_; }
    __device__ bool next(int i, Unit& u) const {
        const long L = (long)i * G + c; if (L >= nwg) return false;
        int wgid = (int)L; { const int q = nwg / NXCD, r = nwg % NXCD, xcd = wgid % NXCD, off = wgid / NXCD; wgid = (xcd < r ? xcd * (q + 1) : r * (q + 1) + (xcd - r) * q) + off; }
        const int nig = WGM * nN, gid = wgid / nig, fm = gid * WGM, gsz = (nM - fm) < WGM ? (nM - fm) : WGM;
        u.pm = fm + ((wgid % nig) % gsz); u.pn = (wgid % nig) / gsz; u.be = 0; u.s0 = 0; u.ko = 0; return true;
    }
};
struct MoeOrder {
    StaticOrder so; int tlo, nNr, kper; unsigned tbp0, tbp1;
    __device__ void init(const unsigned* cnt, int tlo_, int thi_, int nN, int ksplit, int kper_, int G, int c) {
        int t = 0; tbp0 = 0u; tbp1 = 0u;
#pragma unroll
        for (int e = 0; e < NE; ++e) { if (e < 4) tbp0 |= (unsigned)t << (8 * e); else tbp1 |= (unsigned)t << (8 * (e - 4));
            t += ((int)__hip_atomic_load(cnt + 64 * e, __ATOMIC_RELAXED, __HIP_MEMORY_SCOPE_AGENT) + 255) >> 8; }
        tlo = tlo_; nNr = nN; kper = kper_; const int hi = thi_ < t ? thi_ : t; so.init(hi > tlo_ ? hi - tlo_ : 0, nN * ksplit, G, c);
    }
    __device__ bool next(int i, Unit& u) const {
        if (!so.next(i, u)) return false;
        const int tile = tlo + u.pm; int e = 0, tbe = 0;
#pragma unroll
        for (int k = 1; k < NE; ++k) { const int tk = (int)(((k < 4 ? tbp0 : tbp1) >> (8 * (k & 3))) & 0xffu); if (tile >= tk) { e = k; tbe = tk; } }
        u.be = e; u.s0 = (tile - tbe) * 256; const int kh = u.pn / nNr; u.pn -= kh * nNr; u.ko = kh * kper; return true;
    }
};
struct ARowIdent {
    __device__ __forceinline__ unsigned direct(const Unit& u, int r) const { return (unsigned)(u.pm * BM + r); }
    __device__ __forceinline__ void prefetch(const Unit&, PG8_LAS unsigned*) const {}
    __device__ __forceinline__ unsigned get(const Unit& u, int r, const PG8_LAS unsigned*) const { return (unsigned)(u.pm * BM + r); }
};
struct ARowMoe {
    const int* ltok; const unsigned* cnt;
    __device__ __forceinline__ unsigned direct(const Unit& u, int r) const {
        const int slot = u.s0 + r, n = (int)__hip_atomic_load(cnt + 64 * u.be, __ATOMIC_RELAXED, __HIP_MEMORY_SCOPE_AGENT);
        return slot < n ? (unsigned)ltok[u.be * T + slot] : 0u;
    }
    __device__ __forceinline__ void prefetch(const Unit& u, PG8_LAS unsigned* tab) const { if (threadIdx.x < BM) tab[threadIdx.x] = direct(u, (int)threadIdx.x); }
    __device__ __forceinline__ unsigned get(const Unit&, int r, const PG8_LAS unsigned* tab) const { return tab[r]; }
};

__device__ __forceinline__ unsigned cvt_pk_bf16(float lo, float hi) { unsigned r; asm volatile("v_cvt_pk_bf16_f32 %0, %1, %2" : "=v"(r) : "v"(lo), "v"(hi)); return r; }
struct EpiBf16 {
    static constexpr bool PERM = true, HAS_RS = false;
    bf16_t* O; int ldc;
    __device__ __forceinline__ void operator()(const f32x4 (&acc)[2][2][4][2], const Unit& u, int wr, int wc, int fr, int fq, const PG8_LAS float* rst) const {
        const int row0 = u.pm * BM + wr * 64 + fr, col0 = u.pn * BM + wc * 32 + 8 * fq;
#pragma unroll
        for (int ai = 0; ai < 2; ++ai)
#pragma unroll
            for (int m = 0; m < 4; ++m) { bf16_t* rowp = O + (size_t)(row0 + ai * HALF + m * 16) * ldc + col0;
#pragma unroll
                for (int bj = 0; bj < 2; ++bj) { const f32x4 v0 = acc[ai][bj][m][0], v1 = acc[ai][bj][m][1];
                    u32x4 w; w.x = cvt_pk_bf16(v0[0], v0[1]); w.y = cvt_pk_bf16(v0[2], v0[3]); w.z = cvt_pk_bf16(v1[0], v1[1]); w.w = cvt_pk_bf16(v1[2], v1[3]);
                    *(u32x4*)(rowp + bj * HALF) = w; } }
    }
};
struct EpiRes {
    static constexpr bool PERM = false, HAS_RS = false;
    const float* base; float* out; int ldc;
    __device__ __forceinline__ void operator()(const f32x4 (&acc)[2][2][4][2], const Unit& u, int wr, int wc, int fr, int fq, const PG8_LAS float* rst) const {
        const int row0 = u.pm * BM + wr * 64 + fr, col0 = u.pn * BM + wc * 32 + 4 * fq;
#pragma unroll
        for (int ai = 0; ai < 2; ++ai) {
            f32x4 b[4][2][2];
#pragma unroll
            for (int m = 0; m < 4; ++m) { const size_t off = (size_t)(row0 + ai * HALF + m * 16) * ldc + col0;
#pragma unroll
                for (int bj = 0; bj < 2; ++bj)
#pragma unroll
                    for (int n = 0; n < 2; ++n) b[m][bj][n] = *(const f32x4*)(base + off + bj * HALF + n * 16); }
            asm volatile("" ::: "memory");
#pragma unroll
            for (int m = 0; m < 4; ++m) { const size_t off = (size_t)(row0 + ai * HALF + m * 16) * ldc + col0;
#pragma unroll
                for (int bj = 0; bj < 2; ++bj)
#pragma unroll
                    for (int n = 0; n < 2; ++n) *(f32x4*)(out + off + bj * HALF + n * 16) = b[m][bj][n] + acc[ai][bj][m][n]; }
            asm volatile("" ::: "memory");
        }
    }
};
__device__ __forceinline__ float silu_f(float v) { return v * __builtin_amdgcn_rcpf(1.f + __expf(-v)); }
typedef float f32x2 __attribute__((ext_vector_type(2)));
__device__ __forceinline__ f32x2 swiglu2(f32x2 g2, f32x2 up) {
    f32x2 e; e.x = __builtin_amdgcn_exp2f(-g2.x); e.y = __builtin_amdgcn_exp2f(-g2.y);
    const f32x2 d = e + 1.0f; f32x2 r; r.x = __builtin_amdgcn_rcpf(d.x); r.y = __builtin_amdgcn_rcpf(d.y);
    return (g2 * up) * r;
}
struct EpiSwiglu {
    static constexpr bool PERM = true, HAS_RS = false;
    bf16_t* O; int ldc;
    __device__ __forceinline__ void operator()(const f32x4 (&acc)[2][2][4][2], const Unit& u, int wr, int wc, int fr, int fq, const PG8_LAS float* rst) const {
        const int row0 = u.pm * BM + wr * 64 + fr, col0 = u.pn * HALF + wc * 32 + 8 * fq;
#pragma unroll
        for (int ai = 0; ai < 2; ++ai)
#pragma unroll
            for (int m = 0; m < 4; ++m) { bf16_t* rowp = O + (size_t)(row0 + ai * HALF + m * 16) * ldc + col0;
                const f32x4 g0 = acc[ai][0][m][0], g1 = acc[ai][0][m][1], u0 = acc[ai][1][m][0], u1 = acc[ai][1][m][1];
                const f32x2 a = swiglu2((f32x2){g0[0], g0[1]}, (f32x2){u0[0], u0[1]}), b = swiglu2((f32x2){g0[2], g0[3]}, (f32x2){u0[2], u0[3]});
                const f32x2 c = swiglu2((f32x2){g1[0], g1[1]}, (f32x2){u1[0], u1[1]}), d = swiglu2((f32x2){g1[2], g1[3]}, (f32x2){u1[2], u1[3]});
                u32x4 w; w.x = cvt_pk_bf16(a.x, a.y); w.y = cvt_pk_bf16(b.x, b.y); w.z = cvt_pk_bf16(c.x, c.y); w.w = cvt_pk_bf16(d.x, d.y);
                *(u32x4*)rowp = w; }
    }
};
__device__ __forceinline__ float clamp448(float v) { return __builtin_amdgcn_fmed3f(v, -448.f, 448.f); }
__device__ __forceinline__ unsigned pk4_fp8(float a, float b, float c, float d) { unsigned w = 0u; w = __builtin_amdgcn_cvt_pk_fp8_f32(clamp448(a), clamp448(b), w, false); w = __builtin_amdgcn_cvt_pk_fp8_f32(clamp448(c), clamp448(d), w, true); return w; }
struct EpiSwiglu8 {
    static constexpr bool PERM = true, HAS_RS = false;
    unsigned char* O; int ldc;
    __device__ __forceinline__ void operator()(const f32x4 (&acc)[2][2][4][2], const Unit& u, int wr, int wc, int fr, int fq, const PG8_LAS float* rst) const {
        const int row0 = u.pm * BM + wr * 64 + fr, col0 = u.pn * HALF + wc * 32 + 8 * fq;
#pragma unroll
        for (int ai = 0; ai < 2; ++ai)
#pragma unroll
            for (int m = 0; m < 4; ++m) { unsigned char* rowp = O + (size_t)(row0 + ai * HALF + m * 16) * ldc + col0;
                const f32x4 g0 = acc[ai][0][m][0], g1 = acc[ai][0][m][1], u0 = acc[ai][1][m][0], u1 = acc[ai][1][m][1];
                const f32x2 a = swiglu2((f32x2){g0[0], g0[1]}, (f32x2){u0[0], u0[1]}), b = swiglu2((f32x2){g0[2], g0[3]}, (f32x2){u0[2], u0[3]});
                const f32x2 c = swiglu2((f32x2){g1[0], g1[1]}, (f32x2){u1[0], u1[1]}), d = swiglu2((f32x2){g1[2], g1[3]}, (f32x2){u1[2], u1[3]});
                typedef unsigned u32x2 __attribute__((ext_vector_type(2)));
                u32x2 w; w.x = pk4_fp8(a.x, a.y, b.x, b.y); w.y = pk4_fp8(c.x, c.y, d.x, d.y);
                *(u32x2*)rowp = w; }
    }
};
struct EpiMoeDn {
    static constexpr bool PERM = true, HAS_RS = true;
    bf16_t* O0; bf16_t* O1; const float* lgate; const unsigned* cnt; int tlo;
    __device__ __forceinline__ float rowscale(const Unit& u, int r) const { const int slot = u.s0 + r, n = (int)__hip_atomic_load(cnt + 64 * u.be, __ATOMIC_RELAXED, __HIP_MEMORY_SCOPE_AGENT); return slot < n ? lgate[u.be * T + slot] : 0.f; }
    __device__ __forceinline__ void operator()(const f32x4 (&acc)[2][2][4][2], const Unit& u, int wr, int wc, int fr, int fq, const PG8_LAS float* rst) const {
        const int r0 = wr * 64 + fr, col0 = u.pn * BM + wc * 32 + 8 * fq;
#pragma unroll
        for (int ai = 0; ai < 2; ++ai)
#pragma unroll
            for (int m = 0; m < 4; ++m) { const int r = r0 + ai * HALF + m * 16; const float gt = rst[r];
                bf16_t* rowp = (u.ko ? O1 : O0) + (size_t)((tlo + u.pm) * BM + r) * D + col0;
#pragma unroll
                for (int bj = 0; bj < 2; ++bj) { const f32x4 v0 = acc[ai][bj][m][0] * gt, v1 = acc[ai][bj][m][1] * gt;
                    u32x4 w; w.x = cvt_pk_bf16(v0[0], v0[1]); w.y = cvt_pk_bf16(v0[2], v0[3]); w.z = cvt_pk_bf16(v1[0], v1[1]); w.w = cvt_pk_bf16(v1[2], v1[3]);
                    *(u32x4*)(rowp + bj * HALF) = w; } }
    }
};

template <class Epi, class Sched, class ARow, bool ALIGN_EPI, bool F8 = false>
__device__ __forceinline__ void gemm_phase(PG8_LAS unsigned char* lds, PG8_LAS unsigned* rowtab, const Gemm g, const Sched& S, const ARow& AR, const Epi& E, int probe = 0) {
    PG8_LAS int* utab = (PG8_LAS int*)(rowtab + 256);
    { const int i_ = (int)threadIdx.x; if (i_ < MAXU) { Unit u_; const bool ok_ = S.next(i_, u_); utab[i_ * 8 + 0] = ok_ ? u_.pm : -1; utab[i_ * 8 + 1] = u_.pn; utab[i_ * 8 + 2] = u_.be; utab[i_ * 8 + 3] = u_.s0; utab[i_ * 8 + 4] = u_.ko; } }
    __syncthreads();
    PG8_LAS float* rstab = (PG8_LAS float*)(utab + MAXU * 8);
    if constexpr (Epi::HAS_RS) {
        for (int idx = (int)threadIdx.x; idx < MAXRSU * BM; idx += 512) { const int e8_ = (idx >> 8) * 8; if (utab[e8_] >= 0) { Unit u_; u_.pm = utab[e8_]; u_.pn = utab[e8_ + 1]; u_.be = utab[e8_ + 2]; u_.s0 = utab[e8_ + 3]; u_.ko = utab[e8_ + 4]; rstab[idx] = E.rowscale(u_, idx & 255); } }
        __syncthreads(); }
#define PG8_NEXT(i, u) ([&]() { const int i2_ = (i); if (i2_ >= MAXU) return false; const i32x4 v_ = *(const PG8_LAS i32x4*)(utab + i2_ * 8); u.pm = __builtin_amdgcn_readfirstlane(v_[0]); u.pn = __builtin_amdgcn_readfirstlane(v_[1]); u.be = __builtin_amdgcn_readfirstlane(v_[2]); u.s0 = __builtin_amdgcn_readfirstlane(v_[3]); u.ko = __builtin_amdgcn_readfirstlane(utab[i2_ * 8 + 4]); return u.pm >= 0; })()
    const int tid = threadIdx.x, wid = __builtin_amdgcn_readfirstlane(tid >> 6), lane = tid & 63, wr = wid >> 2, wc = wid & 3, fr = lane & 15, fq = lane >> 4;
    constexpr int ESZ = F8 ? 1 : 2;
    const int nt = g.K * ESZ / (BK * 2);
    int Rr[2]; unsigned Cb[2], voffB[2];
#pragma unroll
    for (int i = 0; i < 2; ++i) { int R, C; stage_rc(tid * 16 + i * 8192, R, C); const int Rb = Epi::PERM ? ((R & ~31) + perm32(R & 31)) : R;
        Rr[i] = R; Cb[i] = (unsigned)C * 2u; voffB[i] = (unsigned)(Rb * g.ldb * ESZ + C * 2); }
    const size_t kstep = (size_t)(BK * 2);
    const size_t hstepB = (size_t)HALF * g.ldb * ESZ;
    const unsigned lda2 = (unsigned)g.lda * ESZ;
    const unsigned ldsw = (unsigned)wid * 1024u;
    const int aoff = lds_byte(wr * 64 + fr, fq * 8), boff = lds_byte(wc * 32 + fr, fq * 8);
#define PG8_SA(b, h) (((b) * 2 + (h)) * HTB)
#define PG8_SB(b, h) ((4 + (b) * 2 + (h)) * HTB)
#define PG8_STAGE(bufoff, gbase, voff) do { _Pragma("unroll") for (int _i = 0; _i < 2; ++_i) \
        __builtin_amdgcn_global_load_lds((const unsigned*)((const char*)(gbase) + (voff)[_i]), (PG8_LAS unsigned*)(lds + (bufoff) + ldsw + _i * 8192), 16, 0, 0); } while (0)
#define PG8_LDA(dst, b, h) do { _Pragma("unroll") for (int m = 0; m < 4; ++m) _Pragma("unroll") for (int k = 0; k < 2; ++k) dst[m][k] = *(const PG8_LAS bf16x8*)(lds + PG8_SA(b, h) + aoff + m * 2048 + k * 1024); } while (0)
#define PG8_LDB(dst, b, h) do { _Pragma("unroll") for (int n = 0; n < 2; ++n) _Pragma("unroll") for (int k = 0; k < 2; ++k) dst[n][k] = *(const PG8_LAS bf16x8*)(lds + PG8_SB(b, h) + boff + n * 2048 + k * 1024); } while (0)
#define PG8_CAT(x) __builtin_shufflevector(__builtin_bit_cast(i32x4, x[0]), __builtin_bit_cast(i32x4, x[1]), 0, 1, 2, 3, 4, 5, 6, 7)
#define PG8_MMA(ai, bj, At, Bt) do { __builtin_amdgcn_s_setprio(1); _Pragma("unroll") for (int m = 0; m < 4; ++m) _Pragma("unroll") for (int n = 0; n < 2; ++n) { \
        if constexpr (F8) acc[ai][bj][m][n] = __builtin_amdgcn_mfma_scale_f32_16x16x128_f8f6f4(PG8_CAT(Bt[n]), PG8_CAT(At[m]), acc[ai][bj][m][n], 0, 0, 0, (bj) == 0 ? g.sclB : g.sclB1, 0, g.sclA); \
        else { _Pragma("unroll") for (int k = 0; k < 2; ++k) acc[ai][bj][m][n] = __builtin_amdgcn_mfma_f32_16x16x32_bf16(Bt[n][k], At[m][k], acc[ai][bj][m][n], 0, 0, 0); } } \
        __builtin_amdgcn_s_setprio(0); } while (0)
#define PG8_WAIT_V(n) asm volatile("s_waitcnt vmcnt(" #n ")" ::: "memory")
#define PG8_WAIT_L(n) asm volatile("s_waitcnt lgkmcnt(" #n ")" ::: "memory")
#define PG8_BAR __builtin_amdgcn_s_barrier()
#define PG8_SCHED __builtin_amdgcn_sched_barrier(0)
    Unit cur, nxt; int ui = 0;
    if (!PG8_NEXT(0, cur)) return;
    f32x4 acc[2][2][4][2];
#pragma unroll
    for (int a = 0; a < 2; ++a)
#pragma unroll
        for (int b = 0; b < 2; ++b)
#pragma unroll
            for (int m = 0; m < 4; ++m)
#pragma unroll
                for (int n = 0; n < 2; ++n) acc[a][b][m][n] = (f32x4){0.f, 0.f, 0.f, 0.f};
    bf16x8 At[4][2], B0[2][2], B1[2][2];
    unsigned offC[2][2];
#pragma unroll
    for (int h = 0; h < 2; ++h)
#pragma unroll
        for (int i = 0; i < 2; ++i) offC[h][i] = AR.direct(cur, h * HALF + Rr[i]) * lda2 + Cb[i];
    const char* cA = (const char*)g.A + (size_t)cur.ko * ESZ;
    const char* cB = (const char*)g.Bt + ((size_t)cur.be * g.bgroup + (size_t)cur.pn * BM * g.ldb + cur.ko) * ESZ;
    PG8_STAGE(PG8_SB(0, 0), cB, voffB); PG8_STAGE(PG8_SB(0, 1), cB + hstepB, voffB); PG8_STAGE(PG8_SA(0, 0), cA, offC[0]); PG8_STAGE(PG8_SA(0, 1), cA, offC[1]);
    if (wr == 1) PG8_BAR;
    PG8_WAIT_V(2); PG8_BAR;
    PG8_STAGE(PG8_SB(1, 0), cB + kstep, voffB); PG8_STAGE(PG8_SA(1, 0), cA + kstep, offC[0]); PG8_STAGE(PG8_SB(1, 1), cB + hstepB + kstep, voffB);
    PG8_WAIT_V(6); PG8_BAR;
    for (;;) {
        const bool has_next = PG8_NEXT(ui + 1, nxt);
        if (has_next) AR.prefetch(nxt, rowtab);
        const char* nA = has_next ? (const char*)g.A + (size_t)nxt.ko * ESZ : cA;
        const char* nB = has_next ? (const char*)g.Bt + ((size_t)nxt.be * g.bgroup + (size_t)nxt.pn * BM * g.ldb + nxt.ko) * ESZ : cB;
        for (int t = 0; t < nt; t += 2) {
            const bool last = (t == nt - 2);
            const char* a1 = cA + (size_t)(t + 1) * kstep;
            const char* a2 = last ? nA : cA + (size_t)(t + 2) * kstep; const char* b2 = last ? nB : cB + (size_t)(t + 2) * kstep;
            const char* a3 = a2 + kstep; const char* b3 = b2 + kstep;
            PG8_LDB(B0, 0, 0); PG8_LDB(B1, 0, 1); PG8_SCHED; PG8_LDA(At, 0, 0); PG8_STAGE(PG8_SA(1, 1), a1, offC[1]);
            if (last && has_next) {
#pragma unroll
                for (int h = 0; h < 2; ++h)
#pragma unroll
                    for (int i = 0; i < 2; ++i) offC[h][i] = AR.get(nxt, h * HALF + Rr[i], rowtab) * lda2 + Cb[i]; }
            PG8_WAIT_V(8); PG8_WAIT_L(0); PG8_BAR; PG8_MMA(0, 0, At, B0); PG8_MMA(0, 1, At, B1); PG8_BAR; PG8_SCHED;
            PG8_LDA(At, 0, 1); PG8_STAGE(PG8_SB(0, 0), b2, voffB); PG8_STAGE(PG8_SB(0, 1), b2 + hstepB, voffB); PG8_STAGE(PG8_SA(0, 0), a2, offC[0]);
            PG8_WAIT_V(8); PG8_WAIT_L(0); PG8_BAR; PG8_MMA(1, 0, At, B0); PG8_MMA(1, 1, At, B1); PG8_BAR; PG8_SCHED;
            PG8_LDB(B0, 1, 0); PG8_LDB(B1, 1, 1); PG8_SCHED; PG8_LDA(At, 1, 0); PG8_STAGE(PG8_SA(0, 1), a2, offC[1]);
            PG8_WAIT_V(8); PG8_WAIT_L(0); PG8_BAR; PG8_MMA(0, 0, At, B0); PG8_MMA(0, 1, At, B1); PG8_BAR; PG8_SCHED;
            PG8_LDA(At, 1, 1); PG8_STAGE(PG8_SB(1, 0), b3, voffB); PG8_STAGE(PG8_SB(1, 1), b3 + hstepB, voffB); PG8_STAGE(PG8_SA(1, 0), a3, offC[0]);
            PG8_WAIT_V(8); PG8_WAIT_L(0); PG8_BAR; PG8_MMA(1, 0, At, B0); PG8_MMA(1, 1, At, B1); PG8_BAR; PG8_SCHED;
        }
        if constexpr (ALIGN_EPI) { if (wr == 0) PG8_BAR; }
        if (!(probe & 1)) E(acc, cur, wr, wc, fr, fq, rstab + (ui < MAXRSU ? ui : 0) * BM);
        if (!has_next) break;
#pragma unroll
        for (int a = 0; a < 2; ++a)
#pragma unroll
            for (int b = 0; b < 2; ++b)
#pragma unroll
                for (int m = 0; m < 4; ++m)
#pragma unroll
                    for (int n = 0; n < 2; ++n) acc[a][b][m][n] = (f32x4){0.f, 0.f, 0.f, 0.f};
        cur = nxt; cA = nA; cB = nB; ++ui;
        if constexpr (ALIGN_EPI) { if (wr == 1) PG8_BAR; }
    }
    PG8_WAIT_V(0);
    if constexpr (!ALIGN_EPI) { if (wr == 0) PG8_BAR; }
    PG8_BAR;
#undef PG8_SA
#undef PG8_SB
#undef PG8_STAGE
#undef PG8_LDA
#undef PG8_LDB
#undef PG8_MMA
#undef PG8_NEXT
#undef PG8_CAT
#undef PG8_WAIT_V
#undef PG8_WAIT_L
#undef PG8_BAR
#undef PG8_SCHED
}
}


namespace att {
typedef float f32x16 __attribute__((ext_vector_type(16)));
typedef float f32x4 __attribute__((ext_vector_type(4)));
typedef short bf16x8 __attribute__((ext_vector_type(8)));
typedef short s16x4 __attribute__((ext_vector_type(4)));
typedef unsigned u32x4 __attribute__((ext_vector_type(4)));
#define ATT_LAS __attribute__((address_space(3)))
constexpr int KBUF = 13312, VBUF = 8192, L_K0 = 0, L_V0 = 2 * KBUF, L_SCR = L_V0 + 2 * VBUF, L_OST = L_SCR + 8 * 256, L_END = L_OST + 8 * 4096,
              SWA_KBUF = 64 * 144, SWA_K0 = L_END, SWA_V0 = SWA_K0 + 3 * SWA_KBUF, SWA_END = SWA_V0 + 3 * VBUF;
constexpr float LOG2E = 1.4426950408889634f;
__device__ __forceinline__ s16x4 trread(const ATT_LAS char* p) { return __builtin_bit_cast(s16x4, __builtin_amdgcn_ds_read_tr16_b64_v4i16((ATT_LAS s16x4*)p)); }
__device__ __forceinline__ unsigned cvtpk(float lo, float hi) { unsigned r; asm volatile("v_cvt_pk_bf16_f32 %0, %1, %2" : "=v"(r) : "v"(lo), "v"(hi)); return r; }
#define ATT_PACK8(P, B) __builtin_bit_cast(bf16x8, (u32x4){cvtpk(P[(B) + 0], P[(B) + 1]), cvtpk(P[(B) + 2], P[(B) + 3]), cvtpk(P[(B) + 4], P[(B) + 5]), cvtpk(P[(B) + 6], P[(B) + 7])})
__device__ __forceinline__ bf16x8 vfrag(const ATT_LAS char* vp) { const s16x4 lo = trread(vp), hi = trread(vp + 8 * 64); return (bf16x8){lo[0], lo[1], lo[2], lo[3], hi[0], hi[1], hi[2], hi[3]}; }

template <int NS, int KSTR, bool ALIBI>
__device__ __forceinline__ void tile(const ATT_LAS char* Kb, const ATT_LAS char* Vb, const bf16x8 (&qf)[NS], f32x16 (&o)[2], float& m, float& l, ATT_LAS float* scr, float c0, float slope2, float dq, int lane) {
    const int r32 = lane & 31, h = lane >> 5;
    f32x16 p0, p1;
#pragma unroll
    for (int i = 0; i < 16; ++i) { p0[i] = 0.f; p1[i] = 0.f; }
    const ATT_LAS char* ka = Kb + r32 * KSTR + h * 16;
#pragma unroll
    for (int s2 = 0; s2 < NS; ++s2) {
        const bf16x8 a0 = *(const ATT_LAS bf16x8*)(ka + s2 * 32), a1 = *(const ATT_LAS bf16x8*)(ka + 32 * KSTR + s2 * 32);
        p0 = __builtin_amdgcn_mfma_f32_32x32x16_bf16(a0, qf[s2], p0, 0, 0, 0);
        p1 = __builtin_amdgcn_mfma_f32_32x32x16_bf16(a1, qf[s2], p1, 0, 0, 0);
    }
    float mx = -INFINITY;
    if (ALIBI) {
#pragma unroll
        for (int i = 0; i < 16; ++i) { const float kr = (float)((i & 3) + 8 * (i >> 2));
            const float v0 = p0[i] * c0 - slope2 * fabsf(dq - kr), v1 = p1[i] * c0 - slope2 * fabsf(dq - 32.f - kr);
            p0[i] = v0; p1[i] = v1; mx = fmaxf(mx, fmaxf(v0, v1)); }
    } else {
#pragma unroll
        for (int i = 0; i < 16; ++i) mx = __builtin_fmaxf(__builtin_fmaxf(mx, p0[i]), p1[i]);
        mx *= c0;
    }
    mx = fmaxf(mx, __shfl_xor(mx, 32));
    if (__any(mx > m + 8.f)) {
        const float mn = fmaxf(m, mx), alpha = __builtin_amdgcn_exp2f(m - mn); m = mn; l *= alpha;
        if (h == 0) scr[r32] = alpha;
#pragma unroll
        for (int g = 0; g < 4; ++g) { const f32x4 a4 = *(const ATT_LAS f32x4*)(scr + 8 * g + 4 * h);
#pragma unroll
            for (int j = 0; j < 4; ++j) { o[0][4 * g + j] *= a4[j]; o[1][4 * g + j] *= a4[j]; } }
    }
    float ps = 0.f;
    if (ALIBI) {
#pragma unroll
        for (int i = 0; i < 16; ++i) { p0[i] = __builtin_amdgcn_exp2f(p0[i] - m); p1[i] = __builtin_amdgcn_exp2f(p1[i] - m); ps += p0[i] + p1[i]; }
    } else {
        const float nm = -m;
#pragma unroll
        for (int i = 0; i < 16; ++i) { p0[i] = __builtin_amdgcn_exp2f(__builtin_fmaf(p0[i], c0, nm)); p1[i] = __builtin_amdgcn_exp2f(__builtin_fmaf(p1[i], c0, nm)); ps += p0[i] + p1[i]; }
    }
    l += ps;
    const int i16 = lane & 15, g1 = (lane >> 4) & 1;
    const ATT_LAS char* vb = Vb + (4 * h + (i16 >> 2)) * 64 + (16 * g1 + 4 * (i16 & 3)) * 2;
    {   const bf16x8 A = ATT_PACK8(p0, 0);
        o[0] = __builtin_amdgcn_mfma_f32_32x32x16_bf16(A, vfrag(vb + 0 * 64), o[0], 0, 0, 0);
        o[1] = __builtin_amdgcn_mfma_f32_32x32x16_bf16(A, vfrag(vb + 4096 + 0 * 64), o[1], 0, 0, 0); }
    {   const bf16x8 A = ATT_PACK8(p0, 8);
        o[0] = __builtin_amdgcn_mfma_f32_32x32x16_bf16(A, vfrag(vb + 16 * 64), o[0], 0, 0, 0);
        o[1] = __builtin_amdgcn_mfma_f32_32x32x16_bf16(A, vfrag(vb + 4096 + 16 * 64), o[1], 0, 0, 0); }
    {   const bf16x8 A = ATT_PACK8(p1, 0);
        o[0] = __builtin_amdgcn_mfma_f32_32x32x16_bf16(A, vfrag(vb + 32 * 64), o[0], 0, 0, 0);
        o[1] = __builtin_amdgcn_mfma_f32_32x32x16_bf16(A, vfrag(vb + 4096 + 32 * 64), o[1], 0, 0, 0); }
    {   const bf16x8 A = ATT_PACK8(p1, 8);
        o[0] = __builtin_amdgcn_mfma_f32_32x32x16_bf16(A, vfrag(vb + 48 * 64), o[0], 0, 0, 0);
        o[1] = __builtin_amdgcn_mfma_f32_32x32x16_bf16(A, vfrag(vb + 4096 + 48 * 64), o[1], 0, 0, 0); }
}
__device__ __forceinline__ void finish(f32x16 (&o)[2], float l, ATT_LAS float* scr, ATT_LAS bf16_t* stg, bf16_t* O, int tok0, int lane) {
    const int r32 = lane & 31, h = lane >> 5;
    const float lt = l + __shfl_xor(l, 32);
    if (h == 0) scr[r32] = 1.f / lt;
#pragma unroll
    for (int g = 0; g < 4; ++g) { const f32x4 a4 = *(const ATT_LAS f32x4*)(scr + 8 * g + 4 * h);
#pragma unroll
        for (int j = 0; j < 4; ++j) { const int q = 8 * g + 4 * h + j;
            stg[q * 64 + r32] = f2bf(o[0][4 * g + j] * a4[j]); stg[q * 64 + 32 + r32] = f2bf(o[1][4 * g + j] * a4[j]); } }
#pragma unroll
    for (int it = 0; it < 4; ++it) { const int row = it * 8 + (lane >> 3), ch = lane & 7;
        const u32x4 v = *(const ATT_LAS u32x4*)(stg + row * 64 + ch * 8);
        *(u32x4*)(O + (size_t)(tok0 + row) * 1024 + ch * 8) = v; }
}

struct Cv8Ptrs { const float* wg; const float* wu; const float* wd; unsigned char* dgu; unsigned char* ddn; };
struct Cv8 { float r[16]; int id; };
__device__ __forceinline__ void cv8_decode(const Cv8Ptrs& cp, int id, int lane, const float*& src, size_t& stride2, unsigned char*& dst, float& mul) {
    const int it = id >> 1, hf = id & 1, e = it / 5376, q = it % 5376, which = q / 1792, item = q % 1792, nl = lane & 31, kh = lane >> 5;
    if (which < 2) { const int k0 = 64 * (item / 112) + 32 * hf, n = 32 * (item % 112) + nl;
        src = (which == 0 ? cp.wg : cp.wu) + (size_t)e * D * FF + (size_t)(k0 + kh) * FF + n; stride2 = (size_t)2 * FF;
        dst = cp.dgu + (size_t)e * 2 * FF * D + (size_t)(256 * (n >> 7) + 128 * which + (n & 127)) * D + k0 + 16 * kh; mul = which == 0 ? 128.f * 1.4426950408889634f : 128.f * 0.6931471805599453f;
    } else { const int k0 = 64 * (item / 32) + 32 * hf, n = 32 * (item % 32) + nl;
        src = cp.wd + (size_t)e * FF * D + (size_t)(k0 + kh) * D + n; stride2 = (size_t)2 * D;
        dst = cp.ddn + (size_t)e * D * FF + (size_t)n * FF + k0 + 16 * kh; mul = 256.f; }
}
__device__ __forceinline__ void cv8_issue(const Cv8Ptrs& cp, Cv8& cs, int id, int lane) {
    const float* src; size_t st2; unsigned char* dst; float mul; cv8_decode(cp, id, lane, src, st2, dst, mul);
#pragma unroll
    for (int i = 0; i < 16; ++i) cs.r[i] = src[(size_t)i * st2];
    cs.id = id;
}
__device__ __forceinline__ void cv8_finish(const Cv8Ptrs& cp, Cv8& cs, int lane) {
    const float* src; size_t st2; unsigned char* dst; float mul; cv8_decode(cp, cs.id, lane, src, st2, dst, mul);
    unsigned w[4];
#pragma unroll
    for (int i = 0; i < 8; i += 2) {
        const auto s0 = __builtin_amdgcn_permlane32_swap(__float_as_uint(cs.r[i]), __float_as_uint(cs.r[8 + i]), false, false);
        const auto s1 = __builtin_amdgcn_permlane32_swap(__float_as_uint(cs.r[i + 1]), __float_as_uint(cs.r[9 + i]), false, false);
        unsigned v = 0u;
        v = __builtin_amdgcn_cvt_pk_fp8_f32(__uint_as_float(s0[0]) * mul, __uint_as_float(s0[1]) * mul, v, false);
        v = __builtin_amdgcn_cvt_pk_fp8_f32(__uint_as_float(s1[0]) * mul, __uint_as_float(s1[1]) * mul, v, true);
        w[i >> 1] = v; }
    *(u32x4*)dst = (u32x4){w[0], w[1], w[2], w[3]};
    cs.id = -1;
}
#define CV8_FINISH() do { if (cs.id >= 0) cv8_finish(cp, cs, lane); } while (0)
#define CV8_ISSUE() do { if (cnext < cend) { cv8_issue(cp, cs, cnext, lane); cnext += cstride; } } while (0)

__device__ __forceinline__ void mla_unit(ATT_LAS char* sm, const bf16_t* QM, const bf16_t* KVM, const bf16_t* KROPE, const float* ropecs, bf16_t* YMIX, int b, int hd, int qb, const Cv8Ptrs& cp, Cv8& cs, int& cnext, int cstride, int cend) {
    const int tid = threadIdx.x, lane = tid & 63, wave = __builtin_amdgcn_readfirstlane(tid >> 6), r32 = lane & 31, h = lane >> 5;
    const int q0 = 256 * qb, NT = 4 * qb + 4, cw = 4 * qb + (wave >> 1);
    const int tokw = b * SEQ + q0 + 32 * wave;
    ATT_LAS float* scr = (ATT_LAS float*)(sm + L_SCR + wave * 256);
    const size_t kvoff = (size_t)(b * SEQ + (tid >> 3)) * 1024 + hd * 128 + (tid & 7) * 8;
    const size_t kroff = (size_t)(b * SEQ + (tid >> 2)) * 32 + (tid & 3) * 8;
    const int kdst = (tid >> 3) * 208 + (tid & 7) * 16, krdst = (tid >> 2) * 208 + 128 + (tid & 3) * 16, vdst = ((tid & 7) >> 2) * 4096 + (tid >> 3) * 64 + (tid & 3) * 16;
    u32x4 knA, krA = (u32x4){0u, 0u, 0u, 0u}, vvA, knB, krB = (u32x4){0u, 0u, 0u, 0u}, vvB;
#define MLA_GLOAD(t, S) do { kn##S = *(const u32x4*)(KVM + kvoff + (size_t)(t) * 64 * 1024); vv##S = *(const u32x4*)(KVM + kvoff + (size_t)(t) * 64 * 1024 + 64); \
        if (tid < 256) kr##S = *(const u32x4*)(KROPE + kroff + (size_t)(t) * 64 * 32); } while (0)
#define MLA_LWRITE(bufi, S) do { *(ATT_LAS u32x4*)(sm + L_K0 + (bufi) * KBUF + kdst) = kn##S; if (tid < 256) *(ATT_LAS u32x4*)(sm + L_K0 + (bufi) * KBUF + krdst) = kr##S; \
        *(ATT_LAS u32x4*)(sm + L_V0 + (bufi) * VBUF + vdst) = vv##S; } while (0)
    MLA_GLOAD(0, A); MLA_GLOAD(1, B);
    bf16x8 qf[6];
    const bf16_t* qp = QM + (size_t)(tokw + r32) * 768 + hd * 96 + 8 * h;
#pragma unroll
    for (int s2 = 0; s2 < 6; ++s2) qf[s2] = *(const bf16x8*)(qp + 16 * s2);
    {   const float* cs = ropecs + (size_t)(tokw + r32) * 32 + 8 * h;
        const f32x4 c0 = *(const f32x4*)cs, c1 = *(const f32x4*)(cs + 4), s0 = *(const f32x4*)(cs + 16), s1 = *(const f32x4*)(cs + 20);
        float t1[8], t2[8];
#pragma unroll
        for (int j = 0; j < 8; ++j) { t1[j] = bf2f((bf16_t)qf[4][j]); t2[j] = bf2f((bf16_t)qf[5][j]); }
#pragma unroll
        for (int j = 0; j < 8; ++j) { const float c = j < 4 ? c0[j & 3] : c1[j & 3], sn = j < 4 ? s0[j & 3] : s1[j & 3];
            qf[4][j] = (short)f2bf(t1[j] * c - t2[j] * sn); qf[5][j] = (short)f2bf(t2[j] * c + t1[j] * sn); } }
    f32x16 o[2];
#pragma unroll
    for (int i = 0; i < 16; ++i) { o[0][i] = 0.f; o[1][i] = 0.f; }
    float m = -1e30f, l = 0.f;
    MLA_LWRITE(0, A);
    MLA_GLOAD(2, A);
    __syncthreads();
    for (int t = 0; t < NT; t += 2) {
        CV8_FINISH();
        MLA_LWRITE(1, B);
        if (t + 3 < NT) MLA_GLOAD(t + 3, B);
        CV8_ISSUE();
        if (t <= cw) tile<6, 208, false>(sm + L_K0, sm + L_V0, qf, o, m, l, scr, 0.10206207261596577f * LOG2E, 0.f, 0.f, lane);
        __syncthreads();
        CV8_FINISH();
        if (t + 2 < NT) MLA_LWRITE(0, A);
        if (t + 4 < NT) MLA_GLOAD(t + 4, A);
        CV8_ISSUE();
        if (t + 1 <= cw) tile<6, 208, false>(sm + L_K0 + KBUF, sm + L_V0 + VBUF, qf, o, m, l, scr, 0.10206207261596577f * LOG2E, 0.f, 0.f, lane);
        __syncthreads();
    }
    finish(o, l, scr, (ATT_LAS bf16_t*)(sm + L_OST + wave * 4096), YMIX + 512 + hd * 64, tokw, lane);
#undef MLA_GLOAD
#undef MLA_LWRITE
}
__device__ __forceinline__ void swa_unit(ATT_LAS char* sm, const bf16_t* PROJ0, const float* sinks, bf16_t* YMIX, int b, int n, int hk, const Cv8Ptrs& cp, Cv8& cs, int& cnext, int cstride, int cend) {
    const int tid = threadIdx.x, lane = tid & 63, wave = __builtin_amdgcn_readfirstlane(tid >> 6), r32 = lane & 31, h = lane >> 5;
    const int head = hk * 4 + (wave >> 1), qi0 = 32 * (wave & 1), tokw = b * SEQ + 64 * n + qi0;
    ATT_LAS float* scr = (ATT_LAS float*)(sm + L_SCR + wave * 256);
    const int t_lo = n >= 2 ? 0 : 2 - n;
    const size_t koff = (size_t)(b * SEQ + (tid >> 3)) * EVEN_INP + P0_KA + hk * 64 + (tid & 7) * 8;
    const int kdst = (tid >> 3) * 144 + (tid & 7) * 16, vdst = ((tid & 7) >> 2) * 4096 + (tid >> 3) * 64 + (tid & 3) * 16;
    u32x4 kn[3], vv[3];
#pragma unroll
    for (int t = 0; t < 3; ++t) if (t >= t_lo) { const size_t o_ = koff + (size_t)(n - 2 + t) * 64 * EVEN_INP; kn[t] = *(const u32x4*)(PROJ0 + o_); vv[t] = *(const u32x4*)(PROJ0 + o_ + (P0_VA - P0_KA)); }
    bf16x8 qf[4];
    const bf16_t* qp = PROJ0 + (size_t)(tokw + r32) * EVEN_INP + P0_QA + head * 64 + 8 * h;
#pragma unroll
    for (int s2 = 0; s2 < 4; ++s2) qf[s2] = *(const bf16x8*)(qp + 16 * s2);
    f32x16 o[2];
#pragma unroll
    for (int i = 0; i < 16; ++i) { o[0][i] = 0.f; o[1][i] = 0.f; }
    float m = sinks[head] * LOG2E, l = h == 0 ? 1.f : 0.f;
    const float slope2 = exp2f(-(float)(head + 1)) * LOG2E;
    __syncthreads();
#pragma unroll
    for (int t = 0; t < 3; ++t) if (t >= t_lo) { *(ATT_LAS u32x4*)(sm + SWA_K0 + t * SWA_KBUF + kdst) = kn[t]; *(ATT_LAS u32x4*)(sm + SWA_V0 + t * VBUF + vdst) = vv[t]; }
    __syncthreads();
    for (int t = t_lo; t < 3; ++t) { CV8_FINISH(); CV8_ISSUE();
        tile<4, 144, true>(sm + SWA_K0 + t * SWA_KBUF, sm + SWA_V0 + t * VBUF, qf, o, m, l, scr, 0.125f * LOG2E, slope2, (float)(qi0 + r32 + 128 - 64 * t - 4 * h), lane); }
    finish(o, l, scr, (ATT_LAS bf16_t*)(sm + L_OST + wave * 4096), YMIX + head * 64, tokw, lane);
}
}


namespace ret {
using att::f32x16; using att::f32x4; using att::bf16x8; using att::s16x4; using att::u32x4; using att::trread; using att::cvtpk; using att::vfrag;
__device__ __forceinline__ bf16x8 nfrag(const ATT_LAS char* p) { const s16x4 lo = trread(p), hi = trread(p + 4 * 64); return (bf16x8){lo[0], lo[1], lo[2], lo[3], hi[0], hi[1], hi[2], hi[3]}; }
__device__ __forceinline__ float log2g(int hh) { return log2f(1.f - exp2f(-5.f - (float)hh)); }

__device__ __forceinline__ void ret1_unit(ATT_LAS char* sm, const bf16_t* PROJ1, bf16_t* RKV, int u) {
    const int tid = threadIdx.x, lane = tid & 63, wave = __builtin_amdgcn_readfirstlane(tid >> 6), r32 = lane & 31, h = lane >> 5, i16 = lane & 15, g1 = (lane >> 4) & 1;
    const int b = u >> 7, hh = (u >> 5) & 3, n = u & 31;
    const float lg = log2g(hh);
    __syncthreads();
#pragma unroll
    for (int k = 0; k < 2; ++k) {
        const int c = tid + 512 * k, t = c >> 4, ch = c & 15;
        const bf16_t* src = PROJ1 + (size_t)(b * SEQ + 64 * n + t) * ODD_IN + hh * 128 + ch * 8;
        const u32x4 kv = *(const u32x4*)(src + P1_K), vv = *(const u32x4*)(src + P1_V);
        const float fac = 0.08838834764831845f * exp2f(lg * (float)(63 - t));
        u32x4 ks;
#pragma unroll
        for (int j = 0; j < 4; ++j) { const unsigned w = kv[j]; ks[j] = cvtpk(__uint_as_float(w << 16) * fac, __uint_as_float(w & 0xffff0000u) * fac); }
        const int dst = (ch >> 2) * 4096 + t * 64 + (ch & 3) * 16;
        *(ATT_LAS u32x4*)(sm + dst) = ks; *(ATT_LAS u32x4*)(sm + 16384 + dst) = vv;
    }
    __syncthreads();
    const int dkb = wave >> 1, dvb = 2 * (wave & 1);
    f32x16 acc[2];
#pragma unroll
    for (int i = 0; i < 16; ++i) { acc[0][i] = 0.f; acc[1][i] = 0.f; }
    const int fo = (8 * h + (i16 >> 2)) * 64 + (16 * g1 + 4 * (i16 & 3)) * 2;
#pragma unroll
    for (int s2 = 0; s2 < 4; ++s2) {
        const bf16x8 A = nfrag(sm + dkb * 4096 + s2 * 16 * 64 + fo);
        acc[0] = __builtin_amdgcn_mfma_f32_32x32x16_bf16(A, nfrag(sm + 16384 + dvb * 4096 + s2 * 16 * 64 + fo), acc[0], 0, 0, 0);
        acc[1] = __builtin_amdgcn_mfma_f32_32x32x16_bf16(A, nfrag(sm + 16384 + (dvb + 1) * 4096 + s2 * 16 * 64 + fo), acc[1], 0, 0, 0);
    }
    bf16_t* dst = RKV + (size_t)u * 16384 + 32 * dvb + r32;
#pragma unroll
    for (int i = 0; i < 16; ++i) { const int dk = 32 * dkb + (i & 3) + 8 * (i >> 2) + 4 * h; dst[dk * 128] = f2bf(acc[0][i]); dst[dk * 128 + 32] = f2bf(acc[1][i]); }
}
__device__ __forceinline__ void ret2_elems(bf16_t* RKV, int gt, int NGT) {
    for (int e = gt; e < BATCH * 4 * 4096; e += NGT) {
        const int bh = e >> 12, el = (e & 4095) * 4;
        const float cd = exp2f(64.f * log2g(bh & 3));
        float st[4] = {0.f, 0.f, 0.f, 0.f};
        unsigned long long* p = (unsigned long long*)(RKV + (size_t)bh * 32 * 16384 + el);
#pragma unroll 8
        for (int n = 0; n < 32; ++n) {
            const unsigned long long x = p[(size_t)n * 4096];
            p[(size_t)n * 4096] = (unsigned long long)cvtpk(st[0], st[1]) | ((unsigned long long)cvtpk(st[2], st[3]) << 32);
            st[0] = cd * st[0] + __uint_as_float((unsigned)x << 16); st[1] = cd * st[1] + __uint_as_float((unsigned)x & 0xffff0000u);
            st[2] = cd * st[2] + __uint_as_float((unsigned)(x >> 32) << 16); st[3] = cd * st[3] + __uint_as_float((unsigned)(x >> 32) & 0xffff0000u);
        }
    }
}
__device__ __forceinline__ void ret12_item(ATT_LAS char* sm, const bf16_t* PROJ1, bf16_t* RKV, int item) {
    const int tid = threadIdx.x, lane = tid & 63, wave = __builtin_amdgcn_readfirstlane(tid >> 6), r32 = lane & 31, h = lane >> 5, i16 = lane & 15, g1 = (lane >> 4) & 1;
    const int bh = item >> 2, dq = item & 3, b = bh >> 2, hh = bh & 3;
    const float lg = log2g(hh), cd = exp2f(64.f * lg);
    const bool loader = wave >= 4; const int lt = tid & 255;
    const int t0 = lt >> 4, ch = lt & 15;
    const bf16_t* ksrc = PROJ1 + (size_t)(b * SEQ + t0) * ODD_IN + P1_K + hh * 128 + ch * 8;
    const bf16_t* vsrc = PROJ1 + (size_t)(b * SEQ + (lt >> 2)) * ODD_IN + P1_V + hh * 128 + 32 * dq + (lt & 3) * 8;
    const int kdst = (ch >> 2) * 4096 + t0 * 64 + (ch & 3) * 16, vdst = 16384 + (lt >> 2) * 64 + (lt & 3) * 16;
    float fk[4];
#pragma unroll
    for (int k = 0; k < 4; ++k) fk[k] = 0.08838834764831845f * exp2f(lg * (float)(63 - t0 - 16 * k));
    u32x4 kA[4], vA, kB[4], vB, kC[4], vC;
#define R12_LOAD(n, S) do { const size_t o_ = (size_t)(n) * 64 * ODD_IN; _Pragma("unroll") for (int k = 0; k < 4; ++k) k##S[k] = *(const u32x4*)(ksrc + o_ + (size_t)(16 * k) * ODD_IN); v##S = *(const u32x4*)(vsrc + o_); } while (0)
#define R12_SCALE(x, f) (u32x4){cvtpk(__uint_as_float((x)[0] << 16) * (f), __uint_as_float((x)[0] & 0xffff0000u) * (f)), cvtpk(__uint_as_float((x)[1] << 16) * (f), __uint_as_float((x)[1] & 0xffff0000u) * (f)), \
                                cvtpk(__uint_as_float((x)[2] << 16) * (f), __uint_as_float((x)[2] & 0xffff0000u) * (f)), cvtpk(__uint_as_float((x)[3] << 16) * (f), __uint_as_float((x)[3] & 0xffff0000u) * (f))}
    f32x16 acc;
#pragma unroll
    for (int i = 0; i < 16; ++i) acc[i] = 0.f;
    const int fo = (8 * h + (i16 >> 2)) * 64 + (16 * g1 + 4 * (i16 & 3)) * 2;
#define R12_STEP(n, S) do { \
        __syncthreads(); \
        if (loader) { _Pragma("unroll") for (int k = 0; k < 4; ++k) *(ATT_LAS u32x4*)(sm + kdst + 16 * k * 64) = R12_SCALE(k##S[k], fk[k]); *(ATT_LAS u32x4*)(sm + vdst) = v##S; \
                      R12_LOAD(((n) + 3 < 32 ? (n) + 3 : 31), S); } \
        __syncthreads(); \
        if (!loader) { \
            bf16_t* dst_ = RKV + ((size_t)bh * 32 + (n)) * 16384 + 32 * dq + r32; \
            _Pragma("unroll") for (int i = 0; i < 16; ++i) { dst_[(32 * wave + (i & 3) + 8 * (i >> 2) + 4 * h) * 128] = f2bf(acc[i]); acc[i] *= cd; } \
            _Pragma("unroll") for (int s2 = 0; s2 < 4; ++s2) acc = __builtin_amdgcn_mfma_f32_32x32x16_bf16(nfrag(sm + wave * 4096 + s2 * 16 * 64 + fo), nfrag(sm + 16384 + s2 * 16 * 64 + fo), acc, 0, 0, 0); } } while (0)
    if (loader) { R12_LOAD(0, A); R12_LOAD(1, B); R12_LOAD(2, C); }
    for (int n = 0; n < 30; n += 3) { R12_STEP(n, A); R12_STEP(n + 1, B); R12_STEP(n + 2, C); }
    R12_STEP(30, A); R12_STEP(31, B);
    __syncthreads();
#undef R12_LOAD
#undef R12_SCALE
#undef R12_STEP
}
constexpr int R3_Q = 0, R3_K = 17408, R3_V = 34816, R3_R = 51200, R3_O = 83968, R3_END = R3_O + 64 * 132 * 4;
__device__ __forceinline__ void ret3_unit(ATT_LAS char* sm, const bf16_t* PROJ1, const bf16_t* RKV, const float* gn, bf16_t* YMIX, int u) {
    const int tid = threadIdx.x, lane = tid & 63, wave = __builtin_amdgcn_readfirstlane(tid >> 6), r32 = lane & 31, h = lane >> 5, i16 = lane & 15, g1 = (lane >> 4) & 1;
    const int b = u >> 7, hh = (u >> 5) & 3, n = u & 31, tok0 = b * SEQ + 64 * n;
    const float lg = log2g(hh);
    __syncthreads();
#pragma unroll
    for (int k = 0; k < 2; ++k) {
        const int c = tid + 512 * k, t = c >> 4, ch = c & 15;
        const bf16_t* src = PROJ1 + (size_t)(tok0 + t) * ODD_IN + hh * 128 + ch * 8;
        *(ATT_LAS u32x4*)(sm + R3_Q + t * 272 + ch * 16) = *(const u32x4*)(src + P1_Q);
        *(ATT_LAS u32x4*)(sm + R3_K + t * 272 + ch * 16) = *(const u32x4*)(src + P1_K);
        *(ATT_LAS u32x4*)(sm + R3_V + (ch >> 2) * 4096 + t * 64 + (ch & 3) * 16) = *(const u32x4*)(src + P1_V);
    }
#pragma unroll
    for (int k = 0; k < 4; ++k) {
        const int c = tid + 512 * k, d = c >> 4, ch = c & 15;
        *(ATT_LAS u32x4*)(sm + R3_R + (ch >> 2) * 8192 + d * 64 + (ch & 3) * 16) = *(const u32x4*)(RKV + (size_t)u * 16384 + d * 128 + ch * 8);
    }
    __syncthreads();
    const int qb = wave >> 2, dvb = wave & 3;
    bf16x8 qf[8];
#pragma unroll
    for (int s2 = 0; s2 < 8; ++s2) qf[s2] = *(const ATT_LAS bf16x8*)(sm + R3_Q + (32 * qb + r32) * 272 + s2 * 32 + h * 16);
    f32x16 acc, accx;
#pragma unroll
    for (int i = 0; i < 16; ++i) { acc[i] = 0.f; accx[i] = 0.f; }
    const int fv = (4 * h + (i16 >> 2)) * 64 + (16 * g1 + 4 * (i16 & 3)) * 2;
    for (int kb = 0; kb <= qb; ++kb) {
        f32x16 p;
#pragma unroll
        for (int i = 0; i < 16; ++i) p[i] = 0.f;
#pragma unroll
        for (int s2 = 0; s2 < 8; ++s2) { const bf16x8 a = *(const ATT_LAS bf16x8*)(sm + R3_K + (32 * kb + r32) * 272 + s2 * 32 + h * 16); p = __builtin_amdgcn_mfma_f32_32x32x16_bf16(a, qf[s2], p, 0, 0, 0); }
        const int q = 32 * qb + r32;
#pragma unroll
        for (int i = 0; i < 16; ++i) { const int key = 32 * kb + (i & 3) + 8 * (i >> 2) + 4 * h, df = q - key; p[i] = df >= 0 ? p[i] * 0.08838834764831845f * exp2f(lg * (float)df) : 0.f; }
        { const bf16x8 A = ATT_PACK8(p, 0); acc = __builtin_amdgcn_mfma_f32_32x32x16_bf16(A, vfrag(sm + R3_V + dvb * 4096 + (32 * kb) * 64 + fv), acc, 0, 0, 0); }
        { const bf16x8 A = ATT_PACK8(p, 8); acc = __builtin_amdgcn_mfma_f32_32x32x16_bf16(A, vfrag(sm + R3_V + dvb * 4096 + (32 * kb + 16) * 64 + fv), acc, 0, 0, 0); }
    }
    const int fn = (8 * h + (i16 >> 2)) * 64 + (16 * g1 + 4 * (i16 & 3)) * 2;
#pragma unroll
    for (int s2 = 0; s2 < 8; ++s2) accx = __builtin_amdgcn_mfma_f32_32x32x16_bf16(qf[s2], nfrag(sm + R3_R + dvb * 8192 + s2 * 16 * 64 + fn), accx, 0, 0, 0);
    ATT_LAS float* Os = (ATT_LAS float*)(sm + R3_O);
#pragma unroll
    for (int i = 0; i < 16; ++i) { const int q = 32 * qb + (i & 3) + 8 * (i >> 2) + 4 * h; Os[q * 132 + 32 * dvb + r32] = acc[i] + accx[i] * exp2f(lg * (float)(q + 1)); }
    __syncthreads();
#pragma unroll
    for (int k = 0; k < 8; ++k) {
        const int q = 8 * wave + k, tkn = tok0 + q;
        const float a = Os[q * 132 + lane], c = Os[q * 132 + 64 + lane];
        const float mu = wave_sum(a + c) * (1.f / 128.f), da = a - mu, dc = c - mu;
        const float rs = rsqrtf(wave_sum(da * da + dc * dc) * (1.f / 128.f) + EPS);
        const bf16_t* gp = PROJ1 + (size_t)tkn * ODD_IN + P1_G + hh * 128;
        YMIX[(size_t)tkn * D + hh * 128 + lane] = f2bf(silu(bf2f(gp[lane])) * da * rs * gn[hh * 128 + lane]);
        YMIX[(size_t)tkn * D + hh * 128 + 64 + lane] = f2bf(silu(bf2f(gp[64 + lane])) * dc * rs * gn[hh * 128 + 64 + lane]);
    }
}
}

#define LAS __attribute__((address_space(3)))
#define GAS __attribute__((address_space(1)))
typedef unsigned v4u __attribute__((ext_vector_type(4)));
#define LDS_WAIT() asm volatile("s_waitcnt lgkmcnt(0)" ::: "memory")
__device__ __forceinline__ unsigned pk2(float lo, float hi) { return (unsigned)f2bf(lo) | ((unsigned)f2bf(hi) << 16); }
constexpr int NWAVES = 8, LDS_BYTES = 147456, RING_BYTES = 131072, MISC_OFF = RING_BYTES + 320, ROWTAB_OFF = RING_BYTES + 1024;
constexpr int CW_BAR = 4096;

#define XB_TMO      128
#define XB_XCNT(j)  (256  + 64 * (j))
#define XB_XSUB(j)  (1280 + 64 * (j))
#define XB_XGEN(j)  (2304 + 64 * (j))
#define XB_TOP      3328
#define XB_TOPGEN   3392
#define XCD_BAR_WORDS 3456
#define XB_SPIN_CAP (1u << 18)
__device__ __forceinline__ unsigned xb_ld(unsigned* p)              { return __hip_atomic_load(p, __ATOMIC_RELAXED, __HIP_MEMORY_SCOPE_AGENT); }
__device__ __forceinline__ unsigned xb_add(unsigned* p, unsigned v) { return __hip_atomic_fetch_add(p, v, __ATOMIC_RELAXED, __HIP_MEMORY_SCOPE_AGENT); }
__device__ __forceinline__ unsigned xb_xcc_id() { return (unsigned)__builtin_amdgcn_s_getreg((3 << 11) | 20) & 0xFu; }
#define XB_SPIN(cond, bar) do { unsigned _sp = 0; while (cond) { __builtin_amdgcn_s_sleep(1); \
    if ((++_sp & 255u) == 0u) { if (xb_ld(&(bar)[XB_TMO])) break; if (_sp > XB_SPIN_CAP) { atomicAdd(&(bar)[XB_TMO], 1u); break; } } } } while (0)
struct XcdBarrier {
    unsigned* bar; unsigned x;
    volatile LAS unsigned* st;
};
__device__ __forceinline__ XcdBarrier xcd_barrier_post(unsigned* bar, volatile LAS unsigned* st) {
    XcdBarrier b; b.bar = bar; b.x = xb_xcc_id(); b.st = st;
    if (threadIdx.x == 0) (void)xb_add(&bar[XB_XCNT(b.x)], 1u);
    return b;
}
__device__ __forceinline__ void xcd_barrier_complete(unsigned* bar, unsigned x, unsigned& nloc, unsigned& nx) {
    const unsigned G = gridDim.x * gridDim.y * gridDim.z;
    unsigned sum, cnt, mine, sp = 0u;
    for (;;) {
        sum = 0u; cnt = 0u; mine = 0u;
#pragma unroll
        for (unsigned j = 0; j < 16; ++j) { const unsigned c = xb_ld(&bar[XB_XCNT(j)]); sum += c; cnt += (c > 0u) ? 1u : 0u; mine = (j == x) ? c : mine; }
        if (sum == G) break;
        __builtin_amdgcn_s_sleep(1);
        if ((++sp & 255u) == 0u) { if (xb_ld(&bar[XB_TMO])) break; if (sp > XB_SPIN_CAP) { atomicAdd(&bar[XB_TMO], 1u); break; } }
    }
    nloc = mine > 0u ? mine : 1u; nx = cnt > 0u ? cnt : 1u;
}
__device__ __forceinline__ void xcd_barrier(const XcdBarrier& b) {
    asm volatile("s_waitcnt vmcnt(0)" ::: "memory");
    __syncthreads();
    if (threadIdx.x == 0) {
        unsigned* bar = b.bar;
        __builtin_amdgcn_s_waitcnt(0);
        unsigned nloc = b.st[0], nx = b.st[1];
        if (nloc == 0u) { xcd_barrier_complete(bar, b.x, nloc, nx); b.st[0] = nloc; b.st[1] = nx; }
        const unsigned old = xb_add(&bar[XB_XSUB(b.x)], 1u);
        const unsigned gen = old / nloc;
        if (old + 1u == (gen + 1u) * nloc) {
            __builtin_amdgcn_fence(__ATOMIC_RELEASE, "agent");
            asm volatile("s_waitcnt vmcnt(0)" ::: "memory");
            const unsigned og = xb_add(&bar[XB_TOP], 1u);
            const unsigned tg = og / nx;
            if (og + 1u == (tg + 1u) * nx) xb_add(&bar[XB_TOPGEN], 1u);
            else XB_SPIN(xb_ld(&bar[XB_TOPGEN]) == tg, bar);
            __builtin_amdgcn_fence(__ATOMIC_ACQUIRE, "agent");
            xb_add(&bar[XB_XGEN(b.x)], 1u);
            asm volatile("s_waitcnt vmcnt(0)" ::: "memory");
        } else {
            XB_SPIN(xb_ld(&bar[XB_XGEN(b.x)]) == gen, bar);
            __builtin_amdgcn_fence(__ATOMIC_ACQUIRE, "agent");
            asm volatile("s_waitcnt vmcnt(0)" ::: "memory");
        }
    }
    __syncthreads();
}

template <class RM>
__device__ __forceinline__ void p0_item(const float* W, int K, int N, bf16_t* WT, RM rm, LAS float* scr, int item, int lane, float mul = 1.f) {
    const int nblk = N / 32, kb = item / nblk, nb = item % nblk, k0 = 64 * kb, n0 = 32 * nb;
#pragma unroll
    for (int i = 0; i < 32; ++i) { const int kk = 2 * i + (lane >> 5); scr[kk * 33 + (lane & 31)] = W[(size_t)(k0 + kk) * N + n0 + (lane & 31)] * mul; }
    LDS_WAIT(); asm volatile("" ::: "memory");
    const int c = lane & 7;
#pragma unroll
    for (int j = 0; j < 4; ++j) { const int n = (lane >> 3) + 8 * j; const LAS float* sp = scr + (8 * c) * 33 + n;
        v4u o; o.x = pk2(sp[0 * 33], sp[1 * 33]); o.y = pk2(sp[2 * 33], sp[3 * 33]); o.z = pk2(sp[4 * 33], sp[5 * 33]); o.w = pk2(sp[6 * 33], sp[7 * 33]);
        *(v4u*)(WT + (size_t)rm(n0 + n) * K + k0 + 8 * c) = o; }
    LDS_WAIT(); asm volatile("" ::: "memory");
}
template <class RM>
__device__ __forceinline__ void p0_item8(const float* W, int K, int N, unsigned char* WT, RM rm, float scale, LAS float* scr, int item, int lane) {
    const int nblk = N / 32, kb = item / nblk, nb = item % nblk, k0 = 64 * kb, n0 = 32 * nb;
#pragma unroll
    for (int i = 0; i < 32; ++i) { const int kk = 2 * i + (lane >> 5); scr[kk * 33 + (lane & 31)] = W[(size_t)(k0 + kk) * N + n0 + (lane & 31)] * scale; }
    LDS_WAIT(); asm volatile("" ::: "memory");
    const int c = lane & 3;
#pragma unroll
    for (int j = 0; j < 2; ++j) { const int n = (lane >> 2) + 16 * j; const LAS float* sp = scr + (16 * c) * 33 + n;
        v4u o; o.x = pg8::pk4_fp8(sp[0 * 33], sp[1 * 33], sp[2 * 33], sp[3 * 33]); o.y = pg8::pk4_fp8(sp[4 * 33], sp[5 * 33], sp[6 * 33], sp[7 * 33]);
        o.z = pg8::pk4_fp8(sp[8 * 33], sp[9 * 33], sp[10 * 33], sp[11 * 33]); o.w = pg8::pk4_fp8(sp[12 * 33], sp[13 * 33], sp[14 * 33], sp[15 * 33]);
        *(v4u*)(WT + (size_t)rm(n0 + n) * K + k0 + 16 * c) = o; }
    LDS_WAIT(); asm volatile("" ::: "memory");
}
__device__ __forceinline__ void norm_rows(const float* x, const float* g, bf16_t* o, int gw, int NGW, int lane) {
    typedef float f32x4 __attribute__((ext_vector_type(4)));
    f32x4 gv[4];
#pragma unroll
    for (int j = 0; j < 4; ++j) gv[j] = *((const f32x4*)g + lane + 64 * j);
    for (int m = gw; m < T; m += NGW) {
        const f32x4* xr = (const f32x4*)(x + (size_t)m * D) + lane;
        f32x4 v[4]; float s = 0.f;
#pragma unroll
        for (int j = 0; j < 4; ++j) { v[j] = xr[64 * j]; s += (v[j].x * v[j].x + v[j].y * v[j].y) + (v[j].z * v[j].z + v[j].w * v[j].w); }
        const float rs = rsqrtf(wave_sum(s) * (1.f / D) + EPS);
        unsigned long long* o8 = (unsigned long long*)(o + (size_t)m * D) + lane;
#pragma unroll
        for (int j = 0; j < 4; ++j) o8[64 * j] = (unsigned long long)pk2(v[j].x * rs * gv[j].x, v[j].y * rs * gv[j].y) | ((unsigned long long)pk2(v[j].z * rs * gv[j].z, v[j].w * rs * gv[j].w) << 32);
    }
}
__device__ __forceinline__ void mla_prep_rows(const bf16_t* proj0, const float* qg, const float* kvg, const int* pos, bf16_t* cqn, bf16_t* ckvn, bf16_t* krope, float* ropecs, int gw, int NGW, int lane) {
    for (int tkn = gw; tkn < T; tkn += NGW) {
        const bf16_t* pr = proj0 + (size_t)tkn * EVEN_INP;
        float q[6], s = 0.f;
#pragma unroll
        for (int j = 0; j < 6; ++j) { q[j] = bf2f(pr[P0_CQ + lane + 64 * j]); s += q[j] * q[j]; }
        float rs = rsqrtf(wave_sum(s) * (1.f / 384.f) + EPS);
#pragma unroll
        for (int j = 0; j < 6; ++j) cqn[(size_t)tkn * 384 + lane + 64 * j] = f2bf(q[j] * rs * qg[lane + 64 * j]);
        float c[4]; s = 0.f;
#pragma unroll
        for (int j = 0; j < 4; ++j) { c[j] = bf2f(pr[P0_CKV + lane + 64 * j]); s += c[j] * c[j]; }
        rs = rsqrtf(wave_sum(s) * (1.f / 256.f) + EPS);
#pragma unroll
        for (int j = 0; j < 4; ++j) ckvn[(size_t)tkn * 256 + lane + 64 * j] = f2bf(c[j] * rs * kvg[lane + 64 * j]);
        if (lane < 16) {
            const float p = (float)pos[tkn];
            const float inv = powf(10000.f, -(float)(2 * lane) / 32.f);
            const float ang = p * inv, cs = cosf(ang), sn = sinf(ang);
            const float t1 = bf2f(pr[P0_KR + lane]), t2 = bf2f(pr[P0_KR + 16 + lane]);
            krope[(size_t)tkn * 32 + lane] = f2bf(t1 * cs - t2 * sn);
            krope[(size_t)tkn * 32 + 16 + lane] = f2bf(t2 * cs + t1 * sn);
            ropecs[(size_t)tkn * 32 + lane] = cs; ropecs[(size_t)tkn * 32 + 16 + lane] = sn;
        }
    }
}
__device__ __forceinline__ void swa_naive(const bf16_t* proj0, const float* sinks, bf16_t* ymix, int gt, int NGT) {
    for (int idx = gt; idx < T * 8; idx += NGT) {
        const int tkn = idx >> 3, h = idx & 7, hk = h >> 2;
        const int b = tkn / SEQ, sq = tkn % SEQ, n = sq / CHUNK, qi = sq % CHUNK;
        const float slope = exp2f(-(float)(h + 1));
        float q[64], o[64];
#pragma unroll
        for (int d = 0; d < 64; ++d) { q[d] = bf2f(proj0[(size_t)tkn * EVEN_INP + P0_QA + h * 64 + d]); o[d] = 0.f; }
        float m = sinks[h], l = 1.f;
        const int k_lo = (n - 2) * CHUNK, k_hi = (n + 1) * CHUNK;
        for (int kp = (k_lo < 0 ? 0 : k_lo); kp < k_hi; ++kp) {
            const bf16_t* kr = proj0 + (size_t)(b * SEQ + kp) * EVEN_INP + P0_KA + hk * 64;
            float sc = 0.f;
#pragma unroll
            for (int d = 0; d < 64; ++d) sc += q[d] * bf2f(kr[d]);
            const float dist = fabsf((float)(qi + 2 * CHUNK - (kp - k_lo)));
            sc = sc * 0.125f - slope * dist;
            const float mn = fmaxf(m, sc), f = __expf(m - mn), pz = __expf(sc - mn);
            l = l * f + pz; m = mn;
            const bf16_t* vr = kr + (P0_VA - P0_KA);
#pragma unroll
            for (int d = 0; d < 64; ++d) o[d] = o[d] * f + pz * bf2f(vr[d]);
        }
        const float il = 1.f / l;
#pragma unroll
        for (int d = 0; d < 64; ++d) ymix[(size_t)tkn * D + h * 64 + d] = f2bf(o[d] * il);
    }
}
__device__ __forceinline__ void mla_naive(const bf16_t* qm, const bf16_t* kvm, const bf16_t* krope, const int* pos, bf16_t* ymix, int gt, int NGT) {
    for (int idx = gt; idx < T * 8; idx += NGT) {
        const int tkn = idx >> 3, h = idx & 7;
        const int b = tkn / SEQ, sq = tkn % SEQ, c = sq / CHUNK;
        float q[96], o[64];
#pragma unroll
        for (int d = 0; d < 96; ++d) q[d] = bf2f(qm[(size_t)tkn * 768 + h * 96 + d]);
        { const float p = (float)pos[tkn];
#pragma unroll
          for (int i = 0; i < 16; ++i) { const float inv = powf(10000.f, -(float)(2 * i) / 32.f), ang = p * inv, cs = cosf(ang), sn = sinf(ang);
              const float t1 = q[64 + i], t2 = q[80 + i]; q[64 + i] = t1 * cs - t2 * sn; q[80 + i] = t2 * cs + t1 * sn; } }
#pragma unroll
        for (int d = 0; d < 64; ++d) o[d] = 0.f;
        float m = -1e30f, l = 0.f;
        const int nk = (c + 1) * CHUNK;
        for (int kp = 0; kp < nk; ++kp) {
            const bf16_t* kr = kvm + (size_t)(b * SEQ + kp) * 1024 + h * 128;
            const bf16_t* rr = krope + (size_t)(b * SEQ + kp) * 32;
            float sc = 0.f;
#pragma unroll
            for (int d = 0; d < 64; ++d) sc += q[d] * bf2f(kr[d]);
#pragma unroll
            for (int d = 0; d < 32; ++d) sc += q[64 + d] * bf2f(rr[d]);
            sc *= 0.10206207261596577f;
            const float mn = fmaxf(m, sc), f = __expf(m - mn), pz = __expf(sc - mn);
            l = l * f + pz; m = mn;
#pragma unroll
            for (int d = 0; d < 64; ++d) o[d] = o[d] * f + pz * bf2f(kr[64 + d]);
        }
        const float il = 1.f / l;
#pragma unroll
        for (int d = 0; d < 64; ++d) ymix[(size_t)tkn * D + 512 + h * 64 + d] = f2bf(o[d] * il);
    }
}
__device__ __forceinline__ void ret_naive(const bf16_t* proj1, float* yr, LAS float* sm, int bx, int G, int tid) {
    for (int bh = bx; bh < BATCH * 4; bh += G) {
        const int b = bh >> 2, h = bh & 3, dv = tid & 127;
        const float g = 1.f - exp2f(-5.f - (float)h);
        float S[128];
#pragma unroll
        for (int d = 0; d < 128; ++d) S[d] = 0.f;
        for (int sq = 0; sq < SEQ; ++sq) {
            const bf16_t* pr = proj1 + (size_t)(b * SEQ + sq) * ODD_IN;
            __syncthreads();
            if (tid < 128) { sm[dv] = bf2f(pr[P1_Q + h * 128 + dv]); sm[128 + dv] = bf2f(pr[P1_K + h * 128 + dv]) * 0.08838834764831845f; }
            __syncthreads();
            if (tid < 128) {
                const float v = bf2f(pr[P1_V + h * 128 + dv]); float o = 0.f;
#pragma unroll
                for (int d = 0; d < 128; ++d) { S[d] = g * S[d] + sm[128 + d] * v; o += sm[d] * S[d]; }
                yr[(size_t)(b * SEQ + sq) * 512 + h * 128 + dv] = o;
            }
        }
    }
}
__device__ __forceinline__ void ret_gn_rows(const float* yr, const bf16_t* proj1, const float* gn, bf16_t* ymix, int gw, int NGW, int lane) {
    for (int w = gw; w < T * 4; w += NGW) {
        const int tkn = w >> 2, h = w & 3;
        const float a = yr[(size_t)tkn * 512 + h * 128 + lane], c = yr[(size_t)tkn * 512 + h * 128 + 64 + lane];
        const float mu = wave_sum(a + c) * (1.f / 128.f);
        const float da = a - mu, dc = c - mu;
        const float rs = rsqrtf(wave_sum(da * da + dc * dc) * (1.f / 128.f) + EPS);
        const float g0 = bf2f(proj1[(size_t)tkn * ODD_IN + P1_G + h * 128 + lane]), g1 = bf2f(proj1[(size_t)tkn * ODD_IN + P1_G + h * 128 + 64 + lane]);
        ymix[(size_t)tkn * D + h * 128 + lane] = f2bf(silu(g0) * da * rs * gn[h * 128 + lane]);
        ymix[(size_t)tkn * D + h * 128 + 64 + lane] = f2bf(silu(g1) * dc * rs * gn[h * 128 + 64 + lane]);
    }
}
__device__ __forceinline__ void conv_elems(const bf16_t* proj1, const float* w, bf16_t* ymix, int gt, int NGT) {
    typedef float f32x4 __attribute__((ext_vector_type(4)));
    for (int i = gt; i < T * 64; i += NGT) {
        const int tkn = i >> 6, c8 = (i & 63) * 8, sq = tkn % SEQ;
        float y[8];
#pragma unroll
        for (int k = 0; k < 8; ++k) y[k] = 0.f;
#pragma unroll
        for (int j = 0; j < 3; ++j) {
            if (sq - 2 + j >= 0) {
                const bf16_t* pr = proj1 + (size_t)(tkn - 2 + j) * ODD_IN + c8;
                const v4u cv = *(const v4u*)(pr + P1_C), hv = *(const v4u*)(pr + P1_H);
                const f32x4 w0 = *(const f32x4*)(w + j * 512 + c8), w1 = *(const f32x4*)(w + j * 512 + c8 + 4);
#pragma unroll
                for (int k = 0; k < 4; ++k) { const float wl = k < 2 ? w0[2 * k] : w1[2 * k - 4], wh = k < 2 ? w0[2 * k + 1] : w1[2 * k - 3];
                    y[2 * k] += wl * __uint_as_float(cv[k] << 16) * __uint_as_float(hv[k] << 16);
                    y[2 * k + 1] += wh * __uint_as_float(cv[k] & 0xffff0000u) * __uint_as_float(hv[k] & 0xffff0000u); }
            }
        }
        const v4u bv = *(const v4u*)(proj1 + (size_t)tkn * ODD_IN + P1_B + c8);
        v4u o;
#pragma unroll
        for (int k = 0; k < 4; ++k) o[k] = pk2(__uint_as_float(bv[k] << 16) * y[2 * k], __uint_as_float(bv[k] & 0xffff0000u) * y[2 * k + 1]);
        *(v4u*)(ymix + (size_t)tkn * D + 512 + c8) = o;
    }
}
__device__ __forceinline__ void route_tokens(const float* x, const float* g, const float* router, unsigned char* xnm8, unsigned* ctl, unsigned char* tab, LAS unsigned* sm, int bx, int G, int tid) {
    typedef float f32x4 __attribute__((ext_vector_type(4)));
    const int wave = tid >> 6, lane = tid & 63;
    LAS unsigned* lcnt = sm; LAS unsigned* lbase = sm + 8; LAS int* se = (LAS int*)(sm + 16); LAS int* ss = (LAS int*)(sm + 16 + 128); LAS float* sg = (LAS float*)(sm + 16 + 256);
    for (int blk = bx; blk < T / 64; blk += G) {
        __syncthreads();
        if (tid < NE) lcnt[tid] = 0u;
        __syncthreads();
        for (int it = 0; it < 8; ++it) {
            const int lt = wave * 8 + it, tkn = blk * 64 + lt;
            const f32x4* xr = (const f32x4*)(x + (size_t)tkn * D) + lane;
            f32x4 v[4]; float s = 0.f;
#pragma unroll
            for (int j = 0; j < 4; ++j) { v[j] = xr[64 * j]; s += (v[j].x * v[j].x + v[j].y * v[j].y) + (v[j].z * v[j].z + v[j].w * v[j].w); }
            const float rs = rsqrtf(wave_sum(s) * (1.f / D) + EPS);
            float lg[NE];
#pragma unroll
            for (int e = 0; e < NE; ++e) lg[e] = 0.f;
#pragma unroll
            for (int j = 0; j < 4; ++j) {
                const f32x4 gv = *((const f32x4*)g + lane + 64 * j);
                const f32x4 hv = v[j] * rs * gv;
                *(unsigned*)(xnm8 + (size_t)tkn * D + 4 * lane + 256 * j) = pg8::pk4_fp8(hv.x * 4.f, hv.y * 4.f, hv.z * 4.f, hv.w * 4.f);
                const f32x4* rr = (const f32x4*)(router + (size_t)(4 * lane + 256 * j) * NE);
#pragma unroll
                for (int q = 0; q < 4; ++q) { const f32x4 r0 = rr[2 * q], r1 = rr[2 * q + 1]; const float hq = hv[q];
                    lg[0] += hq * r0.x; lg[1] += hq * r0.y; lg[2] += hq * r0.z; lg[3] += hq * r0.w; lg[4] += hq * r1.x; lg[5] += hq * r1.y; lg[6] += hq * r1.z; lg[7] += hq * r1.w; }
            }
#pragma unroll
            for (int e = 0; e < NE; ++e) lg[e] = wave_sum(lg[e]);
            int e0 = 0; float v0 = lg[0];
#pragma unroll
            for (int e = 1; e < NE; ++e) if (lg[e] > v0) { v0 = lg[e]; e0 = e; }
            int e1 = -1; float v1 = -INFINITY;
#pragma unroll
            for (int e = 0; e < NE; ++e) if (e != e0 && lg[e] > v1) { v1 = lg[e]; e1 = e; }
            const float p1 = __expf(v1 - v0), g0 = 1.f / (1.f + p1), g1 = p1 / (1.f + p1);
            if (lane == 0) { se[lt * 2] = e0; se[lt * 2 + 1] = e1; sg[lt * 2] = g0; sg[lt * 2 + 1] = g1; ss[lt * 2] = (int)__hip_atomic_fetch_add(&lcnt[e0], 1u, __ATOMIC_RELAXED, __HIP_MEMORY_SCOPE_WORKGROUP); ss[lt * 2 + 1] = (int)__hip_atomic_fetch_add(&lcnt[e1], 1u, __ATOMIC_RELAXED, __HIP_MEMORY_SCOPE_WORKGROUP); }
        }
        __syncthreads();
        if (tid < NE) lbase[tid] = __hip_atomic_fetch_add(&ctl[CW_CNT + 64 * tid], lcnt[tid], __ATOMIC_RELAXED, __HIP_MEMORY_SCOPE_AGENT);
        __syncthreads();
        if (tid < 64) {
            const int lt = tid, tkn = blk * 64 + lt;
            int* ltok = (int*)(tab + TAB_LTOK); float* lgate = (float*)(tab + TAB_LGATE); int* tsel = (int*)(tab + TAB_TSEL);
#pragma unroll
            for (int k = 0; k < 2; ++k) { const int e = se[lt * 2 + k], slot = (int)lbase[e] + ss[lt * 2 + k]; ltok[e * T + slot] = tkn; lgate[e * T + slot] = sg[lt * 2 + k]; tsel[tkn * 4 + 2 * k] = e; tsel[tkn * 4 + 2 * k + 1] = slot; }
        }
    }
}
__device__ __forceinline__ void final_rows(const float* x3, const bf16_t* yp0, const bf16_t* yp1, const unsigned* cnt, const unsigned char* tab, const float* g, float* out, int gw, int NGW, int lane) {
    const int* tsel = (const int*)(tab + TAB_TSEL);
    int tb[NE]; { int t = 0;
#pragma unroll
      for (int e = 0; e < NE; ++e) { tb[e] = t; t += ((int)__hip_atomic_load(cnt + 64 * e, __ATOMIC_RELAXED, __HIP_MEMORY_SCOPE_AGENT) + 255) >> 8; } }
    for (int tkn = gw; tkn < T; tkn += NGW) {
        size_t row[2];
#pragma unroll
        for (int k = 0; k < 2; ++k) { const int e = tsel[tkn * 4 + 2 * k], slot = tsel[tkn * 4 + 2 * k + 1]; int tbe = 0;
#pragma unroll
            for (int i = 0; i < NE; ++i) tbe = (i == e) ? tb[i] : tbe;
            row[k] = (size_t)tbe * 256 + slot; }
        float v[16]; float s = 0.f;
#pragma unroll
        for (int j = 0; j < 16; ++j) { const int c = lane + 64 * j;
            v[j] = x3[(size_t)tkn * D + c] + bf2f(yp0[row[0] * D + c]) + bf2f(yp1[row[0] * D + c]) + bf2f(yp0[row[1] * D + c]) + bf2f(yp1[row[1] * D + c]);
            s += v[j] * v[j]; }
        const float rs = rsqrtf(wave_sum(s) * (1.f / D) + EPS);
#pragma unroll
        for (int j = 0; j < 16; ++j) out[(size_t)tkn * D + lane + 64 * j] = v[j] * rs * g[lane + 64 * j];
    }
}

#ifndef MK_ONE_LAUNCH
#define MK_ONE_LAUNCH 1
#endif
#ifndef PROBE_DUP
#define PROBE_DUP -1
#endif
#ifndef PROBE_MODE
#define PROBE_MODE 0
#endif
constexpr int NPHASE = 19;
#ifndef OFF_IPW1
#define OFF_IPW1 10
#endif
#ifndef OFF_IPW2
#define OFF_IPW2 10
#endif
constexpr int OFF_ITEMS = 128 * NWAVES * (OFF_IPW1 + OFF_IPW2);
enum Phase { PH_P0 = 0, PH_G1, PH_MP, PH_G2, PH_ATT, PH_G3, PH_N2, PH_G4, PH_G5, PH_N3, PH_G6, PH_RET1, PH_RET2, PH_RET3, PH_G7, PH_ROUTE, PH_G8, PH_G9, PH_FINAL };
struct Args { const float* in[25]; float* out; unsigned char* ws; int ph_lo, ph_hi, probe, pad; };
static_assert(sizeof(Args) == 25 * 8 + 8 + 8 + 16, "Args has no padding");
enum In { I_X = 0, I_POS, I_ENORM_MIX, I_EW_IN, I_ESINKS, I_EQ_NORM, I_EW_UQ, I_EKV_NORM, I_EW_UKV, I_EW_OUT, I_ENORM_FFN, I_EW_GATE, I_EW_UP, I_EW_DOWN,
          I_ONORM_MIX, I_OW_IN, I_ORET_GN, I_OCONV_W, I_OW_OUT, I_ONORM_FFN, I_OROUTER, I_OWE_GATE, I_OWE_UP, I_OWE_DOWN, I_FINAL_NORM };

__global__ void __launch_bounds__(NWAVES * 64, 2) skel_fwd(Args args) {
    extern __shared__ __attribute__((aligned(16))) unsigned char lds_raw[];
    LAS unsigned char* lds = (LAS unsigned char*)lds_raw;
    LAS unsigned* rowtab = (LAS unsigned*)(lds + ROWTAB_OFF);
    volatile LAS unsigned* MISC = (volatile LAS unsigned*)(lds + MISC_OFF);
    const int G = gridDim.x, bx = blockIdx.x, tid = threadIdx.x, lane = tid & 63, wave = __builtin_amdgcn_readfirstlane(tid >> 6);
    const int gw = bx * NWAVES + wave, NGW = G * NWAVES, gt = bx * NWAVES * 64 + tid, NGT = G * NWAVES * 64;
    unsigned char* ws = args.ws; float* out = args.out;
    unsigned* ctl = (unsigned*)(ws + WS_CTL);
    const unsigned* cnt = ctl + CW_CNT;
    bf16_t* XN = (bf16_t*)(ws + WS_XN); bf16_t* YMIX = (bf16_t*)(ws + WS_YMIX); bf16_t* PROJ0 = (bf16_t*)(ws + WS_PROJ0); bf16_t* CQN = (bf16_t*)(ws + WS_CQN);
    bf16_t* CKVN = (bf16_t*)(ws + WS_CKVN); bf16_t* KROPE = (bf16_t*)(ws + WS_KROPE); bf16_t* QM = (bf16_t*)(ws + WS_QM); bf16_t* KVM = (bf16_t*)(ws + WS_KVM);
    bf16_t* ACT = (bf16_t*)(ws + WS_ACT); bf16_t* PROJ1 = (bf16_t*)(ws + WS_PROJ1); float* YR = (float*)(ws + WS_YR);
    unsigned char* ACTM = ws + WS_ACTM; bf16_t* YP0 = (bf16_t*)(ws + WS_YP0); bf16_t* YP1 = (bf16_t*)(ws + WS_YP1); unsigned char* XNM = ws + WS_XNM;
    unsigned char* TAB = ws + WS_TAB;
    const int* ltok = (const int*)(TAB + TAB_LTOK); const float* lgate = (const float*)(TAB + TAB_LGATE);
    const int lo = args.ph_lo, hi = args.ph_hi;
    for (int u = tid; u < (LDS_BYTES - RING_BYTES) / 4; u += NWAVES * 64) ((LAS unsigned*)(lds + RING_BYTES))[u] = 0u;
    __syncthreads();
    XcdBarrier bar; bar.bar = (unsigned*)(ctl + CW_BAR); bar.x = 0; bar.st = nullptr;
    if (hi - lo > 1) bar = xcd_barrier_post((unsigned*)(ctl + CW_BAR), MISC + 8);
#define IN(k) (lo <= (k) && (k) < hi)
#define SEAM(k) do { if (IN(k) && IN((k) + 1)) xcd_barrier(bar); } while (0)
    using namespace pg8;

#define EXPERT_ITEM(rr) do { const int r_ = (rr), e_ = r_ / (3 * 1792), q_ = r_ % (3 * 1792), which_ = q_ / 1792, item_ = q_ % 1792; LAS float* scr_ = (LAS float*)(lds + wave * 16384); \
        if (which_ == 0) p0_item8(args.in[I_OWE_GATE] + (size_t)e_ * D * FF, D, FF, ws + WS_WE_GU + (size_t)e_ * 2 * FF * D, RowGU{0}, 128.f * LOG2E_F, scr_, item_, lane); \
        else if (which_ == 1) p0_item8(args.in[I_OWE_UP] + (size_t)e_ * D * FF, D, FF, ws + WS_WE_GU + (size_t)e_ * 2 * FF * D, RowGU{1}, 128.f * RLOG2E_F, scr_, item_, lane); \
        else p0_item8(args.in[I_OWE_DOWN] + (size_t)e_ * FF * D, FF, D, ws + WS_WE_DN + (size_t)e_ * D * FF, RowIdent{0}, 256.f, scr_, item_, lane); } while (0)
#define OFFLOAD_TAIL(nwg, base, IPW) do { const int rem_ = (nwg) % G; if (rem_ != 0 && bx >= rem_) { const int first_ = (base) + ((bx - rem_) * NWAVES + wave) * (IPW); \
        for (int k_ = 0; k_ < (IPW); ++k_) EXPERT_ITEM(first_ + k_); } } while (0)
    if (IN(PH_P0)) {
        LAS float* scr = (LAS float*)(lds + wave * 16384);
        constexpr int I_IN0 = 16 * 45, I_UQ = 6 * 24, I_UKV = 4 * 32, I_SQ = 16 * 32, I_FF = 16 * 112, I_DN = 56 * 32;
        constexpr int NDENSE = I_IN0 + I_UQ + I_UKV + I_SQ + 2 * I_FF + I_DN + I_FF + I_SQ, NITEMS = NDENSE;
        static_assert(I_DN == I_FF, "expert item arithmetic assumes equal item counts");
        for (int it = gw; it < NITEMS; it += NGW) {
            int r = it;
            if (r < I_IN0) { p0_item(args.in[I_EW_IN], D, EVEN_IN, (bf16_t*)(ws + WS_W_IN0), RowIdent{0}, scr, r, lane); continue; } r -= I_IN0;
            if (r < I_UQ) { p0_item(args.in[I_EW_UQ], 384, 768, (bf16_t*)(ws + WS_W_UQ), RowIdent{0}, scr, r, lane); continue; } r -= I_UQ;
            if (r < I_UKV) { p0_item(args.in[I_EW_UKV], 256, 1024, (bf16_t*)(ws + WS_W_UKV), RowIdent{0}, scr, r, lane); continue; } r -= I_UKV;
            if (r < I_SQ) { p0_item(args.in[I_EW_OUT], D, D, (bf16_t*)(ws + WS_W_OUT0), RowIdent{0}, scr, r, lane); continue; } r -= I_SQ;
            if (r < I_FF) { p0_item(args.in[I_EW_GATE], D, FF, (bf16_t*)(ws + WS_W_GU0), RowGU{0}, scr, r, lane, LOG2E_F); continue; } r -= I_FF;
            if (r < I_FF) { p0_item(args.in[I_EW_UP], D, FF, (bf16_t*)(ws + WS_W_GU0), RowGU{1}, scr, r, lane, RLOG2E_F); continue; } r -= I_FF;
            if (r < I_DN) { p0_item(args.in[I_EW_DOWN], FF, D, (bf16_t*)(ws + WS_W_DN0), RowIdent{0}, scr, r, lane); continue; } r -= I_DN;
            if (r < I_FF) { p0_item(args.in[I_OW_IN], D, ODD_IN, (bf16_t*)(ws + WS_W_IN1), RowIdent{0}, scr, r, lane); continue; } r -= I_FF;
            if (r < I_SQ) { p0_item(args.in[I_OW_OUT], D, D, (bf16_t*)(ws + WS_W_OUT1), RowIdent{0}, scr, r, lane); continue; } r -= I_SQ;
        }
        { v4u* z = (v4u*)((bf16_t*)(ws + WS_W_IN0) + (size_t)EVEN_IN * D); for (int i = gt; i < (EVEN_INP - EVEN_IN) * D / 8; i += NGT) z[i] = (v4u){0u, 0u, 0u, 0u}; }
        norm_rows(args.in[I_X], args.in[I_ENORM_MIX], XN, gw, NGW, lane);
    }
    SEAM(PH_P0);
    if (IN(PH_G1)) {
        Gemm g{XN, (const bf16_t*)(ws + WS_W_IN0), D, D, D, 0}; StaticOrder S; S.init(T / 256, EVEN_INP / 256, G, bx);
        gemm_phase<EpiBf16, StaticOrder, ARowIdent, true>(lds, rowtab, g, S, ARowIdent{}, EpiBf16{PROJ0, EVEN_INP});
    }
    SEAM(PH_G1);
    if (IN(PH_MP)) mla_prep_rows(PROJ0, args.in[I_EQ_NORM], args.in[I_EKV_NORM], (const int*)args.in[I_POS], CQN, CKVN, KROPE, (float*)(ws + WS_ROPE), gw, NGW, lane);
    SEAM(PH_MP);
    if (IN(PH_G2)) {
        { Gemm g{CQN, (const bf16_t*)(ws + WS_W_UQ), 384, 384, 384, 0}; StaticOrder S; S.init(T / 256, 768 / 256, G, bx);
          gemm_phase<EpiBf16, StaticOrder, ARowIdent, true>(lds, rowtab, g, S, ARowIdent{}, EpiBf16{QM, 768}); }
        { Gemm g{CKVN, (const bf16_t*)(ws + WS_W_UKV), 256, 256, 256, 0}; StaticOrder S; S.init(T / 256, 1024 / 256, G, bx);
          gemm_phase<EpiBf16, StaticOrder, ARowIdent, true>(lds, rowtab, g, S, ARowIdent{}, EpiBf16{KVM, 1024}); }
    }
    SEAM(PH_G2);
    if (IN(PH_ATT)) {
        static_assert(att::SWA_END <= RING_BYTES, "attention LDS map");
        const int vcu = (G % 8 == 0) ? (bx % 8) * (G / 8) + bx / 8 : bx;
        const att::Cv8Ptrs cp{args.in[I_OWE_GATE], args.in[I_OWE_UP], args.in[I_OWE_DOWN], ws + WS_WE_GU, ws + WS_WE_DN};
        att::Cv8 cs; cs.id = -1; int cnext = vcu * NWAVES + wave; const int cstride = G * NWAVES, cend = 2 * NE * 3 * 1792;
        for (int pr = vcu; pr < BATCH * 8 * 4; pr += G) {
            const int bh = pr >> 2, sI = pr & 3;
            att::mla_unit((LAS char*)lds, QM, KVM, KROPE, (const float*)(ws + WS_ROPE), YMIX, bh >> 3, bh & 7, sI, cp, cs, cnext, cstride, cend);
            att::mla_unit((LAS char*)lds, QM, KVM, KROPE, (const float*)(ws + WS_ROPE), YMIX, bh >> 3, bh & 7, 7 - sI, cp, cs, cnext, cstride, cend);
        }
        for (int u = vcu; u < BATCH * 32 * 2; u += G) att::swa_unit((LAS char*)lds, PROJ0, args.in[I_ESINKS], YMIX, u >> 6, (u & 63) >> 1, u & 1, cp, cs, cnext, cstride, cend);
        for (;;) { if (cs.id >= 0) att::cv8_finish(cp, cs, lane); if (cnext >= cend) break; att::cv8_issue(cp, cs, cnext, lane); cnext += cstride; }
    }
    SEAM(PH_ATT);
    if (IN(PH_G3)) {
        Gemm g{YMIX, (const bf16_t*)(ws + WS_W_OUT0), D, D, D, 0}; StaticOrder S; S.init(T / 256, D / 256, G, bx);
        gemm_phase<EpiRes, StaticOrder, ARowIdent, true>(lds, rowtab, g, S, ARowIdent{}, EpiRes{args.in[I_X], out, D});
    }
    SEAM(PH_G3);
    if (IN(PH_N2)) norm_rows(out, args.in[I_ENORM_FFN], XN, gw, NGW, lane);
    SEAM(PH_N2);
    if (IN(PH_G4)) {
        Gemm g{XN, (const bf16_t*)(ws + WS_W_GU0), D, D, D, 0}; StaticOrder S; S.init(T / 256, 2 * FF / 256, G, bx);
        gemm_phase<EpiSwiglu, StaticOrder, ARowIdent, true>(lds, rowtab, g, S, ARowIdent{}, EpiSwiglu{ACT, FF}, args.probe);
    }
    SEAM(PH_G4);
    if (IN(PH_G5)) {
        Gemm g{ACT, (const bf16_t*)(ws + WS_W_DN0), FF, FF, FF, 0}; StaticOrder S; S.init(T / 256, D / 256, G, bx);
        gemm_phase<EpiRes, StaticOrder, ARowIdent, true>(lds, rowtab, g, S, ARowIdent{}, EpiRes{out, out, D});
    }
    SEAM(PH_G5);
    if (IN(PH_N3)) norm_rows(out, args.in[I_ONORM_MIX], XN, gw, NGW, lane);
    SEAM(PH_N3);
    if (IN(PH_G6)) {
        Gemm g{XN, (const bf16_t*)(ws + WS_W_IN1), D, D, D, 0}; StaticOrder S; S.init(T / 256, ODD_IN / 256, G, bx);
        gemm_phase<EpiBf16, StaticOrder, ARowIdent, true>(lds, rowtab, g, S, ARowIdent{}, EpiBf16{PROJ1, ODD_IN});
    }
    SEAM(PH_G6);
    if (IN(PH_RET1)) {
        const int vcu = (G % 8 == 0) ? (bx % 8) * (G / 8) + bx / 8 : bx;
        for (int it = vcu; it < BATCH * 4 * 4; it += G) ret::ret12_item((LAS char*)lds, PROJ1, (bf16_t*)(ws + WS_RKV), it);
        conv_elems(PROJ1, args.in[I_OCONV_W], YMIX, gt, NGT);
    }
    SEAM(PH_RET1);
    if (IN(PH_RET3)) { static_assert(ret::R3_END <= RING_BYTES, "retention LDS map");
        for (int u = bx; u < BATCH * 4 * 32; u += G) ret::ret3_unit((LAS char*)lds, PROJ1, (const bf16_t*)(ws + WS_RKV), args.in[I_ORET_GN], YMIX, u); }
    SEAM(PH_RET3);
    if (IN(PH_G7)) {
        Gemm g{YMIX, (const bf16_t*)(ws + WS_W_OUT1), D, D, D, 0}; StaticOrder S; S.init(T / 256, D / 256, G, bx);
        gemm_phase<EpiRes, StaticOrder, ARowIdent, true>(lds, rowtab, g, S, ARowIdent{}, EpiRes{out, out, D});
    }
    SEAM(PH_G7);
    if (IN(PH_ROUTE)) route_tokens(out, args.in[I_ONORM_FFN], args.in[I_OROUTER], XNM, ctl, TAB, (LAS unsigned*)lds, bx, G, tid);
    SEAM(PH_ROUTE);
    if (IN(PH_G8)) {
        Gemm g{XNM, ws + WS_WE_GU, D, D, D, (size_t)2 * FF * D, 0x7D7D7D7D, 0x78787878, 0x7B7B7B7B}; MoeOrder S; S.init(cnt, 0, MOE_MAXT, 2 * FF / 256, 1, 0, G, bx);
        gemm_phase<EpiSwiglu8, MoeOrder, ARowMoe, true, true>(lds, rowtab, g, S, ARowMoe{ltok, cnt}, EpiSwiglu8{ACTM, FF}, args.probe);
    }
    SEAM(PH_G8);
    if (IN(PH_G9)) {
        Gemm g{ACTM, ws + WS_WE_DN, FF, FF, FF / 2, (size_t)D * FF, 0x7C7C7C7C, 0x77777777, 0x77777777}; MoeOrder S; S.init(cnt, 0, MOE_MAXT, D / 256, 2, FF / 2, G, bx);
        gemm_phase<EpiMoeDn, MoeOrder, ARowIdent, true, true>(lds, rowtab, g, S, ARowIdent{}, EpiMoeDn{YP0, YP1, lgate, cnt, 0}, args.probe);
    }
    SEAM(PH_G9);
    if (IN(PH_FINAL)) final_rows(out, YP0, YP1, cnt, TAB, args.in[I_FINAL_NORM], out, gw, NGW, lane);
#undef IN
#undef SEAM
}

template <class RM> static void wconv(const float* W, int K, int N, bf16_t* WT, RM rm, hipStream_t st) {
    hipLaunchKernelGGL((k_wconv<RM>), dim3((K / 32) * (N / 32)), dim3(256), 0, st, W, K, N, WT, rm);
}
template <bool DUAL, class Ctx> static void gemm(const bf16_t* A, int lda, const bf16_t* Bt, int ldb, int M, int N, int K, Ctx ctx, hipStream_t st) {
    GemmArgs g{A, Bt, lda, ldb, M, N, K, 0};
    hipLaunchKernelGGL((k_gemm<DUAL, Ctx>), dim3(N / 64, M / 64), dim3(256), 0, st, g, ctx);
}

extern "C" void kernel_launch(void* const* d_in, const int* in_sizes, int n_in, void* d_out, int out_size, void* d_ws, size_t ws_size, hipStream_t stream) {
    if (n_in != 25 || out_size != T * D || ws_size < WS_END) { fprintf(stderr, "kernel_launch: unexpected problem (n_in %d out %d ws %zu need %zu)\n", n_in, out_size, ws_size, (size_t)WS_END); return; }
    const float* x = (const float*)d_in[0]; const int* pos = (const int*)d_in[1];
    const float* e_norm_mix = (const float*)d_in[2]; const float* e_w_in = (const float*)d_in[3]; const float* e_sinks = (const float*)d_in[4];
    const float* e_q_norm = (const float*)d_in[5]; const float* e_w_uq = (const float*)d_in[6]; const float* e_kv_norm = (const float*)d_in[7]; const float* e_w_ukv = (const float*)d_in[8];
    const float* e_w_out = (const float*)d_in[9]; const float* e_norm_ffn = (const float*)d_in[10]; const float* e_w_gate = (const float*)d_in[11]; const float* e_w_up = (const float*)d_in[12];
    const float* e_w_down = (const float*)d_in[13]; const float* o_norm_mix = (const float*)d_in[14]; const float* o_w_in = (const float*)d_in[15]; const float* o_ret_gn = (const float*)d_in[16];
    const float* o_conv_w = (const float*)d_in[17]; const float* o_w_out = (const float*)d_in[18]; const float* o_norm_ffn = (const float*)d_in[19]; const float* o_router = (const float*)d_in[20];
    const float* o_we_gate = (const float*)d_in[21]; const float* o_we_up = (const float*)d_in[22]; const float* o_we_down = (const float*)d_in[23]; const float* final_norm = (const float*)d_in[24];
    unsigned char* ws = (unsigned char*)d_ws; float* out = (float*)d_out;
    unsigned* ctl = (unsigned*)(ws + WS_CTL);
    bf16_t* W_IN0 = (bf16_t*)(ws + WS_W_IN0); bf16_t* W_UQ = (bf16_t*)(ws + WS_W_UQ); bf16_t* W_UKV = (bf16_t*)(ws + WS_W_UKV); bf16_t* W_OUT0 = (bf16_t*)(ws + WS_W_OUT0);
    bf16_t* W_GU0 = (bf16_t*)(ws + WS_W_GU0); bf16_t* W_DN0 = (bf16_t*)(ws + WS_W_DN0); bf16_t* W_IN1 = (bf16_t*)(ws + WS_W_IN1); bf16_t* W_OUT1 = (bf16_t*)(ws + WS_W_OUT1);
    bf16_t* WE_GU = (bf16_t*)(ws + WS_WE_GU); bf16_t* WE_DN = (bf16_t*)(ws + WS_WE_DN);
    bf16_t* XN = (bf16_t*)(ws + WS_XN); bf16_t* YMIX = (bf16_t*)(ws + WS_YMIX); bf16_t* PROJ0 = (bf16_t*)(ws + WS_PROJ0); bf16_t* CQN = (bf16_t*)(ws + WS_CQN);
    bf16_t* CKVN = (bf16_t*)(ws + WS_CKVN); bf16_t* KROPE = (bf16_t*)(ws + WS_KROPE); bf16_t* QM = (bf16_t*)(ws + WS_QM); bf16_t* KVM = (bf16_t*)(ws + WS_KVM);
    bf16_t* ACT = (bf16_t*)(ws + WS_ACT); bf16_t* PROJ1 = (bf16_t*)(ws + WS_PROJ1); float* YR = (float*)(ws + WS_YR);
    bf16_t* ACTM = (bf16_t*)(ws + WS_ACTM); bf16_t* YP0 = (bf16_t*)(ws + WS_YP0); bf16_t* YP1 = (bf16_t*)(ws + WS_YP1); unsigned char* TAB = ws + WS_TAB; bf16_t* XNM = (bf16_t*)(ws + WS_XNM);

    static int grid = 0;
    if (grid == 0) {
        int dev = 0, cus = 0;
        if (hipGetDevice(&dev) != hipSuccess || hipDeviceGetAttribute(&cus, hipDeviceAttributeMultiprocessorCount, dev) != hipSuccess) { fprintf(stderr, "kernel_launch: device query failed\n"); grid = -1; return; }
        if (hipFuncSetAttribute((const void*)skel_fwd, hipFuncAttributeMaxDynamicSharedMemorySize, LDS_BYTES) != hipSuccess) { fprintf(stderr, "kernel_launch: hipFuncSetAttribute failed\n"); grid = -1; return; }
        grid = cus;
    }
    if (grid < 0) return;
    Args a{};
    for (int i = 0; i < 25; ++i) a.in[i] = (const float*)d_in[i];
    a.out = out; a.ws = ws;
    auto phase = [&](int lo, int hi) { a.ph_lo = lo; a.ph_hi = hi; hipLaunchKernelGGL(skel_fwd, dim3(grid), dim3(NWAVES * 64), LDS_BYTES, stream, a); };
    (void)hipMemsetAsync(ws + WS_CTL, 0, 1 * MiB, stream);
#if MK_ONE_LAUNCH
    phase(0, NPHASE);
#else
    for (int k = 0; k < NPHASE; ++k) { phase(k, k + 1); if (k == PROBE_DUP) { a.probe = PROBE_MODE; phase(k, k + 1); a.probe = 0; } }
#endif
}
```
